# Optimizing an MI355X kernel written in HIP

```python
import jax, jax.numpy as jnp
from jax import lax
import numpy as np

D_MODEL = 1024
BATCH = 4
SEQ = 4096
DEPTH = 1

MEM_LEN = 256
D_MIX = D_MODEL
DN_HEAD_DIM = 128
DN_HEADS = (D_MIX // 2) // DN_HEAD_DIM
D_DN = DN_HEADS * DN_HEAD_DIM
D_RG = D_MIX - D_DN
RG_BLOCKS = 4
RG_BLOCK_W = D_RG // RG_BLOCKS
RG_C = 8.0
CONV_WIDTH = 4
CHUNK = 64
XA_HEADS = 4
XA_HEAD_DIM = D_MODEL // XA_HEADS
N_EXPERTS = 32
TOP_K = 4
D_FF = D_MODEL
SWIGLU_LIMIT = 7.0
SWIGLU_ALPHA = 1.702
MOE_BLOCK = 128
EPS = 1e-6

kernel_name = "hybrid_deltanet_rglru_memxattn_moe"


def rmsnorm(x, g):
    xf = x.astype(jnp.float32)
    y = xf * lax.rsqrt(jnp.mean(xf * xf, axis=-1, keepdims=True) + EPS)
    return (y * g.astype(jnp.float32)).astype(x.dtype)


def l2norm(x):
    return x * lax.rsqrt(jnp.sum(x * x, axis=-1, keepdims=True) + EPS)


def causal_dwconv(x, w):
    K, C = w.shape
    return lax.conv_general_dilated(
        x, w[:, None, :].astype(x.dtype), window_strides=(1,), padding=[(K - 1, 0)],
        dimension_numbers=('NWC', 'WIO', 'NWC'), feature_group_count=C)


def gated_delta_rule(q, k, v, g, beta):
    B, T, H, DK = q.shape
    DV = v.shape[-1]
    C = CHUNK
    N = T // C
    q = q * (DK ** -0.5)

    def chunk(t):
        return t.reshape(B, N, C, H, -1).transpose(0, 3, 1, 2, 4)

    qc, kc, vc = chunk(q), chunk(k), chunk(v)
    gc = g.reshape(B, N, C, H).transpose(0, 3, 1, 2)
    bc = beta.reshape(B, N, C, H).transpose(0, 3, 1, 2)
    gcum = jnp.cumsum(gc, axis=-1)
    causal = jnp.tril(jnp.ones((C, C), bool))
    strict = jnp.tril(jnp.ones((C, C), bool), k=-1)
    diff = gcum[..., :, None] - gcum[..., None, :]
    decay = jnp.where(causal, jnp.exp(jnp.where(causal, diff, 0.0)), 0.0)
    k_beta = kc * bc[..., None]
    A = jnp.where(strict, jnp.einsum('bhncd,bhnsd->bhncs', k_beta, kc) * decay, 0.0)
    lower = A + jnp.eye(C, dtype=A.dtype)
    rhs = jnp.concatenate([vc * bc[..., None], k_beta * jnp.exp(gcum)[..., None]], axis=-1)
    sol = lax.linalg.triangular_solve(lower, rhs, left_side=True, lower=True, unit_diagonal=True)
    u, w = sol[..., :DV], sol[..., DV:]
    qk = jnp.einsum('bhncd,bhnsd->bhncs', qc, kc) * decay

    def step(S, inp):
        q_i, k_i, u_i, w_i, qk_i, g_i = inp
        v_new = u_i - jnp.matmul(w_i, S)
        o = jnp.matmul(q_i * jnp.exp(g_i)[..., None], S) + jnp.matmul(qk_i, v_new)
        g_last = g_i[..., -1]
        k_dec = k_i * jnp.exp(g_last[..., None] - g_i)[..., None]
        S = S * jnp.exp(g_last)[..., None, None] + jnp.einsum('bhcd,bhce->bhde', k_dec, v_new)
        return S, o

    mv = lambda t: jnp.moveaxis(t, 2, 0)
    S0 = jnp.zeros((B, H, DK, DV), jnp.float32)
    _, o = lax.scan(step, S0, (mv(qc), mv(kc), mv(u), mv(w), mv(qk), mv(gcum)))
    return o.transpose(1, 0, 3, 2, 4).reshape(B, T, H, DV)


def rg_lru(xr, w_a, b_a, w_x, b_x, lam):
    B, T, _ = xr.shape
    xf = xr.astype(jnp.float32)
    xb = xf.reshape(B, T, RG_BLOCKS, RG_BLOCK_W)
    r = jax.nn.sigmoid(jnp.einsum('btni,nio->btno', xb, w_a.astype(jnp.float32)) + b_a.astype(jnp.float32))
    i = jax.nn.sigmoid(jnp.einsum('btni,nio->btno', xb, w_x.astype(jnp.float32)) + b_x.astype(jnp.float32))
    r = r.reshape(B, T, D_RG)
    i = i.reshape(B, T, D_RG)
    log_a = RG_C * r * jax.nn.log_sigmoid(lam.astype(jnp.float32))
    a = jnp.exp(log_a)
    mult = jnp.sqrt(-jnp.expm1(2.0 * log_a))
    mult = jnp.where(jnp.arange(T)[None, :, None] == 0, 1.0, mult)
    bx = mult * (i * xf)

    def combine(c1, c2):
        a1, b1 = c1
        a2, b2 = c2
        return a1 * a2, a2 * b1 + b2

    _, h = lax.associative_scan(combine, (a, bx), axis=1)
    return h


def hybrid_mixer(u, w_in, dn_conv, dn_a_log, dn_dt_bias, dn_norm, rg_conv, rg_conv_b,
                 rg_w_a, rg_b_a, rg_w_x, rg_b_x, rg_lambda, w_out):
    B, T, _ = u.shape
    proj = u @ w_in
    sizes = (D_DN, D_DN, D_DN, D_DN, DN_HEADS, DN_HEADS, D_RG, D_RG)
    cuts = [int(c) for c in np.cumsum(sizes)[:-1]]
    q, k, v, z, b, a, rx, ry = jnp.split(proj, cuts, axis=-1)

    qkv = jax.nn.silu(causal_dwconv(jnp.concatenate([q, k, v], axis=-1), dn_conv)).astype(jnp.float32)
    q, k, v = jnp.split(qkv, 3, axis=-1)
    heads = lambda t: t.reshape(B, T, DN_HEADS, DN_HEAD_DIM)
    q, k, v = l2norm(heads(q)), l2norm(heads(k)), heads(v)
    beta = jax.nn.sigmoid(b.astype(jnp.float32))
    g = -jnp.exp(dn_a_log.astype(jnp.float32)) * jax.nn.softplus(
        a.astype(jnp.float32) + dn_dt_bias.astype(jnp.float32))
    o = gated_delta_rule(q, k, v, g, beta)
    o = rmsnorm(o, dn_norm) * jax.nn.silu(heads(z.astype(jnp.float32)))
    dn_out = o.reshape(B, T, D_DN).astype(u.dtype)

    xr = causal_dwconv(rx, rg_conv) + rg_conv_b.astype(rx.dtype)
    h = rg_lru(xr, rg_w_a, rg_b_a, rg_w_x, rg_b_x, rg_lambda)
    rg_out = (h * jax.nn.gelu(ry.astype(jnp.float32))).astype(u.dtype)

    return jnp.concatenate([dn_out, rg_out], axis=-1) @ w_out


def memory_cross_attention(hn, mem_n, w_cq, w_ckv, w_co):
    B, T, D = hn.shape
    M = mem_n.shape[1]
    q = (hn @ w_cq).reshape(B, T, XA_HEADS, XA_HEAD_DIM)
    k, v = jnp.split(mem_n @ w_ckv, 2, axis=-1)
    k = k.reshape(B, M, XA_HEADS, XA_HEAD_DIM)
    v = v.reshape(B, M, XA_HEADS, XA_HEAD_DIM)
    s = jnp.einsum('bthd,bmhd->bhtm', q, k).astype(jnp.float32) * (XA_HEAD_DIM ** -0.5)
    p = jax.nn.softmax(s, axis=-1).astype(hn.dtype)
    o = jnp.einsum('bhtm,bmhd->bthd', p, v).reshape(B, T, D)
    return o @ w_co


def moe_ffn(hn, w_router, b_router, w_gate, b_gate, w_up, b_up, w_down, b_down):
    B, T, D = hn.shape
    n_tok = B * T
    xt = hn.reshape(n_tok, D)
    logits = xt.astype(jnp.float32) @ w_router.astype(jnp.float32) + b_router.astype(jnp.float32)
    top_logit, top_e = lax.top_k(logits, TOP_K)
    gate = jax.nn.softmax(top_logit, axis=-1)
    n_assign = n_tok * TOP_K
    flat_e = top_e.reshape(-1)
    order = jnp.argsort(flat_e)
    sorted_e = flat_e[order]
    sorted_tok = order // TOP_K
    sorted_gate = gate.reshape(-1)[order]
    counts = jnp.bincount(flat_e, length=N_EXPERTS)
    padded = (counts + MOE_BLOCK - 1) // MOE_BLOCK * MOE_BLOCK
    pad_end = jnp.cumsum(padded)
    pad_start = pad_end - padded
    start = jnp.cumsum(counts) - counts
    dest = pad_start[sorted_e] + jnp.arange(n_assign) - start[sorted_e]
    n_blocks = -(-n_assign // MOE_BLOCK) + N_EXPERTS
    n_rows = n_blocks * MOE_BLOCK
    row_tok = jnp.full((n_rows,), n_tok, jnp.int32).at[dest].set(sorted_tok.astype(jnp.int32))
    row_gate = jnp.zeros((n_rows,), xt.dtype).at[dest].set(sorted_gate.astype(xt.dtype))
    block_e = jnp.minimum(jnp.searchsorted(pad_end, jnp.arange(n_blocks) * MOE_BLOCK, side='right'),
                          N_EXPERTS - 1)
    x_pad = jnp.concatenate([xt, jnp.zeros((1, D), xt.dtype)], axis=0)
    xb = x_pad[row_tok].reshape(n_blocks, MOE_BLOCK, D)

    def expert_block(args):
        xblk, e = args
        gt = jnp.minimum(xblk @ w_gate[e] + b_gate[e], SWIGLU_LIMIT)
        up = jnp.clip(xblk @ w_up[e] + b_up[e], -SWIGLU_LIMIT, SWIGLU_LIMIT)
        hid = (up + 1.0) * (gt * jax.nn.sigmoid(SWIGLU_ALPHA * gt))
        return hid @ w_down[e] + b_down[e]

    yb = lax.map(expert_block, (xb, block_e))
    y = yb.reshape(n_rows, D) * row_gate[:, None]
    out = jax.ops.segment_sum(y, row_tok, num_segments=n_tok + 1)[:n_tok]
    return out.reshape(B, T, D)


def setup_inputs(seed: int = 0) -> dict:
    key = jax.random.key(seed)
    ks = jax.random.split(key, 32)
    L = DEPTH
    f32 = jnp.float32
    nrm = lambda kk, shape, scale: jax.random.normal(kk, shape, f32) * scale
    gain = lambda kk, shape: 1.0 + 0.02 * jax.random.normal(kk, shape, f32)
    d_in = 4 * D_DN + 2 * DN_HEADS + 2 * D_RG
    dt = jnp.exp(jax.random.uniform(ks[6], (L, DN_HEADS), f32, np.log(1e-3), np.log(1e-1)))
    a8 = jax.random.uniform(ks[14], (L, D_RG), f32, 0.9, 0.999)
    s = a8 ** (1.0 / RG_C)
    return {
        'x': nrm(ks[0], (BATCH, SEQ, D_MODEL), 1.0),
        'mem': nrm(ks[1], (BATCH, MEM_LEN, D_MODEL), 1.0),
        'norm_mix': gain(ks[2], (L, D_MODEL)),
        'w_in': nrm(ks[3], (L, D_MODEL, d_in), D_MODEL ** -0.5),
        'dn_conv': nrm(ks[4], (L, CONV_WIDTH, 3 * D_DN), CONV_WIDTH ** -0.5),
        'dn_a_log': jnp.log(jax.random.uniform(ks[5], (L, DN_HEADS), f32, 1.0, 16.0)),
        'dn_dt_bias': dt + jnp.log(-jnp.expm1(-dt)),
        'dn_norm': gain(ks[7], (L, DN_HEAD_DIM)),
        'rg_conv': nrm(ks[8], (L, CONV_WIDTH, D_RG), CONV_WIDTH ** -0.5),
        'rg_conv_b': nrm(ks[9], (L, D_RG), 0.01),
        'rg_w_a': nrm(ks[10], (L, RG_BLOCKS, RG_BLOCK_W, RG_BLOCK_W), RG_BLOCK_W ** -0.5),
        'rg_b_a': nrm(ks[11], (L, RG_BLOCKS, RG_BLOCK_W), 0.01),
        'rg_w_x': nrm(ks[12], (L, RG_BLOCKS, RG_BLOCK_W, RG_BLOCK_W), RG_BLOCK_W ** -0.5),
        'rg_b_x': nrm(ks[13], (L, RG_BLOCKS, RG_BLOCK_W), 0.01),
        'rg_lambda': jnp.log(s) - jnp.log1p(-s),
        'w_out': nrm(ks[15], (L, D_MIX, D_MODEL), D_MIX ** -0.5),
        'norm_cross': gain(ks[16], (L, D_MODEL)),
        'norm_mem': gain(ks[17], (L, D_MODEL)),
        'w_cq': nrm(ks[18], (L, D_MODEL, D_MODEL), D_MODEL ** -0.5),
        'w_ckv': nrm(ks[19], (L, D_MODEL, 2 * D_MODEL), D_MODEL ** -0.5),
        'w_co': nrm(ks[20], (L, D_MODEL, D_MODEL), D_MODEL ** -0.5),
        'norm_moe': gain(ks[21], (L, D_MODEL)),
        'w_router': nrm(ks[22], (L, D_MODEL, N_EXPERTS), D_MODEL ** -0.5),
        'b_router': nrm(ks[23], (L, N_EXPERTS), 0.01),
        'w_gate': nrm(ks[24], (L, N_EXPERTS, D_MODEL, D_FF), D_MODEL ** -0.5),
        'b_gate': nrm(ks[25], (L, N_EXPERTS, D_FF), 0.01),
        'w_up': nrm(ks[26], (L, N_EXPERTS, D_MODEL, D_FF), D_MODEL ** -0.5),
        'b_up': nrm(ks[27], (L, N_EXPERTS, D_FF), 0.01),
        'w_down': nrm(ks[28], (L, N_EXPERTS, D_FF, D_MODEL), D_FF ** -0.5),
        'b_down': nrm(ks[29], (L, N_EXPERTS, D_MODEL), 0.01),
        'norm_final': gain(ks[30], (D_MODEL,)),
    }


def reference(x, mem, norm_mix, w_in, dn_conv, dn_a_log, dn_dt_bias, dn_norm, rg_conv, rg_conv_b,
              rg_w_a, rg_b_a, rg_w_x, rg_b_x, rg_lambda, w_out, norm_cross, norm_mem, w_cq, w_ckv,
              w_co, norm_moe, w_router, b_router, w_gate, b_gate, w_up, b_up, w_down, b_down,
              norm_final):
    h = x
    for l in range(DEPTH):
        h = h + hybrid_mixer(rmsnorm(h, norm_mix[l]), w_in[l], dn_conv[l], dn_a_log[l], dn_dt_bias[l],
                             dn_norm[l], rg_conv[l], rg_conv_b[l], rg_w_a[l], rg_b_a[l], rg_w_x[l],
                             rg_b_x[l], rg_lambda[l], w_out[l])
        h = h + memory_cross_attention(rmsnorm(h, norm_cross[l]), rmsnorm(mem, norm_mem[l]),
                                       w_cq[l], w_ckv[l], w_co[l])
        h = h + moe_ffn(rmsnorm(h, norm_moe[l]), w_router[l], b_router[l], w_gate[l], b_gate[l],
                        w_up[l], b_up[l], w_down[l], b_down[l])
    return rmsnorm(h, norm_final)
```

```cpp
#include <hip/hip_runtime.h>
#include <cstdio>
#include <cstdint>

typedef unsigned short bf16;
__device__ __forceinline__ float bf2f(bf16 v) { return __builtin_bit_cast(float, (unsigned)v << 16); }
__device__ __forceinline__ bf16 f2bf(float f) { unsigned u = __builtin_bit_cast(unsigned, f); return (bf16)((u + 0x7fffu + ((u >> 16) & 1u)) >> 16); }

constexpr int NB = 4, T = 4096, D = 1024, M = NB * T, NIN = 3080, NP = 3072, MEML = 256;
constexpr int NE = 32, TOPK = 4;
constexpr float EPS = 1e-6f;
constexpr int PC_Q = 0, PC_K = 512, PC_V = 1024, PC_Z = 1536, PC_RX = 2048, PC_RY = 2560;

constexpr size_t MiB = 1u << 20;
constexpr size_t WS_CTL = 0, CTL_BYTES = 1 * MiB;
constexpr int CW_CNT = 8192;
constexpr size_t CTL_SS1 = 128 * 1024, CTL_SS2 = 192 * 1024;
constexpr size_t WS_BA = 1 * MiB, WS_RSTD2 = 1 * MiB + 512 * 1024, WS_DEC = 1 * MiB + 768 * 1024;
constexpr size_t WS_RGW = 2 * MiB, WS_WR = 2 * MiB + 512 * 1024, WS_MEMN = 3 * MiB, WS_KM = 5 * MiB, WS_VT = 7 * MiB;
constexpr size_t WS_RGSUM = 9 * MiB, WS_TOKL = 10 * MiB, WS_GATEL = 12 * MiB;
constexpr size_t WS_WIN = 16 * MiB, WS_WOUT = 22 * MiB, WS_WCQ = 24 * MiB, WS_WCKV = 26 * MiB, WS_WCO = 30 * MiB;
constexpr size_t WS_WGU = 32 * MiB, WS_WD = 160 * MiB;
constexpr size_t WS_XN = 224 * MiB;
constexpr size_t WS_PROJ = 256 * MiB;
constexpr size_t WS_HB = 256 * MiB, WS_Q = 288 * MiB, WS_P = 320 * MiB, WS_HID = 256 * MiB;
constexpr size_t WS_DN = 352 * MiB;
constexpr size_t WS_O2 = 352 * MiB, WS_SC = 384 * MiB  ;
constexpr size_t WS_ODN = 442 * MiB, WS_HLOC = 474 * MiB, WS_CP = 490 * MiB, WS_END = 506 * MiB;
constexpr size_t WS_Y = 32 * MiB;
constexpr size_t WS_QKVN = 32 * MiB;

__global__ void k_transpose(const float* W, int ldn, bf16* out, int K, const float* gain,
                            int zb, long in_s1, long in_s2, long out_s1, long out_s2) {
    __shared__ float tile[32][33];
    const int z = blockIdx.z; W += (z / zb) * in_s1 + (z % zb) * in_s2; out += (z / zb) * out_s1 + (z % zb) * out_s2;
    const int r0 = blockIdx.x * 32, k0 = blockIdx.y * 32, tx = threadIdx.x & 31, ty = threadIdx.x >> 5;
    for (int i = ty; i < 32; i += 8) { const int k = k0 + i; tile[i][tx] = W[(size_t)k * ldn + r0 + tx] * (gain ? gain[k] : 1.f); }
    __syncthreads();
    for (int i = ty; i < 32; i += 8) out[(size_t)(r0 + i) * K + k0 + tx] = f2bf(tile[tx][i]);
}
__global__ void k_router_w(const float* wr, const float* g, bf16* hi, bf16* lo) {
    const int i = blockIdx.x * blockDim.x + threadIdx.x; if (i >= NE * D) return;
    const int e = i / D, k = i % D; const float v = wr[k * NE + e] * g[k]; const bf16 h = f2bf(v); hi[i] = h; lo[i] = f2bf(v - bf2f(h));
}

__device__ __forceinline__ float wave_sum(float v) {
#pragma unroll
    for (int o = 1; o < 64; o <<= 1) v += __shfl_xor(v, o);
    return v;
}
__global__ void k_rmsnorm_rows(const float* x, const float* g, bf16* out, int nrows, const float* w8, int ldw, float* ba) {
    const int row = blockIdx.x * (blockDim.x >> 6) + (threadIdx.x >> 6), lane = threadIdx.x & 63; if (row >= nrows) return;
    const float* xr = x + (size_t)row * D; float v[16]; float s = 0.f;
#pragma unroll
    for (int j = 0; j < 16; ++j) { v[j] = xr[lane + 64 * j]; s += v[j] * v[j]; }
    const float rstd = rsqrtf(wave_sum(s) * (1.f / D) + EPS);
    float acc[8];
#pragma unroll
    for (int q = 0; q < 8; ++q) acc[q] = 0.f;
#pragma unroll
    for (int j = 0; j < 16; ++j) { const int k = lane + 64 * j; const float u = v[j] * rstd * g[k]; out[(size_t)row * D + k] = f2bf(u);
        if (w8) {
#pragma unroll
            for (int q = 0; q < 8; ++q) acc[q] += u * w8[(size_t)k * ldw + q]; } }
    if (w8) {
#pragma unroll
        for (int q = 0; q < 8; ++q) { const float t = wave_sum(acc[q]); if (lane == 0) ba[(size_t)row * 8 + q] = t; } }
}

__device__ __forceinline__ float sigmoidf_(float x) { return 1.f / (1.f + __expf(-x)); }
__device__ __forceinline__ float siluf_(float x) { return x * sigmoidf_(x); }
__device__ __forceinline__ float softplusf_(float x) { return fmaxf(x, 0.f) + log1pf(__expf(-fabsf(x))); }
__device__ __forceinline__ float gelu_tanh(float x) { const float u = 0.7978845608028654f * (x + 0.044715f * x * x * x); return 0.5f * x * (1.f + tanhf(u)); }
__device__ __forceinline__ float ffn_act(float gt, float up) { gt = fminf(gt, 7.f); up = fminf(fmaxf(up, -7.f), 7.f); return (up + 1.f) * (gt * sigmoidf_(1.702f * gt)); }

struct GP {
    const bf16* A; int lda; const bf16* Bt; int ldb; int K;
    float* F0; float* F1; bf16* H0; bf16* H1; const float* C0; const float* C1; const int* I0; const float* G0; const unsigned* cnt;
};
template <int MODE> __global__ void __launch_bounds__(256) k_gemm(GP p) {
    __shared__ float As[16][65], Bs[16][65], Bs2[16][65];
    __shared__ int rowsrc[64]; __shared__ int rowaux[64]; __shared__ float rowg[64];
    const int tid = threadIdx.x, tx = tid & 15, ty = tid >> 4;
    int row0 = blockIdx.y * 64, col0 = blockIdx.x * 64; const bf16* A = p.A; const bf16* Bt = p.Bt;
    int e = 0, nvalid = 64, slot0 = 0;
    if (MODE == 4) { const int b = blockIdx.z >> 2, h = blockIdx.z & 3; row0 += b * T; A += h * 256; Bt += (size_t)(b * 256) * 1024 + h * 256; }
    if (MODE == 5) { const int b = blockIdx.z >> 2, h = blockIdx.z & 3; row0 += b * T; A += h * 256; Bt += (size_t)(h * 256) * 1024 + b * 256; }
    if (MODE == 7 || MODE == 8) {
        e = blockIdx.z; const int cnt = (int)p.cnt[e]; if (row0 >= cnt) return; nvalid = min(64, cnt - row0);
        for (int i = 0; i < e; ++i) slot0 += (((int)p.cnt[i] + 255) / 256) * 256;
        if (tid < 64) { const int pos = row0 + tid; const int v = pos < cnt ? p.I0[e * M + pos] : 0; rowaux[tid] = v; rowsrc[tid] = (MODE == 7) ? (v >> 2) : (slot0 + pos); rowg[tid] = pos < cnt ? p.G0[e * M + pos] : 0.f; }
        Bt += (size_t)e * (MODE == 7 ? 2048 : 1024) * 1024;
        __syncthreads();
    }
    float acc[4][4], acc2[4][4];
#pragma unroll
    for (int i = 0; i < 4; ++i)
#pragma unroll
        for (int j = 0; j < 4; ++j) { acc[i][j] = 0.f; acc2[i][j] = 0.f; }
    for (int k0 = 0; k0 < p.K; k0 += 16) {
        for (int i = tid; i < 64 * 16; i += 256) { const int r = i >> 4, k = i & 15;
            const int ar = (MODE == 7 || MODE == 8) ? rowsrc[r] : row0 + r;
            As[k][r] = bf2f(A[(size_t)ar * p.lda + k0 + k]);
            int bc = col0 + r;
            if (MODE == 7) { const int c = col0 + r; bc = (c >> 7) * 256 + (c & 127); Bs2[k][r] = bf2f(Bt[(size_t)(bc + 128) * p.ldb + k0 + k]); }
            Bs[k][r] = bf2f(Bt[(size_t)bc * p.ldb + k0 + k]); }
        __syncthreads();
#pragma unroll
        for (int k = 0; k < 16; ++k) { float a[4], b[4], b2[4];
#pragma unroll
            for (int i = 0; i < 4; ++i) { a[i] = As[k][ty * 4 + i]; b[i] = Bs[k][tx * 4 + i]; if (MODE == 7) b2[i] = Bs2[k][tx * 4 + i]; }
#pragma unroll
            for (int i = 0; i < 4; ++i)
#pragma unroll
                for (int j = 0; j < 4; ++j) { acc[i][j] += a[i] * b[j]; if (MODE == 7) acc2[i][j] += a[i] * b2[j]; } }
        __syncthreads();
    }
#pragma unroll
    for (int i = 0; i < 4; ++i) {
        const int rl = ty * 4 + i, row = row0 + rl; float hsq = 0.f;
#pragma unroll
        for (int j = 0; j < 4; ++j) { const int col = col0 + tx * 4 + j; const float v = acc[i][j];
            if (MODE == 0) p.H0[(size_t)row * NP + col] = f2bf(v);
            if (MODE == 1) { if (col < 1024) p.H0[(size_t)row * 1024 + col] = f2bf(v); else p.H1[(size_t)(col - 1024) * 1024 + row] = f2bf(v); }
            if (MODE == 2 || MODE == 6) { const size_t o = (size_t)row * D + col; const float h = p.C0[o] + v; p.F0[o] = h; p.H0[o] = f2bf(h); hsq += h * h; }
            if (MODE == 3) { const float rs = rsqrtf(p.C0[row] * (1.f / D) + EPS); p.H0[(size_t)row * D + col] = f2bf(v * rs * 0.0625f); }
            if (MODE == 4) { const int h = blockIdx.z & 3; p.F0[(size_t)row * 1024 + h * 256 + col] = v; }
            if (MODE == 5) { const int h = blockIdx.z & 3; p.H0[(size_t)row * 1024 + h * 256 + col] = f2bf(v); }
            if (MODE == 7) { if (rl < nvalid) { const float rs = p.C0[rowaux[rl] >> 2]; const float gt = v * rs + p.C1[e * 1024 + col], up = acc2[i][j] * rs + p.F1[e * 1024 + col];
                    p.H0[(size_t)(slot0 + row) * 1024 + col] = f2bf(ffn_act(gt, up)); } }
            if (MODE == 8) { if (rl < nvalid) p.H0[(size_t)rowaux[rl] * 1024 + col] = f2bf((v + p.C0[e * 1024 + col]) * rowg[rl]); }
        }
        if (MODE == 2 || MODE == 6) atomicAdd(&p.F1[row], hsq);
    }
}

__global__ void k_dn_prep(const bf16* proj, const float* conv, float* qkvn) {
    const int row = blockIdx.x, t = row % T, c = blockIdx.y * 128 + threadIdx.x;
    float s = 0.f;
#pragma unroll
    for (int j = 0; j < 4; ++j) { const int tt = t + j - 3; if (tt >= 0) s += conv[j * 1536 + c] * bf2f(proj[(size_t)(row + j - 3) * NP + c]); }
    s = siluf_(s);
    if (blockIdx.y < 8) { __shared__ float red[2]; float q = wave_sum(s * s); if ((threadIdx.x & 63) == 0) red[threadIdx.x >> 6] = q; __syncthreads(); q = red[0] + red[1]; s *= rsqrtf(q + EPS); }
    qkvn[(size_t)row * 1536 + c] = s;
}
__global__ void __launch_bounds__(256) k_dn_rec(const float* qkvn, const float* ba, const float* a_log, const float* dt_bias, float* odn) {
    const int sl = blockIdx.x & 7, h = (blockIdx.x >> 3) & 3, b = blockIdx.x >> 5, tid = threadIdx.x, dvl = tid & 15, part = tid >> 4;
    __shared__ float qs[128], ks[128], red[16][17], red2[16][17];
    float S[8];
#pragma unroll
    for (int i = 0; i < 8; ++i) S[i] = 0.f;
    const float Aexp = __expf(a_log[h]), dtb = dt_bias[h], scale = 0.08838834764831845f;
    for (int t = 0; t < T; ++t) {
        const size_t row = (size_t)b * T + t;
        if (tid < 128) { qs[tid] = qkvn[row * 1536 + h * 128 + tid]; ks[tid] = qkvn[row * 1536 + 512 + h * 128 + tid]; }
        const float v = qkvn[row * 1536 + 1024 + h * 128 + sl * 16 + dvl];
        const float beta = sigmoidf_(ba[row * 8 + h]), g = -Aexp * softplusf_(ba[row * 8 + 4 + h] + dtb), eg = __expf(g);
        __syncthreads();
        float pk = 0.f;
#pragma unroll
        for (int i = 0; i < 8; ++i) pk += ks[part * 8 + i] * S[i];
        red[part][dvl] = pk; __syncthreads();
        float kS = 0.f;
#pragma unroll
        for (int i = 0; i < 16; ++i) kS += red[i][dvl];
        const float vn = beta * (v - eg * kS);
        float po = 0.f;
#pragma unroll
        for (int i = 0; i < 8; ++i) { S[i] = eg * S[i] + ks[part * 8 + i] * vn; po += qs[part * 8 + i] * S[i]; }
        red2[part][dvl] = po; __syncthreads();
        if (part == 0) { float o = 0.f;
#pragma unroll
            for (int i = 0; i < 16; ++i) o += red2[i][dvl];
            odn[row * 512 + h * 128 + sl * 16 + dvl] = o * scale; }
    }
}
__global__ void k_fin_dn(const float* odn, const bf16* proj, const float* dn_norm, bf16* mix) {
    const int row = blockIdx.x, h = blockIdx.y, dv = threadIdx.x; __shared__ float red[2];
    const float o = odn[(size_t)row * 512 + h * 128 + dv]; float q = wave_sum(o * o); if ((dv & 63) == 0) red[dv >> 6] = q; __syncthreads();
    const float rs = rsqrtf((red[0] + red[1]) * (1.f / 128) + EPS);
    mix[(size_t)row * D + h * 128 + dv] = f2bf(o * rs * dn_norm[dv] * siluf_(bf2f(proj[(size_t)row * NP + PC_Z + h * 128 + dv])));
}
__global__ void __launch_bounds__(512) k_rg_prep(const bf16* proj, const float* conv, const float* convb, const float* w_a, const float* b_a,
                                                   const float* w_x, const float* b_x, const float* lam, float* aa, float* bx) {
    const int row = blockIdx.x, t = row % T, ch = threadIdx.x; __shared__ float xr[512];
    float s = convb[ch];
#pragma unroll
    for (int j = 0; j < 4; ++j) { const int tt = t + j - 3; if (tt >= 0) s += conv[j * 512 + ch] * bf2f(proj[(size_t)(row + j - 3) * NP + PC_RX + ch]); }
    xr[ch] = s; __syncthreads();
    const int nb = ch >> 7, o = ch & 127; float ra = b_a[ch], rx_ = b_x[ch];
    for (int i = 0; i < 128; ++i) { const float xv = xr[nb * 128 + i]; ra += xv * w_a[(nb * 128 + i) * 128 + o]; rx_ += xv * w_x[(nb * 128 + i) * 128 + o]; }
    const float r = sigmoidf_(ra), ig = sigmoidf_(rx_);
    const float log_a = 8.f * r * (-softplusf_(-lam[ch])); const float a = __expf(log_a);
    float mult = sqrtf(fmaxf(-expm1f(2.f * log_a), 0.f)); if (t == 0) mult = 1.f;
    aa[(size_t)row * 512 + ch] = a; bx[(size_t)row * 512 + ch] = mult * (ig * s);
}
__global__ void k_rg_scan(const float* aa, const float* bx, const bf16* proj, bf16* mix) {
    const int i = blockIdx.x * blockDim.x + threadIdx.x, b = i >> 9, ch = i & 511; float h = 0.f;
    for (int t0 = 0; t0 < T; t0 += 8) { float a[8], x[8], y[8];
#pragma unroll
        for (int j = 0; j < 8; ++j) { const size_t row = (size_t)b * T + t0 + j; a[j] = aa[row * 512 + ch]; x[j] = bx[row * 512 + ch]; y[j] = bf2f(proj[row * NP + PC_RY + ch]); }
#pragma unroll
        for (int j = 0; j < 8; ++j) { h = a[j] * h + x[j]; mix[((size_t)b * T + t0 + j) * D + 512 + ch] = f2bf(h * gelu_tanh(y[j])); } }
}
__global__ void k_softmax(const float* sc, bf16* p) {
    const int row = blockIdx.x, h = blockIdx.y, k = threadIdx.x; __shared__ float red[4];
    const float s = sc[(size_t)row * 1024 + h * 256 + k]; float m = s;
#pragma unroll
    for (int o = 1; o < 64; o <<= 1) m = fmaxf(m, __shfl_xor(m, o));
    if ((k & 63) == 0) red[k >> 6] = m; __syncthreads(); m = fmaxf(fmaxf(red[0], red[1]), fmaxf(red[2], red[3])); __syncthreads();
    const float e = __expf(s - m); float q = wave_sum(e); if ((k & 63) == 0) red[k >> 6] = q; __syncthreads(); q = red[0] + red[1] + red[2] + red[3];
    p[(size_t)row * 1024 + h * 256 + k] = f2bf(e / q);
}
__global__ void k_route(const float* hres, const float* ss, const float* g, const float* wr, const float* br, float* rstd2, unsigned* cnt, int* tokl, float* gatel) {
    const int row = blockIdx.x * (blockDim.x >> 6) + (threadIdx.x >> 6), lane = threadIdx.x & 63, e = lane & 31, half = lane >> 5;
    const float rs = rsqrtf(ss[row] * (1.f / D) + EPS); float acc = 0.f;
    for (int k = half * 512; k < half * 512 + 512; ++k) acc += hres[(size_t)row * D + k] * g[k] * wr[k * NE + e];
    acc += __shfl_xor(acc, 32); float logit = acc * rs + br[e];
    float tl[4]; int te[4];
#pragma unroll
    for (int q = 0; q < 4; ++q) { float m = logit; int mi = e;
#pragma unroll
        for (int o = 1; o < 32; o <<= 1) { const float om = __shfl_xor(m, o); const int oi = __shfl_xor(mi, o); if (om > m || (om == m && oi < mi)) { m = om; mi = oi; } }
        tl[q] = m; te[q] = mi; if (e == mi) logit = -3.0e38f; }
    const float e1 = __expf(tl[1] - tl[0]), e2 = __expf(tl[2] - tl[0]), e3 = __expf(tl[3] - tl[0]), inv = 1.f / (1.f + e1 + e2 + e3);
    const float gt[4] = {inv, e1 * inv, e2 * inv, e3 * inv};
    if (lane < 4) { const int ex = lane == 0 ? te[0] : lane == 1 ? te[1] : lane == 2 ? te[2] : te[3]; const float gv = lane == 0 ? gt[0] : lane == 1 ? gt[1] : lane == 2 ? gt[2] : gt[3];
        const unsigned pos = atomicAdd(&cnt[ex], 1u); tokl[ex * M + pos] = row * 4 + lane; gatel[ex * M + pos] = gv; }
    if (lane == 0) rstd2[row] = rs;
}
__global__ void k_combine(float* out, const bf16* y, const float* g) {
    const int row = blockIdx.x * (blockDim.x >> 6) + (threadIdx.x >> 6), lane = threadIdx.x & 63; float v[16]; float s = 0.f;
#pragma unroll
    for (int j = 0; j < 16; ++j) { const int c = lane + 64 * j; float h = out[(size_t)row * D + c];
#pragma unroll
        for (int k = 0; k < 4; ++k) h += bf2f(y[((size_t)row * 4 + k) * D + c]);
        v[j] = h; s += h * h; }
    const float rs = rsqrtf(wave_sum(s) * (1.f / D) + EPS);
#pragma unroll
    for (int j = 0; j < 16; ++j) { const int c = lane + 64 * j; out[(size_t)row * D + c] = v[j] * rs * g[c]; }
}

extern "C" void kernel_launch(void* const* d_in, const int* in_sizes, int n_in, void* d_out, int out_size, void* d_ws, size_t ws_size, hipStream_t stream) {
    if (n_in != 31 || out_size != M * D || ws_size < WS_END) { fprintf(stderr, "kernel_launch: unexpected shapes n_in %d out %d ws %zu\n", n_in, out_size, ws_size); return; }
    const float* const* in = (const float* const*)d_in;
    const float *x = in[0], *mem = in[1], *norm_mix = in[2], *w_in = in[3], *dn_conv = in[4], *dn_a_log = in[5], *dn_dt_bias = in[6], *dn_norm = in[7];
    const float *rg_conv = in[8], *rg_conv_b = in[9], *rg_w_a = in[10], *rg_b_a = in[11], *rg_w_x = in[12], *rg_b_x = in[13], *rg_lambda = in[14], *w_out = in[15];
    const float *norm_cross = in[16], *norm_mem = in[17], *w_cq = in[18], *w_ckv = in[19], *w_co = in[20], *norm_moe = in[21], *w_router = in[22], *b_router = in[23];
    const float *w_gate = in[24], *b_gate = in[25], *w_up = in[26], *b_up = in[27], *w_down = in[28], *b_down = in[29], *norm_final = in[30];
    char* ws = (char*)d_ws; float* out = (float*)d_out;
    unsigned* ctl = (unsigned*)(ws + WS_CTL); unsigned* cnt = ctl + CW_CNT; float* ss1 = (float*)(ws + CTL_SS1); float* ss2 = (float*)(ws + CTL_SS2);
    float* BA = (float*)(ws + WS_BA); float* RSTD2 = (float*)(ws + WS_RSTD2);
    bf16 *WR_hi = (bf16*)(ws + WS_WR), *WR_lo = WR_hi + NE * D, *MEMN = (bf16*)(ws + WS_MEMN), *KM = (bf16*)(ws + WS_KM), *VT = (bf16*)(ws + WS_VT);
    int* TOKL = (int*)(ws + WS_TOKL); float* GATEL = (float*)(ws + WS_GATEL);
    bf16 *Win_t = (bf16*)(ws + WS_WIN), *Wout_t = (bf16*)(ws + WS_WOUT), *Wcq_t = (bf16*)(ws + WS_WCQ), *Wckv_t = (bf16*)(ws + WS_WCKV), *Wco_t = (bf16*)(ws + WS_WCO);
    bf16 *Wgu_t = (bf16*)(ws + WS_WGU), *Wd_t = (bf16*)(ws + WS_WD);
    bf16 *XN = (bf16*)(ws + WS_XN), *MIX = XN, *HB2 = XN, *PROJ = (bf16*)(ws + WS_PROJ), *HB = (bf16*)(ws + WS_HB), *Qb = (bf16*)(ws + WS_Q), *Pb = (bf16*)(ws + WS_P), *HID = (bf16*)(ws + WS_HID);
    bf16 *O2 = (bf16*)(ws + WS_O2), *Y = (bf16*)(ws + WS_Y); float* SC = (float*)(ws + WS_SC); float* ODN = (float*)(ws + WS_ODN); float* QKVN = (float*)(ws + WS_QKVN);

    (void)hipMemsetAsync(ws + WS_CTL, 0, CTL_BYTES, stream);
    const long MM = 1024L * 1024L;
    k_transpose<<<dim3(2048 / 32, 32, 1), 256, 0, stream>>>(w_in, NIN, Win_t, D, nullptr, 1, 0, 0, 0, 0);
    k_transpose<<<dim3(1024 / 32, 32, 1), 256, 0, stream>>>(w_in + 2056, NIN, Win_t + 2048 * 1024, D, nullptr, 1, 0, 0, 0, 0);
    k_transpose<<<dim3(32, 32, 1), 256, 0, stream>>>(w_out, D, Wout_t, D, nullptr, 1, 0, 0, 0, 0);
    k_transpose<<<dim3(32, 32, 1), 256, 0, stream>>>(w_cq, D, Wcq_t, D, norm_cross, 1, 0, 0, 0, 0);
    k_transpose<<<dim3(64, 32, 1), 256, 0, stream>>>(w_ckv, 2048, Wckv_t, D, nullptr, 1, 0, 0, 0, 0);
    k_transpose<<<dim3(32, 32, 1), 256, 0, stream>>>(w_co, D, Wco_t, D, nullptr, 1, 0, 0, 0, 0);
    k_router_w<<<(NE * D + 255) / 256, 256, 0, stream>>>(w_router, norm_moe, WR_hi, WR_lo);
    k_rmsnorm_rows<<<M / 4, 256, 0, stream>>>(x, norm_mix, XN, M, w_in + 2048, NIN, BA);
    k_rmsnorm_rows<<<NB * MEML / 4, 256, 0, stream>>>(mem, norm_mem, MEMN, NB * MEML, nullptr, 0, nullptr);
    GP p{};
    p = GP{}; p.A = XN; p.lda = D; p.Bt = Win_t; p.ldb = D; p.K = D; p.H0 = PROJ;
    k_gemm<0><<<dim3(NP / 64, M / 64, 1), 256, 0, stream>>>(p);
    p = GP{}; p.A = MEMN; p.lda = D; p.Bt = Wckv_t; p.ldb = D; p.K = D; p.H0 = KM; p.H1 = VT;
    k_gemm<1><<<dim3(2048 / 64, 1024 / 64, 1), 256, 0, stream>>>(p);
    k_dn_prep<<<dim3(M, 12), 128, 0, stream>>>(PROJ, dn_conv, QKVN);
    k_dn_rec<<<NB * 4 * 8, 256, 0, stream>>>(QKVN, BA, dn_a_log, dn_dt_bias, ODN);
    k_fin_dn<<<dim3(M, 4), 128, 0, stream>>>(ODN, PROJ, dn_norm, MIX);
    float* AA = out; float* BX = out + (size_t)M * 512;
    k_rg_prep<<<M, 512, 0, stream>>>(PROJ, rg_conv, rg_conv_b, rg_w_a, rg_b_a, rg_w_x, rg_b_x, rg_lambda, AA, BX);
    k_rg_scan<<<NB * 512 / 256, 256, 0, stream>>>(AA, BX, PROJ, MIX);
    k_transpose<<<dim3(4, 32, 256), 256, 0, stream>>>(w_gate, D, Wgu_t, D, norm_moe, 8, MM, 128, 2 * MM, 256 * 1024);
    k_transpose<<<dim3(4, 32, 256), 256, 0, stream>>>(w_up, D, Wgu_t + 128 * 1024, D, norm_moe, 8, MM, 128, 2 * MM, 256 * 1024);
    k_transpose<<<dim3(32, 32, 32), 256, 0, stream>>>(w_down, D, Wd_t, D, nullptr, 1, MM, 0, MM, 0);
    p = GP{}; p.A = MIX; p.lda = D; p.Bt = Wout_t; p.ldb = D; p.K = D; p.C0 = x; p.F0 = out; p.H0 = HB; p.F1 = ss1;
    k_gemm<2><<<dim3(D / 64, M / 64, 1), 256, 0, stream>>>(p);
    p = GP{}; p.A = HB; p.lda = D; p.Bt = Wcq_t; p.ldb = D; p.K = D; p.C0 = ss1; p.H0 = Qb;
    k_gemm<3><<<dim3(D / 64, M / 64, 1), 256, 0, stream>>>(p);
    p = GP{}; p.A = Qb; p.lda = D; p.Bt = KM; p.ldb = D; p.K = 256; p.F0 = SC;
    k_gemm<4><<<dim3(256 / 64, T / 64, 16), 256, 0, stream>>>(p);
    k_softmax<<<dim3(M, 4), 256, 0, stream>>>(SC, Pb);
    p = GP{}; p.A = Pb; p.lda = D; p.Bt = VT; p.ldb = D; p.K = 256; p.H0 = O2;
    k_gemm<5><<<dim3(256 / 64, T / 64, 16), 256, 0, stream>>>(p);
    p = GP{}; p.A = O2; p.lda = D; p.Bt = Wco_t; p.ldb = D; p.K = D; p.C0 = out; p.F0 = out; p.H0 = HB2; p.F1 = ss2;
    k_gemm<6><<<dim3(D / 64, M / 64, 1), 256, 0, stream>>>(p);
    k_route<<<M / 4, 256, 0, stream>>>(out, ss2, norm_moe, w_router, b_router, RSTD2, cnt, TOKL, GATEL);
    p = GP{}; p.A = HB2; p.lda = D; p.Bt = Wgu_t; p.ldb = D; p.K = D; p.cnt = cnt; p.I0 = TOKL; p.G0 = GATEL; p.C0 = RSTD2; p.C1 = b_gate; p.F1 = (float*)b_up; p.H0 = HID;
    k_gemm<7><<<dim3(1024 / 64, M / 64, NE), 256, 0, stream>>>(p);
    p = GP{}; p.A = HID; p.lda = D; p.Bt = Wd_t; p.ldb = D; p.K = D; p.cnt = cnt; p.I0 = TOKL; p.G0 = GATEL; p.C0 = b_down; p.H0 = Y;
    k_gemm<8><<<dim3(1024 / 64, M / 64, NE), 256, 0, stream>>>(p);
    k_combine<<<M / 4, 256, 0, stream>>>(out, Y, norm_final);
}
```

```cpp
#include <hip/hip_runtime.h>
#include <cstdio>
#include <cstdint>

typedef unsigned short bf16;
__device__ __forceinline__ float bf2f(bf16 v) { return __builtin_bit_cast(float, (unsigned)v << 16); }
__device__ __forceinline__ bf16 f2bf(float f) { unsigned u = __builtin_bit_cast(unsigned, f); return (bf16)((u + 0x7fffu + ((u >> 16) & 1u)) >> 16); }

constexpr int NB = 4, T = 4096, D = 1024, M = NB * T, NIN = 3080, NP = 3072, MEML = 256;
constexpr int NE = 32, TOPK = 4;
constexpr float EPS = 1e-6f;
constexpr int PC_Q = 0, PC_K = 512, PC_V = 1024, PC_Z = 1536, PC_RX = 2048, PC_RY = 2560;

constexpr size_t MiB = 1u << 20;
constexpr size_t WS_CTL = 0, CTL_BYTES = 1 * MiB;
constexpr int CW_CNT = 512;
constexpr size_t CTL_SS1 = 128 * 1024, CTL_SS2 = 192 * 1024;
constexpr size_t WS_BA = 1 * MiB, WS_RSTD2 = 1 * MiB + 512 * 1024, WS_DEC = 1 * MiB + 768 * 1024;
constexpr size_t WS_RGW = 2 * MiB, WS_WR = 2 * MiB + 512 * 1024, WS_MEMN = 3 * MiB, WS_KM = 5 * MiB, WS_VT = 7 * MiB;
constexpr size_t WS_RGSUM = 9 * MiB, WS_TOKL = 10 * MiB, WS_GATEL = 12 * MiB, WS_RSL = 14 * MiB;
constexpr size_t WS_WIN = 16 * MiB, WS_WOUT = 22 * MiB, WS_WCQ = 24 * MiB, WS_WCKV = 26 * MiB, WS_WCO = 30 * MiB;
constexpr size_t WS_WGU = 32 * MiB, WS_WD = 160 * MiB;
constexpr size_t WS_XN = 224 * MiB;
constexpr size_t WS_PROJ = 256 * MiB;
constexpr size_t WS_HB = 256 * MiB, WS_Q = 288 * MiB, WS_P = 320 * MiB, WS_HID = 256 * MiB;
constexpr size_t WS_DN = 352 * MiB;
constexpr size_t WS_O2 = 352 * MiB, WS_SC = 384 * MiB  ;
constexpr size_t WS_ODN = 442 * MiB, WS_HLOC = 474 * MiB, WS_CP = 490 * MiB, WS_END = 506 * MiB;
constexpr size_t WS_Y = 32 * MiB;
constexpr size_t WS_QKVN = 32 * MiB;

__global__ void k_transpose(const float* W, int ldn, bf16* out, int K, const float* gain,
                            int zb, long in_s1, long in_s2, long out_s1, long out_s2) {
    __shared__ float tile[32][33];
    const int z = blockIdx.z; W += (z / zb) * in_s1 + (z % zb) * in_s2; out += (z / zb) * out_s1 + (z % zb) * out_s2;
    const int r0 = blockIdx.x * 32, k0 = blockIdx.y * 32, tx = threadIdx.x & 31, ty = threadIdx.x >> 5;
    for (int i = ty; i < 32; i += 8) { const int k = k0 + i; tile[i][tx] = W[(size_t)k * ldn + r0 + tx] * (gain ? gain[k] : 1.f); }
    __syncthreads();
    for (int i = ty; i < 32; i += 8) out[(size_t)(r0 + i) * K + k0 + tx] = f2bf(tile[tx][i]);
}
__global__ void k_router_w(const float* wr, const float* g, bf16* hi, bf16* lo) {
    const int i = blockIdx.x * blockDim.x + threadIdx.x; if (i >= NE * D) return;
    const int e = i / D, k = i % D; const float v = wr[k * NE + e] * g[k]; const bf16 h = f2bf(v); hi[i] = h; lo[i] = f2bf(v - bf2f(h));
}

__device__ __forceinline__ float wave_sum(float v) {
#pragma unroll
    for (int o = 1; o < 64; o <<= 1) v += __shfl_xor(v, o);
    return v;
}
__global__ void k_rmsnorm_rows(const float* x, const float* g, bf16* out, int nrows, const float* w8, int ldw, float* ba) {
    const int row = blockIdx.x * (blockDim.x >> 6) + (threadIdx.x >> 6), lane = threadIdx.x & 63; if (row >= nrows) return;
    const float* xr = x + (size_t)row * D; float v[16]; float s = 0.f;
#pragma unroll
    for (int j = 0; j < 16; ++j) { v[j] = xr[lane + 64 * j]; s += v[j] * v[j]; }
    const float rstd = rsqrtf(wave_sum(s) * (1.f / D) + EPS);
    float acc[8];
#pragma unroll
    for (int q = 0; q < 8; ++q) acc[q] = 0.f;
#pragma unroll
    for (int j = 0; j < 16; ++j) { const int k = lane + 64 * j; const float u = v[j] * rstd * g[k]; out[(size_t)row * D + k] = f2bf(u);
        if (w8) {
#pragma unroll
            for (int q = 0; q < 8; ++q) acc[q] += u * w8[(size_t)k * ldw + q]; } }
    if (w8) {
#pragma unroll
        for (int q = 0; q < 8; ++q) { const float t = wave_sum(acc[q]); if (lane == 0) ba[(size_t)row * 8 + q] = t; } }
}

__device__ __forceinline__ float sigmoidf_(float x) { return 1.f / (1.f + __expf(-x)); }
__device__ __forceinline__ float siluf_(float x) { return x * sigmoidf_(x); }
__device__ __forceinline__ float softplusf_(float x) { return fmaxf(x, 0.f) + log1pf(__expf(-fabsf(x))); }
__device__ __forceinline__ float gelu_tanh(float x) { const float u = 0.7978845608028654f * (x + 0.044715f * x * x * x); return 0.5f * x * (1.f + tanhf(u)); }
__device__ __forceinline__ float ffn_act(float gt, float up) { gt = fminf(gt, 7.f); up = fminf(fmaxf(up, -7.f), 7.f); return (up + 1.f) * (gt * sigmoidf_(1.702f * gt)); }

struct GP {
    const bf16* A; int lda; const bf16* Bt; int ldb; int K;
    float* F0; float* F1; bf16* H0; bf16* H1; const float* C0; const float* C1; const int* I0; const float* G0; const unsigned* cnt;
};
template <int MODE> __global__ void __launch_bounds__(256) k_gemm(GP p) {
    __shared__ float As[16][65], Bs[16][65], Bs2[16][65];
    __shared__ int rowsrc[64]; __shared__ int rowaux[64]; __shared__ float rowg[64];
    const int tid = threadIdx.x, tx = tid & 15, ty = tid >> 4;
    int row0 = blockIdx.y * 64, col0 = blockIdx.x * 64; const bf16* A = p.A; const bf16* Bt = p.Bt;
    int e = 0, nvalid = 64, slot0 = 0;
    if (MODE == 4) { const int b = blockIdx.z >> 2, h = blockIdx.z & 3; row0 += b * T; A += h * 256; Bt += (size_t)(b * 256) * 1024 + h * 256; }
    if (MODE == 5) { const int b = blockIdx.z >> 2, h = blockIdx.z & 3; row0 += b * T; A += h * 256; Bt += (size_t)(h * 256) * 1024 + b * 256; }
    if (MODE == 7 || MODE == 8) {
        e = blockIdx.z; const int cnt = (int)p.cnt[e]; if (row0 >= cnt) return; nvalid = min(64, cnt - row0);
        for (int i = 0; i < e; ++i) slot0 += (((int)p.cnt[i] + 255) / 256) * 256;
        if (tid < 64) { const int pos = row0 + tid; const int v = pos < cnt ? p.I0[e * M + pos] : 0; rowaux[tid] = v; rowsrc[tid] = (MODE == 7) ? (v >> 2) : (slot0 + pos); rowg[tid] = pos < cnt ? p.G0[e * M + pos] : 0.f; }
        Bt += (size_t)e * (MODE == 7 ? 2048 : 1024) * 1024;
        __syncthreads();
    }
    float acc[4][4], acc2[4][4];
#pragma unroll
    for (int i = 0; i < 4; ++i)
#pragma unroll
        for (int j = 0; j < 4; ++j) { acc[i][j] = 0.f; acc2[i][j] = 0.f; }
    for (int k0 = 0; k0 < p.K; k0 += 16) {
        for (int i = tid; i < 64 * 16; i += 256) { const int r = i >> 4, k = i & 15;
            const int ar = (MODE == 7 || MODE == 8) ? rowsrc[r] : row0 + r;
            As[k][r] = bf2f(A[(size_t)ar * p.lda + k0 + k]);
            int bc = col0 + r;
            if (MODE == 7) { const int c = col0 + r; bc = (c >> 7) * 256 + (c & 127); Bs2[k][r] = bf2f(Bt[(size_t)(bc + 128) * p.ldb + k0 + k]); }
            Bs[k][r] = bf2f(Bt[(size_t)bc * p.ldb + k0 + k]); }
        __syncthreads();
#pragma unroll
        for (int k = 0; k < 16; ++k) { float a[4], b[4], b2[4];
#pragma unroll
            for (int i = 0; i < 4; ++i) { a[i] = As[k][ty * 4 + i]; b[i] = Bs[k][tx * 4 + i]; if (MODE == 7) b2[i] = Bs2[k][tx * 4 + i]; }
#pragma unroll
            for (int i = 0; i < 4; ++i)
#pragma unroll
                for (int j = 0; j < 4; ++j) { acc[i][j] += a[i] * b[j]; if (MODE == 7) acc2[i][j] += a[i] * b2[j]; } }
        __syncthreads();
    }
#pragma unroll
    for (int i = 0; i < 4; ++i) {
        const int rl = ty * 4 + i, row = row0 + rl; float hsq = 0.f;
#pragma unroll
        for (int j = 0; j < 4; ++j) { const int col = col0 + tx * 4 + j; const float v = acc[i][j];
            if (MODE == 0) p.H0[(size_t)row * NP + col] = f2bf(v);
            if (MODE == 1) { if (col < 1024) p.H0[(size_t)row * 1024 + col] = f2bf(v); else p.H1[(size_t)(col - 1024) * 1024 + row] = f2bf(v); }
            if (MODE == 2 || MODE == 6) { const size_t o = (size_t)row * D + col; const float h = p.C0[o] + v; p.F0[o] = h; p.H0[o] = f2bf(h); hsq += h * h; }
            if (MODE == 3) { const float rs = rsqrtf(p.C0[row] * (1.f / D) + EPS); p.H0[(size_t)row * D + col] = f2bf(v * rs * 0.0625f); }
            if (MODE == 4) { const int h = blockIdx.z & 3; p.F0[(size_t)row * 1024 + h * 256 + col] = v; }
            if (MODE == 5) { const int h = blockIdx.z & 3; p.H0[(size_t)row * 1024 + h * 256 + col] = f2bf(v); }
            if (MODE == 7) { if (rl < nvalid) { const float rs = p.C0[rowaux[rl] >> 2]; const float gt = v * rs + p.C1[e * 1024 + col], up = acc2[i][j] * rs + p.F1[e * 1024 + col];
                    p.H0[(size_t)(slot0 + row) * 1024 + col] = f2bf(ffn_act(gt, up)); } }
            if (MODE == 8) { if (rl < nvalid) p.H0[(size_t)rowaux[rl] * 1024 + col] = f2bf((v + p.C0[e * 1024 + col]) * rowg[rl]); }
        }
        if (MODE == 2 || MODE == 6) atomicAdd(&p.F1[row], hsq);
    }
}

__global__ void k_dn_prep(const bf16* proj, const float* conv, float* qkvn) {
    const int row = blockIdx.x, t = row % T, c = blockIdx.y * 128 + threadIdx.x;
    float s = 0.f;
#pragma unroll
    for (int j = 0; j < 4; ++j) { const int tt = t + j - 3; if (tt >= 0) s += conv[j * 1536 + c] * bf2f(proj[(size_t)(row + j - 3) * NP + c]); }
    s = siluf_(s);
    if (blockIdx.y < 8) { __shared__ float red[2]; float q = wave_sum(s * s); if ((threadIdx.x & 63) == 0) red[threadIdx.x >> 6] = q; __syncthreads(); q = red[0] + red[1]; s *= rsqrtf(q + EPS); }
    qkvn[(size_t)row * 1536 + c] = s;
}
__global__ void __launch_bounds__(256) k_dn_rec(const float* qkvn, const float* ba, const float* a_log, const float* dt_bias, float* odn) {
    const int sl = blockIdx.x & 7, h = (blockIdx.x >> 3) & 3, b = blockIdx.x >> 5, tid = threadIdx.x, dvl = tid & 15, part = tid >> 4;
    __shared__ float qs[128], ks[128], red[16][17], red2[16][17];
    float S[8];
#pragma unroll
    for (int i = 0; i < 8; ++i) S[i] = 0.f;
    const float Aexp = __expf(a_log[h]), dtb = dt_bias[h], scale = 0.08838834764831845f;
    for (int t = 0; t < T; ++t) {
        const size_t row = (size_t)b * T + t;
        if (tid < 128) { qs[tid] = qkvn[row * 1536 + h * 128 + tid]; ks[tid] = qkvn[row * 1536 + 512 + h * 128 + tid]; }
        const float v = qkvn[row * 1536 + 1024 + h * 128 + sl * 16 + dvl];
        const float beta = sigmoidf_(ba[row * 8 + h]), g = -Aexp * softplusf_(ba[row * 8 + 4 + h] + dtb), eg = __expf(g);
        __syncthreads();
        float pk = 0.f;
#pragma unroll
        for (int i = 0; i < 8; ++i) pk += ks[part * 8 + i] * S[i];
        red[part][dvl] = pk; __syncthreads();
        float kS = 0.f;
#pragma unroll
        for (int i = 0; i < 16; ++i) kS += red[i][dvl];
        const float vn = beta * (v - eg * kS);
        float po = 0.f;
#pragma unroll
        for (int i = 0; i < 8; ++i) { S[i] = eg * S[i] + ks[part * 8 + i] * vn; po += qs[part * 8 + i] * S[i]; }
        red2[part][dvl] = po; __syncthreads();
        if (part == 0) { float o = 0.f;
#pragma unroll
            for (int i = 0; i < 16; ++i) o += red2[i][dvl];
            odn[row * 512 + h * 128 + sl * 16 + dvl] = o * scale; }
    }
}
__global__ void k_fin_dn(const float* odn, const bf16* proj, const float* dn_norm, bf16* mix) {
    const int row = blockIdx.x, h = blockIdx.y, dv = threadIdx.x; __shared__ float red[2];
    const float o = odn[(size_t)row * 512 + h * 128 + dv]; float q = wave_sum(o * o); if ((dv & 63) == 0) red[dv >> 6] = q; __syncthreads();
    const float rs = rsqrtf((red[0] + red[1]) * (1.f / 128) + EPS);
    mix[(size_t)row * D + h * 128 + dv] = f2bf(o * rs * dn_norm[dv] * siluf_(bf2f(proj[(size_t)row * NP + PC_Z + h * 128 + dv])));
}
__global__ void __launch_bounds__(512) k_rg_prep(const bf16* proj, const float* conv, const float* convb, const float* w_a, const float* b_a,
                                                   const float* w_x, const float* b_x, const float* lam, float* aa, float* bx) {
    const int row = blockIdx.x, t = row % T, ch = threadIdx.x; __shared__ float xr[512];
    float s = convb[ch];
#pragma unroll
    for (int j = 0; j < 4; ++j) { const int tt = t + j - 3; if (tt >= 0) s += conv[j * 512 + ch] * bf2f(proj[(size_t)(row + j - 3) * NP + PC_RX + ch]); }
    xr[ch] = s; __syncthreads();
    const int nb = ch >> 7, o = ch & 127; float ra = b_a[ch], rx_ = b_x[ch];
    for (int i = 0; i < 128; ++i) { const float xv = xr[nb * 128 + i]; ra += xv * w_a[(nb * 128 + i) * 128 + o]; rx_ += xv * w_x[(nb * 128 + i) * 128 + o]; }
    const float r = sigmoidf_(ra), ig = sigmoidf_(rx_);
    const float log_a = 8.f * r * (-softplusf_(-lam[ch])); const float a = __expf(log_a);
    float mult = sqrtf(fmaxf(-expm1f(2.f * log_a), 0.f)); if (t == 0) mult = 1.f;
    aa[(size_t)row * 512 + ch] = a; bx[(size_t)row * 512 + ch] = mult * (ig * s);
}
__global__ void k_rg_scan(const float* aa, const float* bx, const bf16* proj, bf16* mix) {
    const int i = blockIdx.x * blockDim.x + threadIdx.x, b = i >> 9, ch = i & 511; float h = 0.f;
    for (int t0 = 0; t0 < T; t0 += 8) { float a[8], x[8], y[8];
#pragma unroll
        for (int j = 0; j < 8; ++j) { const size_t row = (size_t)b * T + t0 + j; a[j] = aa[row * 512 + ch]; x[j] = bx[row * 512 + ch]; y[j] = bf2f(proj[row * NP + PC_RY + ch]); }
#pragma unroll
        for (int j = 0; j < 8; ++j) { h = a[j] * h + x[j]; mix[((size_t)b * T + t0 + j) * D + 512 + ch] = f2bf(h * gelu_tanh(y[j])); } }
}
__global__ void k_softmax(const float* sc, bf16* p) {
    const int row = blockIdx.x, h = blockIdx.y, k = threadIdx.x; __shared__ float red[4];
    const float s = sc[(size_t)row * 1024 + h * 256 + k]; float m = s;
#pragma unroll
    for (int o = 1; o < 64; o <<= 1) m = fmaxf(m, __shfl_xor(m, o));
    if ((k & 63) == 0) red[k >> 6] = m; __syncthreads(); m = fmaxf(fmaxf(red[0], red[1]), fmaxf(red[2], red[3])); __syncthreads();
    const float e = __expf(s - m); float q = wave_sum(e); if ((k & 63) == 0) red[k >> 6] = q; __syncthreads(); q = red[0] + red[1] + red[2] + red[3];
    p[(size_t)row * 1024 + h * 256 + k] = f2bf(e / q);
}
__global__ void k_route(const float* hres, const float* ss, const float* g, const float* wr, const float* br, float* rstd2, unsigned* cnt, int* tokl, float* gatel, float* rsl) {
    const int row = blockIdx.x * (blockDim.x >> 6) + (threadIdx.x >> 6), lane = threadIdx.x & 63, e = lane & 31, half = lane >> 5;
    const float rs = rsqrtf(ss[row] * (1.f / D) + EPS); float acc = 0.f;
    for (int k = half * 512; k < half * 512 + 512; ++k) acc += hres[(size_t)row * D + k] * g[k] * wr[k * NE + e];
    acc += __shfl_xor(acc, 32); float logit = acc * rs + br[e];
    float tl[4]; int te[4];
#pragma unroll
    for (int q = 0; q < 4; ++q) { float m = logit; int mi = e;
#pragma unroll
        for (int o = 1; o < 32; o <<= 1) { const float om = __shfl_xor(m, o); const int oi = __shfl_xor(mi, o); if (om > m || (om == m && oi < mi)) { m = om; mi = oi; } }
        tl[q] = m; te[q] = mi; if (e == mi) logit = -3.0e38f; }
    const float e1 = __expf(tl[1] - tl[0]), e2 = __expf(tl[2] - tl[0]), e3 = __expf(tl[3] - tl[0]), inv = 1.f / (1.f + e1 + e2 + e3);
    const float gt[4] = {inv, e1 * inv, e2 * inv, e3 * inv};
    if (lane < 4) { const int ex = lane == 0 ? te[0] : lane == 1 ? te[1] : lane == 2 ? te[2] : te[3]; const float gv = lane == 0 ? gt[0] : lane == 1 ? gt[1] : lane == 2 ? gt[2] : gt[3];
        const unsigned pos = atomicAdd(&cnt[ex], 1u); tokl[ex * M + pos] = row * 4 + lane; gatel[ex * M + pos] = gv; rsl[ex * M + pos] = rs; }
    if (lane == 0) rstd2[row] = rs;
}
__global__ void k_combine(float* out, const bf16* y, const float* g) {
    const int row = blockIdx.x * (blockDim.x >> 6) + (threadIdx.x >> 6), lane = threadIdx.x & 63; float v[16]; float s = 0.f;
#pragma unroll
    for (int j = 0; j < 16; ++j) { const int c = lane + 64 * j; float h = out[(size_t)row * D + c];
#pragma unroll
        for (int k = 0; k < 4; ++k) h += bf2f(y[((size_t)row * 4 + k) * D + c]);
        v[j] = h; s += h * h; }
    const float rs = rsqrtf(wave_sum(s) * (1.f / D) + EPS);
#pragma unroll
    for (int j = 0; j < 16; ++j) { const int c = lane + 64 * j; out[(size_t)row * D + c] = v[j] * rs * g[c]; }
}

namespace pg8 {
#define PG8_LAS __attribute__((address_space(3)))
typedef unsigned short bf16_t;
typedef short bf16x8 __attribute__((ext_vector_type(8)));
typedef float f32x4 __attribute__((ext_vector_type(4)));
typedef unsigned u32x4 __attribute__((ext_vector_type(4)));
constexpr int BM = 256, BK = 64, HALF = 128, HTB = HALF * BK * 2, STAGE_BYTES = 8 * HTB, NXCD = 8, WGM = 8;

__host__ __device__ __forceinline__ int lds_byte(int r, int c) { const int st = (r >> 4) * 2 + (c >> 5), rr = r & 15, cc = c & 31, ob = rr * 64 + cc * 2; return st * 1024 + (ob ^ (((ob >> 9) & 1) << 5)); }
__host__ __device__ __forceinline__ void stage_rc(int b, int& R, int& C) { const int st = b / 1024, sb = b % 1024, swz = sb ^ (((sb >> 9) & 1) << 5); R = (st >> 1) * 16 + swz / 64; C = (st & 1) * 32 + (swz % 64) / 2; }
__host__ __device__ __forceinline__ int perm32(int rho) { const int n = rho >> 4, i = rho & 15; return 8 * (i >> 2) + 4 * n + (i & 3); }

struct Unit { int pm, pn; const char* a; const char* b; int e, j; };
struct Gemm { int lda, ldb, K; };

struct StaticOrder {
    int nM, nN, nwg, G, c; const char* A; const char* Bt; size_t astep, bstep;
    __device__ void init(const void* A_, const void* Bt_, int M, int N, int lda, int ldb, int G_, int c_) { nM = M / BM; nN = N / BM; nwg = nM * nN; G = G_; c = c_; A = (const char*)A_; Bt = (const char*)Bt_; astep = (size_t)BM * lda * 2; bstep = (size_t)BM * ldb * 2; }
    __device__ bool next(int i, Unit& u) const {
        const long L = (long)i * G + c; if (L >= nwg) return false;
        int wgid = (int)L; { const int q = nwg / NXCD, r = nwg % NXCD, xcd = wgid % NXCD, off = wgid / NXCD; wgid = (xcd < r ? xcd * (q + 1) : r * (q + 1) + (xcd - r) * q) + off; }
        const int nig = WGM * nN, gid = wgid / nig, fm = gid * WGM, gsz = (nM - fm) < WGM ? (nM - fm) : WGM;
        u.pm = fm + ((wgid % nig) % gsz); u.pn = (wgid % nig) / gsz; u.a = A + (size_t)u.pm * astep; u.b = Bt + (size_t)u.pn * bstep; u.e = 0; u.j = 0; return true;
    }
    __device__ __forceinline__ int arow(const Unit&, int) const { return 0; }
};
struct OneUnit {
    Unit u0;
    __device__ bool next(int i, Unit& u) const { if (i != 0) return false; u = u0; return true; }
    __device__ __forceinline__ int arow(const Unit&, int) const { return 0; }
};

__device__ __forceinline__ unsigned cvt_pk_bf16(float lo, float hi) { unsigned r; asm volatile("v_cvt_pk_bf16_f32 %0, %1, %2" : "=v"(r) : "v"(lo), "v"(hi)); return r; }

typedef f32x4 Acc[2][2][4][2];

template <class Epi, class Sched, bool ALIGN_EPI, bool GATHER>
__device__ __forceinline__ void gemm_phase(PG8_LAS unsigned char* lds, const Gemm g, const Sched& S, const Epi& E) {
    const int tid = threadIdx.x, wid = __builtin_amdgcn_readfirstlane(tid >> 6), lane = tid & 63, wr = wid >> 2, wc = wid & 3, fr = lane & 15, fq = lane >> 4;
    const int nt = g.K / BK;
    unsigned voffA[2], voffB[2]; int RA[2], CA[2];
#pragma unroll
    for (int i = 0; i < 2; ++i) { int R, C; stage_rc(tid * 16 + i * 8192, R, C); const int Rb = (R & ~31) + perm32(R & 31);
        voffA[i] = (unsigned)(R * g.lda + C) * 2u; voffB[i] = (unsigned)(Rb * g.ldb + C) * 2u; RA[i] = R; CA[i] = C; }
    const size_t kstep = (size_t)(BK * 2);
    const size_t hstepA = (size_t)HALF * g.lda * 2, hstepB = (size_t)HALF * g.ldb * 2;
    const unsigned ldsw = (unsigned)wid * 1024u;
    const int aoff = lds_byte(wr * 64 + fr, fq * 8), boff = lds_byte(wc * 32 + fr, fq * 8);
    unsigned aoC[2][2], aoN[2][2];
#define PG8_SA(b, h) (((b) * 2 + (h)) * HTB)
#define PG8_SB(b, h) ((4 + (b) * 2 + (h)) * HTB)
#define PG8_STAGE(bufoff, gbase, voff) do { _Pragma("unroll") for (int _i = 0; _i < 2; ++_i) \
        __builtin_amdgcn_global_load_lds((const unsigned*)((const char*)(gbase) + (voff)[_i]), (PG8_LAS unsigned*)(lds + (bufoff) + ldsw + _i * 8192), 16, 0, 0); } while (0)
#define PG8_STAGE_A(bufoff, gbase, h, nx) do { if constexpr (GATHER) { unsigned _v[2]; _v[0] = (nx) ? aoN[h][0] : aoC[h][0]; _v[1] = (nx) ? aoN[h][1] : aoC[h][1]; PG8_STAGE(bufoff, gbase, _v); } \
        else { PG8_STAGE(bufoff, (gbase) + (h) * hstepA, voffA); } } while (0)
#define PG8_GOFF(dst, un) do { _Pragma("unroll") for (int _h = 0; _h < 2; ++_h) _Pragma("unroll") for (int _i = 0; _i < 2; ++_i) \
        dst[_h][_i] = (unsigned)(S.arow(un, _h * HALF + RA[_i]) * g.lda + CA[_i]) * 2u; } while (0)
#define PG8_LDA(dst, b, h) do { _Pragma("unroll") for (int m = 0; m < 4; ++m) _Pragma("unroll") for (int k = 0; k < 2; ++k) dst[m][k] = *(const PG8_LAS bf16x8*)(lds + PG8_SA(b, h) + aoff + m * 2048 + k * 1024); } while (0)
#define PG8_LDB(dst, b, h) do { _Pragma("unroll") for (int n = 0; n < 2; ++n) _Pragma("unroll") for (int k = 0; k < 2; ++k) dst[n][k] = *(const PG8_LAS bf16x8*)(lds + PG8_SB(b, h) + boff + n * 2048 + k * 1024); } while (0)
#define PG8_MMA(ai, bj, At, Bt) do { __builtin_amdgcn_s_setprio(1); _Pragma("unroll") for (int m = 0; m < 4; ++m) _Pragma("unroll") for (int n = 0; n < 2; ++n) _Pragma("unroll") for (int k = 0; k < 2; ++k) \
        acc[ai][bj][m][n] = __builtin_amdgcn_mfma_f32_16x16x32_bf16(Bt[n][k], At[m][k], acc[ai][bj][m][n], 0, 0, 0); __builtin_amdgcn_s_setprio(0); } while (0)
#define PG8_WAIT_V(n) asm volatile("s_waitcnt vmcnt(" #n ")" ::: "memory")
#define PG8_WAIT_L(n) asm volatile("s_waitcnt lgkmcnt(" #n ")" ::: "memory")
#define PG8_BAR __builtin_amdgcn_s_barrier()
#define PG8_SCHED __builtin_amdgcn_sched_barrier(0)
    Unit cur, nxt; int ui = 0;
    if (!S.next(0, cur)) return;
    if constexpr (GATHER) { PG8_GOFF(aoC, cur); }
    Acc acc;
#pragma unroll
    for (int a = 0; a < 2; ++a)
#pragma unroll
        for (int b = 0; b < 2; ++b)
#pragma unroll
            for (int m = 0; m < 4; ++m)
#pragma unroll
                for (int n = 0; n < 2; ++n) acc[a][b][m][n] = (f32x4){0.f, 0.f, 0.f, 0.f};
    bf16x8 At[4][2], B0[2][2], B1[2][2];
    const char* cA = cur.a; const char* cB = cur.b;
    PG8_STAGE(PG8_SB(0, 0), cB, voffB); PG8_STAGE(PG8_SB(0, 1), cB + hstepB, voffB); PG8_STAGE_A(PG8_SA(0, 0), cA, 0, false); PG8_STAGE_A(PG8_SA(0, 1), cA, 1, false);
    if (wr == 1) PG8_BAR;
    PG8_WAIT_V(2); PG8_BAR;
    PG8_STAGE(PG8_SB(1, 0), cB + kstep, voffB); PG8_STAGE_A(PG8_SA(1, 0), cA + kstep, 0, false); PG8_STAGE(PG8_SB(1, 1), cB + hstepB + kstep, voffB);
    PG8_WAIT_V(6); PG8_BAR;
    for (;;) {
        const bool has_next = S.next(ui + 1, nxt);
        if constexpr (GATHER) { if (has_next) { PG8_GOFF(aoN, nxt); } else {
#pragma unroll
            for (int _h = 0; _h < 2; ++_h) { aoN[_h][0] = aoC[_h][0]; aoN[_h][1] = aoC[_h][1]; } } }
        const char* nA = has_next ? nxt.a : cA; const char* nB = has_next ? nxt.b : cB;
        for (int t = 0; t < nt; t += 2) {
            const bool last = (t == nt - 2);
            const char* a1 = cA + (size_t)(t + 1) * kstep;
            const char* a2 = last ? nA : cA + (size_t)(t + 2) * kstep; const char* b2 = last ? nB : cB + (size_t)(t + 2) * kstep;
            const char* a3 = a2 + kstep; const char* b3 = b2 + kstep;
            PG8_LDB(B0, 0, 0); PG8_LDB(B1, 0, 1); PG8_SCHED; PG8_LDA(At, 0, 0); PG8_STAGE_A(PG8_SA(1, 1), a1, 1, false);
            PG8_WAIT_V(8); PG8_WAIT_L(0); PG8_BAR; PG8_MMA(0, 0, At, B0); PG8_MMA(0, 1, At, B1); PG8_BAR; PG8_SCHED;
            PG8_LDA(At, 0, 1); PG8_STAGE(PG8_SB(0, 0), b2, voffB); PG8_STAGE(PG8_SB(0, 1), b2 + hstepB, voffB); PG8_STAGE_A(PG8_SA(0, 0), a2, 0, last);
            PG8_WAIT_V(8); PG8_WAIT_L(0); PG8_BAR; PG8_MMA(1, 0, At, B0); PG8_MMA(1, 1, At, B1); PG8_BAR; PG8_SCHED;
            PG8_LDB(B0, 1, 0); PG8_LDB(B1, 1, 1); PG8_SCHED; PG8_LDA(At, 1, 0); PG8_STAGE_A(PG8_SA(0, 1), a2, 1, last);
            PG8_WAIT_V(8); PG8_WAIT_L(0); PG8_BAR; PG8_MMA(0, 0, At, B0); PG8_MMA(0, 1, At, B1); PG8_BAR; PG8_SCHED;
            PG8_LDA(At, 1, 1); PG8_STAGE(PG8_SB(1, 0), b3, voffB); PG8_STAGE(PG8_SB(1, 1), b3 + hstepB, voffB); PG8_STAGE_A(PG8_SA(1, 0), a3, 0, last);
            PG8_WAIT_V(8); PG8_WAIT_L(0); PG8_BAR; PG8_MMA(1, 0, At, B0); PG8_MMA(1, 1, At, B1); PG8_BAR; PG8_SCHED;
        }
        if constexpr (ALIGN_EPI) { if (wr == 0) PG8_BAR; }
        if constexpr (!Epi::AFTER_DRAIN) { E(acc, cur, wr, wc, fr, fq); }
        if (!has_next) break;
#pragma unroll
        for (int a = 0; a < 2; ++a)
#pragma unroll
            for (int b = 0; b < 2; ++b)
#pragma unroll
                for (int m = 0; m < 4; ++m)
#pragma unroll
                    for (int n = 0; n < 2; ++n) acc[a][b][m][n] = (f32x4){0.f, 0.f, 0.f, 0.f};
        cur = nxt; cA = nA; cB = nB; ++ui;
        if constexpr (GATHER) {
#pragma unroll
            for (int _h = 0; _h < 2; ++_h) { aoC[_h][0] = aoN[_h][0]; aoC[_h][1] = aoN[_h][1]; } }
        if constexpr (ALIGN_EPI) { if (wr == 1) PG8_BAR; }
    }
    PG8_WAIT_V(0);
    if constexpr (!ALIGN_EPI) { if (wr == 0) PG8_BAR; }
    PG8_BAR;
    if constexpr (Epi::AFTER_DRAIN) { E.fused(acc, cur, wr, wc, fr, fq, lds); }
#undef PG8_SA
#undef PG8_SB
#undef PG8_STAGE
#undef PG8_STAGE_A
#undef PG8_GOFF
#undef PG8_LDA
#undef PG8_LDB
#undef PG8_MMA
#undef PG8_WAIT_V
#undef PG8_WAIT_L
#undef PG8_BAR
#undef PG8_SCHED
}

struct EpiStore {
    static constexpr bool AFTER_DRAIN = false; bf16_t* O; int ldc;
    __device__ __forceinline__ void operator()(const Acc& acc, const Unit& u, int wr, int wc, int fr, int fq) const {
        const int row0 = u.pm * BM + wr * 64 + fr, col0 = u.pn * BM + wc * 32 + 8 * fq;
#pragma unroll
        for (int ai = 0; ai < 2; ++ai)
#pragma unroll
            for (int m = 0; m < 4; ++m) { bf16_t* rowp = O + (size_t)(row0 + ai * HALF + m * 16) * ldc + col0;
#pragma unroll
                for (int bj = 0; bj < 2; ++bj) { const f32x4 v0 = acc[ai][bj][m][0], v1 = acc[ai][bj][m][1];
                    u32x4 w; w.x = cvt_pk_bf16(v0[0], v0[1]); w.y = cvt_pk_bf16(v0[2], v0[3]); w.z = cvt_pk_bf16(v1[0], v1[1]); w.w = cvt_pk_bf16(v1[2], v1[3]);
                    *(u32x4*)(rowp + bj * HALF) = w; } }
    }
};
struct EpiResid {
    static constexpr bool AFTER_DRAIN = false; const float* R; float* H; bf16_t* HB; float* SS;
    __device__ __forceinline__ void operator()(const Acc& acc, const Unit& u, int wr, int wc, int fr, int fq) const {
        const int row0 = u.pm * BM + wr * 64 + fr, col0 = u.pn * BM + wc * 32 + 8 * fq;
#pragma unroll
        for (int ai = 0; ai < 2; ++ai)
#pragma unroll
            for (int m = 0; m < 4; ++m) { const int row = row0 + ai * HALF + m * 16; const size_t off = (size_t)row * D + col0; float sq = 0.f;
#pragma unroll
                for (int bj = 0; bj < 2; ++bj) { const f32x4 r0 = *(const f32x4*)(R + off + bj * HALF), r1 = *(const f32x4*)(R + off + bj * HALF + 4);
                    const f32x4 v0 = acc[ai][bj][m][0] + r0, v1 = acc[ai][bj][m][1] + r1;
                    *(f32x4*)(H + off + bj * HALF) = v0; *(f32x4*)(H + off + bj * HALF + 4) = v1;
                    u32x4 w; w.x = cvt_pk_bf16(v0[0], v0[1]); w.y = cvt_pk_bf16(v0[2], v0[3]); w.z = cvt_pk_bf16(v1[0], v1[1]); w.w = cvt_pk_bf16(v1[2], v1[3]);
                    *(u32x4*)(HB + off + bj * HALF) = w;
                    sq += (v0[0] * v0[0] + v0[1] * v0[1]) + (v0[2] * v0[2] + v0[3] * v0[3]) + (v1[0] * v1[0] + v1[1] * v1[1]) + (v1[2] * v1[2] + v1[3] * v1[3]); }
                sq += __shfl_xor(sq, 16); sq += __shfl_xor(sq, 32);
                if (fq == 0) atomicAdd(SS + row, sq); }
    }
};
struct EpiRowScale {
    static constexpr bool AFTER_DRAIN = false; bf16_t* O; const float* SS; float s;
    __device__ __forceinline__ void operator()(const Acc& acc, const Unit& u, int wr, int wc, int fr, int fq) const {
        const int row0 = u.pm * BM + wr * 64 + fr, col0 = u.pn * BM + wc * 32 + 8 * fq;
#pragma unroll
        for (int ai = 0; ai < 2; ++ai)
#pragma unroll
            for (int m = 0; m < 4; ++m) { const int row = row0 + ai * HALF + m * 16; const float rs = rsqrtf(SS[row] * (1.f / D) + EPS) * s; bf16_t* rowp = O + (size_t)row * D + col0;
#pragma unroll
                for (int bj = 0; bj < 2; ++bj) { const f32x4 v0 = acc[ai][bj][m][0] * rs, v1 = acc[ai][bj][m][1] * rs;
                    u32x4 w; w.x = cvt_pk_bf16(v0[0], v0[1]); w.y = cvt_pk_bf16(v0[2], v0[3]); w.z = cvt_pk_bf16(v1[0], v1[1]); w.w = cvt_pk_bf16(v1[2], v1[3]);
                    *(u32x4*)(rowp + bj * HALF) = w; } }
    }
};
struct EpiSoftmax {
    static constexpr bool AFTER_DRAIN = true; bf16_t* P;
    __device__ __forceinline__ void operator()(const Acc&, const Unit&, int, int, int, int) const {}
    __device__ __forceinline__ void fused(Acc& acc, const Unit& u, int wr, int wc, int fr, int fq, PG8_LAS unsigned char* lds) const {
        PG8_LAS float* xm = (PG8_LAS float*)lds; PG8_LAS float* xs = xm + 1024;
#pragma unroll
        for (int ai = 0; ai < 2; ++ai)
#pragma unroll
            for (int m = 0; m < 4; ++m) { float mx = -3.0e38f;
#pragma unroll
                for (int bj = 0; bj < 2; ++bj)
#pragma unroll
                    for (int n = 0; n < 2; ++n) { const f32x4 v = acc[ai][bj][m][n]; mx = fmaxf(mx, fmaxf(fmaxf(v[0], v[1]), fmaxf(v[2], v[3]))); }
                mx = fmaxf(mx, __shfl_xor(mx, 16)); mx = fmaxf(mx, __shfl_xor(mx, 32));
                if (fq == 0) xm[(ai * HALF + wr * 64 + m * 16 + fr) * 4 + wc] = mx; }
        __syncthreads();
#pragma unroll
        for (int ai = 0; ai < 2; ++ai)
#pragma unroll
            for (int m = 0; m < 4; ++m) { const int r = ai * HALF + wr * 64 + m * 16 + fr; const f32x4 q = *(const PG8_LAS f32x4*)(xm + r * 4);
                const float mx = fmaxf(fmaxf(q[0], q[1]), fmaxf(q[2], q[3])); float sm = 0.f;
#pragma unroll
                for (int bj = 0; bj < 2; ++bj)
#pragma unroll
                    for (int n = 0; n < 2; ++n) { f32x4 v = acc[ai][bj][m][n]; v[0] = __expf(v[0] - mx); v[1] = __expf(v[1] - mx); v[2] = __expf(v[2] - mx); v[3] = __expf(v[3] - mx);
                        acc[ai][bj][m][n] = v; sm += (v[0] + v[1]) + (v[2] + v[3]); }
                sm += __shfl_xor(sm, 16); sm += __shfl_xor(sm, 32);
                if (fq == 0) xs[r * 4 + wc] = sm; }
        __syncthreads();
        const int row0 = u.pm * BM, col0 = u.pn * BM + wc * 32 + 8 * fq;
#pragma unroll
        for (int ai = 0; ai < 2; ++ai)
#pragma unroll
            for (int m = 0; m < 4; ++m) { const int r = ai * HALF + wr * 64 + m * 16 + fr; const f32x4 q = *(const PG8_LAS f32x4*)(xs + r * 4);
                const float inv = 1.f / ((q[0] + q[1]) + (q[2] + q[3])); bf16_t* rowp = P + (size_t)(row0 + r) * D + col0;
#pragma unroll
                for (int bj = 0; bj < 2; ++bj) { const f32x4 v0 = acc[ai][bj][m][0] * inv, v1 = acc[ai][bj][m][1] * inv;
                    u32x4 w; w.x = cvt_pk_bf16(v0[0], v0[1]); w.y = cvt_pk_bf16(v0[2], v0[3]); w.z = cvt_pk_bf16(v1[0], v1[1]); w.w = cvt_pk_bf16(v1[2], v1[3]);
                    *(u32x4*)(rowp + bj * HALF) = w; } }
        __syncthreads();
    }
};
struct EpiFFN1 {
    static constexpr bool AFTER_DRAIN = false; bf16_t* HID; const float* RSL; const float* bg; const float* bu; const PG8_LAS int* cntl;
    __device__ __forceinline__ void operator()(const Acc& acc, const Unit& u, int wr, int wc, int fr, int fq) const {
        const int cnt = cntl[u.e], c0 = u.pn * HALF + wc * 32 + 8 * fq;
        const f32x4 g0 = *(const f32x4*)(bg + u.e * 1024 + c0), g1 = *(const f32x4*)(bg + u.e * 1024 + c0 + 4), u0 = *(const f32x4*)(bu + u.e * 1024 + c0), u1 = *(const f32x4*)(bu + u.e * 1024 + c0 + 4);
#pragma unroll
        for (int ai = 0; ai < 2; ++ai)
#pragma unroll
            for (int m = 0; m < 4; ++m) { const int r = ai * HALF + wr * 64 + m * 16 + fr, pos = u.j * BM + r; const float rs = pos < cnt ? RSL[u.e * M + pos] : 0.f;
                const f32x4 a0 = acc[ai][0][m][0] * rs + g0, a1 = acc[ai][0][m][1] * rs + g1, b0 = acc[ai][1][m][0] * rs + u0, b1 = acc[ai][1][m][1] * rs + u1;
                u32x4 w; w.x = cvt_pk_bf16(ffn_act(a0[0], b0[0]), ffn_act(a0[1], b0[1])); w.y = cvt_pk_bf16(ffn_act(a0[2], b0[2]), ffn_act(a0[3], b0[3]));
                w.z = cvt_pk_bf16(ffn_act(a1[0], b1[0]), ffn_act(a1[1], b1[1])); w.w = cvt_pk_bf16(ffn_act(a1[2], b1[2]), ffn_act(a1[3], b1[3]));
                *(u32x4*)(HID + (size_t)(u.pm * BM + r) * 1024 + c0) = w; }
    }
};
struct EpiFFN2 {
    static constexpr bool AFTER_DRAIN = false; bf16_t* Y; const int* TOKL; const float* GATEL; const float* bd; const PG8_LAS int* cntl;
    __device__ __forceinline__ void operator()(const Acc& acc, const Unit& u, int wr, int wc, int fr, int fq) const {
        const int cnt = cntl[u.e], c0 = u.pn * BM + wc * 32 + 8 * fq;
        f32x4 bv[2][2];
#pragma unroll
        for (int bj = 0; bj < 2; ++bj) { bv[bj][0] = *(const f32x4*)(bd + u.e * 1024 + c0 + bj * HALF); bv[bj][1] = *(const f32x4*)(bd + u.e * 1024 + c0 + bj * HALF + 4); }
#pragma unroll
        for (int ai = 0; ai < 2; ++ai)
#pragma unroll
            for (int m = 0; m < 4; ++m) { const int r = ai * HALF + wr * 64 + m * 16 + fr, pos = u.j * BM + r;
                if (pos < cnt) { const int dst = TOKL[u.e * M + pos]; const float gt = GATEL[u.e * M + pos]; bf16_t* rowp = Y + (size_t)dst * 1024 + c0;
#pragma unroll
                    for (int bj = 0; bj < 2; ++bj) { const f32x4 v0 = (acc[ai][bj][m][0] + bv[bj][0]) * gt, v1 = (acc[ai][bj][m][1] + bv[bj][1]) * gt;
                        u32x4 w; w.x = cvt_pk_bf16(v0[0], v0[1]); w.y = cvt_pk_bf16(v0[2], v0[3]); w.z = cvt_pk_bf16(v1[0], v1[1]); w.w = cvt_pk_bf16(v1[2], v1[3]);
                        *(u32x4*)(rowp + bj * HALF) = w; } } }
    }
};
template <int NPN, bool IS_FFN1> struct MoeOrder {
    int G, c; const PG8_LAS int* tstart; const PG8_LAS int* cntl; const char* A; const char* W; const int* TOKL;
    __device__ bool next(int i, Unit& u) const {
        const int L = i * G + c, nrt = tstart[32]; if (L >= nrt * NPN) return false;
        const int rt = L / NPN, pn = L % NPN; int e = 0;
        for (int q = 1; q < 32; ++q) e += (tstart[q] <= rt) ? 1 : 0;
        u.pm = rt; u.pn = pn; u.e = e; u.j = rt - tstart[e];
        if (IS_FFN1) { u.a = A; u.b = W + ((size_t)e * 2048 + (size_t)pn * 256) * 2048; }
        else { u.a = A + (size_t)rt * 256 * 2048; u.b = W + ((size_t)e * 1024 + (size_t)pn * 256) * 2048; }
        return true;
    }
    __device__ __forceinline__ int arow(const Unit& u, int r) const { const int pos = u.j * BM + r; return pos < cntl[u.e] ? (TOKL[u.e * M + pos] >> 2) : 0; }
};
}

#define GAS __attribute__((address_space(1)))
#define LAS __attribute__((address_space(3)))
typedef unsigned v4u __attribute__((ext_vector_type(4)));
typedef float f32x4 __attribute__((ext_vector_type(4)));
typedef GAS unsigned gu32;
constexpr int NWAVES = 8, NTHR = 512;
constexpr int RING_BYTES = 131072, LDSCTL_OFF = RING_BYTES, LDS_BYTES = 163840;
constexpr int LW_BAR = 0, LW_TSTART = 16, LW_CNT = 64, LW_NWORDS = 128;
constexpr int CW_BAR = 1024;

#define XB_TMO      128
#define XB_XCNT(j)  (256  + 64 * (j))
#define XB_XSUB(j)  (1280 + 64 * (j))
#define XB_XGEN(j)  (2304 + 64 * (j))
#define XB_TOP      3328
#define XB_TOPGEN   3392
#define XCD_BAR_WORDS 3456
#define XB_SPIN_CAP (1u << 18)
__device__ __forceinline__ unsigned xb_ld(unsigned* p)              { return __hip_atomic_load(p, __ATOMIC_RELAXED, __HIP_MEMORY_SCOPE_AGENT); }
__device__ __forceinline__ unsigned xb_add(unsigned* p, unsigned v) { return __hip_atomic_fetch_add(p, v, __ATOMIC_RELAXED, __HIP_MEMORY_SCOPE_AGENT); }
__device__ __forceinline__ unsigned xb_xcc_id() { return (unsigned)__builtin_amdgcn_s_getreg((3 << 11) | 20) & 0xFu; }
#define XB_SPIN(cond, bar) do { unsigned _sp = 0; while (cond) { __builtin_amdgcn_s_sleep(1); \
    if ((++_sp & 255u) == 0u) { if (xb_ld(&(bar)[XB_TMO])) break; if (_sp > XB_SPIN_CAP) { atomicAdd(&(bar)[XB_TMO], 1u); break; } } } } while (0)
struct XcdBarrier { unsigned* bar; unsigned x; volatile LAS unsigned* st; };
__device__ __forceinline__ XcdBarrier xcd_barrier_post(unsigned* bar, volatile LAS unsigned* st) {
    XcdBarrier b; b.bar = bar; b.x = xb_xcc_id(); b.st = st;
    if (threadIdx.x == 0) (void)xb_add(&bar[XB_XCNT(b.x)], 1u);
    return b;
}
__device__ __forceinline__ void xcd_barrier_complete(unsigned* bar, unsigned x, unsigned& nloc, unsigned& nx) {
    const unsigned G = gridDim.x * gridDim.y * gridDim.z;
    unsigned sum, cnt, mine, sp = 0u;
    for (;;) {
        sum = 0u; cnt = 0u; mine = 0u;
#pragma unroll
        for (unsigned j = 0; j < 16; ++j) { const unsigned c = xb_ld(&bar[XB_XCNT(j)]); sum += c; cnt += (c > 0u) ? 1u : 0u; mine = (j == x) ? c : mine; }
        if (sum == G) break;
        __builtin_amdgcn_s_sleep(1);
        if ((++sp & 255u) == 0u) { if (xb_ld(&bar[XB_TMO])) break; if (sp > XB_SPIN_CAP) { atomicAdd(&bar[XB_TMO], 1u); break; } }
    }
    nloc = mine > 0u ? mine : 1u; nx = cnt > 0u ? cnt : 1u;
}
__device__ __forceinline__ void xcd_barrier(const XcdBarrier& b) {
    asm volatile("s_waitcnt vmcnt(0)" ::: "memory");
    __syncthreads();
    if (threadIdx.x == 0) {
        unsigned* bar = b.bar;
        __builtin_amdgcn_s_waitcnt(0);
        unsigned nloc = b.st[0], nx = b.st[1];
        if (nloc == 0u) { xcd_barrier_complete(bar, b.x, nloc, nx); b.st[0] = nloc; b.st[1] = nx; }
        const unsigned old = xb_add(&bar[XB_XSUB(b.x)], 1u);
        const unsigned gen = old / nloc;
        if (old + 1u == (gen + 1u) * nloc) {
            __builtin_amdgcn_fence(__ATOMIC_RELEASE, "agent");
            asm volatile("s_waitcnt vmcnt(0)" ::: "memory");
            const unsigned og = xb_add(&bar[XB_TOP], 1u);
            const unsigned tg = og / nx;
            if (og + 1u == (tg + 1u) * nx) xb_add(&bar[XB_TOPGEN], 1u);
            else XB_SPIN(xb_ld(&bar[XB_TOPGEN]) == tg, bar);
            __builtin_amdgcn_fence(__ATOMIC_ACQUIRE, "agent");
            xb_add(&bar[XB_XGEN(b.x)], 1u);
            asm volatile("s_waitcnt vmcnt(0)" ::: "memory");
        } else {
            XB_SPIN(xb_ld(&bar[XB_XGEN(b.x)]) == gen, bar);
            __builtin_amdgcn_fence(__ATOMIC_ACQUIRE, "agent");
            asm volatile("s_waitcnt vmcnt(0)" ::: "memory");
        }
    }
    __syncthreads();
}

struct Args { const float* in[31]; float* out; unsigned char* ws; int ph_lo, ph_hi, bli, pad; };

#define LDS_WAIT() asm volatile("s_waitcnt lgkmcnt(0)" ::: "memory")
__device__ __forceinline__ unsigned pk2(float lo, float hi) { return (unsigned)f2bf(lo) | ((unsigned)f2bf(hi) << 16); }
__device__ __forceinline__ void transpose_item(const float* W, int ldn, int col0, int k0, bf16* dst, int pitch, const float* gain, LAS float* scr, int lane) {
#pragma unroll 8
    for (int i = 0; i < 32; ++i) { const int kk = 2 * i + (lane >> 5); float v = W[(size_t)(k0 + kk) * ldn + col0 + (lane & 31)]; if (gain) v *= gain[k0 + kk]; scr[kk * 33 + (lane & 31)] = v; }
    LDS_WAIT(); asm volatile("" ::: "memory");
    const int c = lane & 7;
#pragma unroll
    for (int j = 0; j < 4; ++j) { const int n = (lane >> 3) + 8 * j; const LAS float* s = scr + (8 * c) * 33 + n;
        v4u o; o.x = pk2(s[0 * 33], s[1 * 33]); o.y = pk2(s[2 * 33], s[3 * 33]); o.z = pk2(s[4 * 33], s[5 * 33]); o.w = pk2(s[6 * 33], s[7 * 33]);
        *(GAS v4u*)(dst + (size_t)n * pitch + k0 + 8 * c) = o; }
    LDS_WAIT(); asm volatile("" ::: "memory");
}

__global__ void __launch_bounds__(NTHR, 2) mk_fwd(Args args) {
    extern __shared__ __attribute__((aligned(16))) unsigned char lds_raw[];
    LAS unsigned char* lds = (LAS unsigned char*)lds_raw;
    volatile LAS unsigned* LW = (volatile LAS unsigned*)(lds + LDSCTL_OFF);
    const int tid = threadIdx.x, lane = tid & 63, wave = __builtin_amdgcn_readfirstlane(tid >> 6), G = gridDim.x, bx = blockIdx.x;
    unsigned char* ws = args.ws; float* out = args.out;
    unsigned* ctl = (unsigned*)(ws + WS_CTL);
    for (int u = tid; u < LW_NWORDS; u += NTHR) LW[u] = 0u;
    __syncthreads();
    XcdBarrier bar = xcd_barrier_post(ctl + CW_BAR + args.bli * XCD_BAR_WORDS, LW + LW_BAR);
    const int lo = args.ph_lo, hi = args.ph_hi;
#ifndef SKIPMASK
#define SKIPMASK 0
#endif
#define IN(k) (!((SKIPMASK >> (k)) & 1) && lo <= (k) && (k) < hi)
#define SEAM(k) do { if (IN(k) && IN((k) + 1)) xcd_barrier(bar); } while (0)
    const float *x = args.in[0], *mem = args.in[1], *norm_mix = args.in[2], *w_in = args.in[3], *w_out = args.in[15], *norm_cross = args.in[16], *norm_mem = args.in[17], *w_cq = args.in[18], *w_ckv = args.in[19], *w_co = args.in[20];
    const float *norm_moe = args.in[21], *w_router = args.in[22], *w_gate = args.in[24], *b_gate = args.in[25], *w_up = args.in[26], *b_up = args.in[27], *w_down = args.in[28], *b_down = args.in[29], *norm_final = args.in[30];
    float* ss1 = (float*)(ws + CTL_SS1); float* ss2 = (float*)(ws + CTL_SS2);
    bf16 *Win_t = (bf16*)(ws + WS_WIN), *Wout_t = (bf16*)(ws + WS_WOUT), *Wcq_t = (bf16*)(ws + WS_WCQ), *Wckv_t = (bf16*)(ws + WS_WCKV), *Wco_t = (bf16*)(ws + WS_WCO), *Wgu_t = (bf16*)(ws + WS_WGU), *Wd_t = (bf16*)(ws + WS_WD);
    bf16 *XN = (bf16*)(ws + WS_XN), *MIX = XN, *HB2 = XN, *PROJ = (bf16*)(ws + WS_PROJ), *HB = (bf16*)(ws + WS_HB), *Qb = (bf16*)(ws + WS_Q), *Pb = (bf16*)(ws + WS_P), *HID = (bf16*)(ws + WS_HID);
    bf16 *O2 = (bf16*)(ws + WS_O2), *Y = (bf16*)(ws + WS_Y), *MEMN = (bf16*)(ws + WS_MEMN), *KM = (bf16*)(ws + WS_KM), *VT = (bf16*)(ws + WS_VT);
    const int gw = bx * NWAVES + wave, NGW = G * NWAVES;

    if (IN(0)) {
        LAS float* scr = (LAS float*)(lds + wave * 16384);
        constexpr int I_IN = 16 * 96, I_SQ = 16 * 32, I_KV = 16 * 64;
        constexpr int NIT = I_IN + 3 * I_SQ + I_KV;
        for (int it = gw; it < NIT; it += NGW) {
            int r = it;
            if (r < I_IN) { const int kb = r / 96, nb = r % 96, n0 = nb * 32; transpose_item(w_in, NIN, n0 < 2048 ? n0 : n0 + 8, kb * 64, Win_t + (size_t)n0 * D, D, nullptr, scr, lane); continue; } r -= I_IN;
            if (r < I_SQ) { const int kb = r / 32, nb = r % 32; transpose_item(w_out, D, nb * 32, kb * 64, Wout_t + (size_t)nb * 32 * D, D, nullptr, scr, lane); continue; } r -= I_SQ;
            if (r < I_SQ) { const int kb = r / 32, nb = r % 32; transpose_item(w_cq, D, nb * 32, kb * 64, Wcq_t + (size_t)nb * 32 * D, D, norm_cross, scr, lane); continue; } r -= I_SQ;
            if (r < I_SQ) { const int kb = r / 32, nb = r % 32; transpose_item(w_co, D, nb * 32, kb * 64, Wco_t + (size_t)nb * 32 * D, D, nullptr, scr, lane); continue; } r -= I_SQ;
            { const int kb = r / 64, nb = r % 64; transpose_item(w_ckv, 2048, nb * 32, kb * 64, Wckv_t + (size_t)nb * 32 * D, D, nullptr, scr, lane); }
        }
        __syncthreads();
        LAS float* w8 = (LAS float*)lds;
        for (int i = tid; i < D * 8; i += NTHR) w8[i] = w_in[(size_t)(i >> 3) * NIN + 2048 + (i & 7)];
        __syncthreads();
        float* BA = (float*)(ws + WS_BA);
        for (int row = gw; row < M + NB * MEML; row += NGW) {
            const bool ismem = row >= M; const float* xr = ismem ? mem + (size_t)(row - M) * D : x + (size_t)row * D; const float* gn = ismem ? norm_mem : norm_mix;
            bf16* orow = ismem ? MEMN + (size_t)(row - M) * D : XN + (size_t)row * D;
            f32x4 v[4]; float s = 0.f;
#pragma unroll
            for (int j = 0; j < 4; ++j) { v[j] = *(const f32x4*)(xr + 4 * lane + 256 * j); s += (v[j][0] * v[j][0] + v[j][1] * v[j][1]) + (v[j][2] * v[j][2] + v[j][3] * v[j][3]); }
            const float rstd = rsqrtf(wave_sum(s) * (1.f / D) + EPS);
            float acc[8];
#pragma unroll
            for (int q = 0; q < 8; ++q) acc[q] = 0.f;
#pragma unroll
            for (int j = 0; j < 4; ++j) { const f32x4 gg = *(const f32x4*)(gn + 4 * lane + 256 * j); const f32x4 u = v[j] * rstd * gg;
                *(unsigned long long*)(orow + 4 * lane + 256 * j) = (unsigned long long)pk2(u[0], u[1]) | ((unsigned long long)pk2(u[2], u[3]) << 32);
                if (!ismem) {
#pragma unroll
                    for (int i = 0; i < 4; ++i) { const int k = 4 * lane + 256 * j + i; const f32x4 wa = *(const LAS f32x4*)(w8 + k * 8), wb = *(const LAS f32x4*)(w8 + k * 8 + 4);
                        acc[0] += u[i] * wa[0]; acc[1] += u[i] * wa[1]; acc[2] += u[i] * wa[2]; acc[3] += u[i] * wa[3]; acc[4] += u[i] * wb[0]; acc[5] += u[i] * wb[1]; acc[6] += u[i] * wb[2]; acc[7] += u[i] * wb[3]; } } }
            if (!ismem) {
#pragma unroll
                for (int q = 0; q < 8; ++q) { const float t = wave_sum(acc[q]); if (lane == q) BA[(size_t)row * 8 + q] = t; } }
        }
        __syncthreads();
    }
    SEAM(0);
    if (IN(1)) {
        { pg8::Gemm g{D, D, D}; pg8::StaticOrder S; S.init(XN, Win_t, M, NP, D, D, G, bx); pg8::EpiStore E{PROJ, NP};
          pg8::gemm_phase<pg8::EpiStore, pg8::StaticOrder, true, false>(lds, g, S, E); }
        { pg8::Gemm g{D, D, D}; pg8::StaticOrder S; S.init(MEMN, Wckv_t, NB * MEML, D, D, D, G, bx); pg8::EpiStore E{KM, D};
          pg8::gemm_phase<pg8::EpiStore, pg8::StaticOrder, true, false>(lds, g, S, E); }
        { pg8::Gemm g{D, D, D}; pg8::StaticOrder S; S.init(Wckv_t + (size_t)D * D, MEMN, D, NB * MEML, D, D, G, (bx + 128) % G); pg8::EpiStore E{VT, D};
          pg8::gemm_phase<pg8::EpiStore, pg8::StaticOrder, true, false>(lds, g, S, E); }
    }
    SEAM(1);
    if (IN(4)) {
        pg8::Gemm g{D, D, D}; pg8::StaticOrder S; S.init(MIX, Wout_t, M, D, D, D, G, bx); pg8::EpiResid E{x, out, HB, ss1};
        pg8::gemm_phase<pg8::EpiResid, pg8::StaticOrder, true, false>(lds, g, S, E);
    }
    SEAM(4);
    if (IN(5)) {
        { const int ut = bx; if (ut < (M / 256) * 4) {
            const int pm = ut >> 2, h = ut & 3, b = pm / (T / 256);
            { pg8::Gemm g{D, D, D}; pg8::OneUnit S; S.u0 = pg8::Unit{pm, h, (const char*)(HB + (size_t)pm * 256 * D), (const char*)(Wcq_t + (size_t)h * 256 * D), 0, 0};
              pg8::EpiRowScale E{Qb, ss1, 0.0625f}; pg8::gemm_phase<pg8::EpiRowScale, pg8::OneUnit, false, false>(lds, g, S, E); }
            asm volatile("s_waitcnt vmcnt(0)" ::: "memory"); __syncthreads();
            { pg8::Gemm g{D, D, 256}; pg8::OneUnit S; S.u0 = pg8::Unit{pm, h, (const char*)(Qb + (size_t)pm * 256 * D + h * 256), (const char*)(KM + (size_t)b * 256 * D + h * 256), 0, 0};
              pg8::EpiSoftmax E{Pb}; pg8::gemm_phase<pg8::EpiSoftmax, pg8::OneUnit, false, false>(lds, g, S, E); }
            asm volatile("s_waitcnt vmcnt(0)" ::: "memory"); __syncthreads();
            { pg8::Gemm g{D, D, 256}; pg8::OneUnit S; S.u0 = pg8::Unit{pm, h, (const char*)(Pb + (size_t)pm * 256 * D + h * 256), (const char*)(VT + (size_t)h * 256 * D + b * 256), 0, 0};
              pg8::EpiStore E{O2, D}; pg8::gemm_phase<pg8::EpiStore, pg8::OneUnit, false, false>(lds, g, S, E); }
            asm volatile("s_waitcnt vmcnt(0)" ::: "memory"); __syncthreads();
        } }
    }
    SEAM(5);
    if (IN(6)) {
        pg8::Gemm g{D, D, D}; pg8::StaticOrder S; S.init(O2, Wco_t, M, D, D, D, G, bx); pg8::EpiResid E{out, out, HB2, ss2};
        pg8::gemm_phase<pg8::EpiResid, pg8::StaticOrder, true, false>(lds, g, S, E);
    }
    SEAM(6);
    if (IN(8) || IN(9)) {
        const unsigned* cntg = ctl + CW_CNT;
        if (tid < 32) LW[LW_CNT + tid] = cntg[tid];
        __syncthreads();
        if (tid == 0) { int s = 0; for (int e = 0; e < 32; ++e) { LW[LW_TSTART + e] = (unsigned)s; s += ((int)LW[LW_CNT + e] + 255) >> 8; } LW[LW_TSTART + 32] = (unsigned)s; }
        __syncthreads();
    }
    const LAS int* tstart = (const LAS int*)(lds + LDSCTL_OFF) + LW_TSTART; const LAS int* cntl = (const LAS int*)(lds + LDSCTL_OFF) + LW_CNT;
    const int* TOKL = (const int*)(ws + WS_TOKL); const float* GATEL = (const float*)(ws + WS_GATEL); const float* RSL = (const float*)(ws + WS_RSL);
    if (IN(8)) {
        pg8::Gemm g{D, D, D}; pg8::MoeOrder<8, true> S{G, bx, tstart, cntl, (const char*)HB2, (const char*)Wgu_t, TOKL};
        pg8::EpiFFN1 E{HID, RSL, b_gate, b_up, cntl};
        pg8::gemm_phase<pg8::EpiFFN1, pg8::MoeOrder<8, true>, true, true>(lds, g, S, E);
    }
    SEAM(8);
    if (IN(9)) {
        pg8::Gemm g{D, D, D}; pg8::MoeOrder<4, false> S{G, bx, tstart, cntl, (const char*)HID, (const char*)Wd_t, TOKL};
        pg8::EpiFFN2 E{Y, TOKL, GATEL, b_down, cntl};
        pg8::gemm_phase<pg8::EpiFFN2, pg8::MoeOrder<4, false>, true, false>(lds, g, S, E);
    }
    SEAM(9);
    if (IN(10)) {
        for (int row = gw; row < M; row += NGW) {
            f32x4 v[4]; float s = 0.f;
#pragma unroll
            for (int j = 0; j < 4; ++j) { const int c = 4 * lane + 256 * j; f32x4 h = *(const f32x4*)(out + (size_t)row * D + c);
#pragma unroll
                for (int k = 0; k < 4; ++k) { const unsigned long long yy = *(const unsigned long long*)(Y + ((size_t)row * 4 + k) * D + c);
                    h[0] += bf2f((bf16)(yy & 0xffff)); h[1] += bf2f((bf16)((yy >> 16) & 0xffff)); h[2] += bf2f((bf16)((yy >> 32) & 0xffff)); h[3] += bf2f((bf16)(yy >> 48)); }
                v[j] = h; s += (h[0] * h[0] + h[1] * h[1]) + (h[2] * h[2] + h[3] * h[3]); }
            const float rs = rsqrtf(wave_sum(s) * (1.f / D) + EPS);
#pragma unroll
            for (int j = 0; j < 4; ++j) { const int c = 4 * lane + 256 * j; const f32x4 gg = *(const f32x4*)(norm_final + c); *(f32x4*)(out + (size_t)row * D + c) = v[j] * rs * gg; }
        }
    }
    if (IN(11)) {
        LAS float* scr = (LAS float*)(lds + wave * 16384);
        constexpr int I_GU = 32 * 2 * 16 * 32, I_D = 32 * 16 * 32;
        for (int it = gw; it < I_GU + I_D; it += NGW) {
            if (it < I_GU) { const int nb = it & 31, kb = (it >> 5) & 15, which = (it >> 9) & 1, e = it >> 10, n0 = nb * 32;
                transpose_item((which ? w_up : w_gate) + (size_t)e * D * D, D, n0, kb * 64, Wgu_t + ((size_t)e * 2048 + (n0 >> 7) * 256 + (n0 & 127) + which * 128) * D, D, norm_moe, scr, lane); }
            else { const int r = it - I_GU, nb = r & 31, kb = (r >> 5) & 15, e = r >> 9;
                transpose_item(w_down + (size_t)e * D * D, D, nb * 32, kb * 64, Wd_t + ((size_t)e * 1024 + nb * 32) * D, D, nullptr, scr, lane); }
        }
    }
#undef IN
#undef SEAM
}

static void launch_mk(Args a, int lo, int hi, int bli, int grid, hipStream_t stream) {
    a.ph_lo = lo; a.ph_hi = hi; a.bli = bli; a.pad = 0;
    hipLaunchKernelGGL(mk_fwd, dim3(grid), dim3(NTHR), LDS_BYTES, stream, a);
}
extern "C" void kernel_launch(void* const* d_in, const int* in_sizes, int n_in, void* d_out, int out_size, void* d_ws, size_t ws_size, hipStream_t stream) {
    if (n_in != 31 || out_size != M * D || ws_size < WS_END) { fprintf(stderr, "kernel_launch: unexpected shapes n_in %d out %d ws %zu\n", n_in, out_size, ws_size); return; }
    static int grid = 0;
    if (grid == 0) {
        int dev = 0, cus = 0;
        if (hipGetDevice(&dev) != hipSuccess || hipDeviceGetAttribute(&cus, hipDeviceAttributeMultiprocessorCount, dev) != hipSuccess) { grid = -1; return; }
        if (hipFuncSetAttribute((const void*)mk_fwd, hipFuncAttributeMaxDynamicSharedMemorySize, LDS_BYTES) != hipSuccess) { fprintf(stderr, "kernel_launch: hipFuncSetAttribute failed\n"); grid = -1; return; }
        int per_cu = 0; (void)hipOccupancyMaxActiveBlocksPerMultiprocessor(&per_cu, (const void*)mk_fwd, NTHR, LDS_BYTES); (void)hipGetLastError();
        if (per_cu < 1) fprintf(stderr, "kernel_launch: occupancy query reports %d blocks per CU\n", per_cu);
        if (cus < 256) { fprintf(stderr, "kernel_launch: needs 256 CUs, device has %d\n", cus); grid = -1; return; }
        grid = 256;
    }
    if (grid < 0) return;
    const float* const* in = (const float* const*)d_in;
    const float *dn_conv = in[4], *dn_a_log = in[5], *dn_dt_bias = in[6], *dn_norm = in[7];
    const float *rg_conv = in[8], *rg_conv_b = in[9], *rg_w_a = in[10], *rg_b_a = in[11], *rg_w_x = in[12], *rg_b_x = in[13], *rg_lambda = in[14];
    const float *norm_moe = in[21], *w_router = in[22], *b_router = in[23];
    char* ws = (char*)d_ws; float* out = (float*)d_out;
    unsigned* ctl = (unsigned*)(ws + WS_CTL); unsigned* cnt = ctl + CW_CNT; float* ss2 = (float*)(ws + CTL_SS2);
    float* BA = (float*)(ws + WS_BA); float* RSTD2 = (float*)(ws + WS_RSTD2);
    int* TOKL = (int*)(ws + WS_TOKL); float* GATEL = (float*)(ws + WS_GATEL); float* RSL = (float*)(ws + WS_RSL);
    bf16 *MIX = (bf16*)(ws + WS_XN), *PROJ = (bf16*)(ws + WS_PROJ);
    float* ODN = (float*)(ws + WS_ODN); float* QKVN = (float*)(ws + WS_QKVN);
    Args a{};
    for (int i = 0; i < 31; ++i) a.in[i] = (const float*)d_in[i];
    a.out = out; a.ws = (unsigned char*)d_ws;

    (void)hipMemsetAsync(ws + WS_CTL, 0, CTL_BYTES, stream);
    launch_mk(a, 0, 2, 0, grid, stream);
    k_dn_prep<<<dim3(M, 12), 128, 0, stream>>>(PROJ, dn_conv, QKVN);
    k_dn_rec<<<NB * 4 * 8, 256, 0, stream>>>(QKVN, BA, dn_a_log, dn_dt_bias, ODN);
    k_fin_dn<<<dim3(M, 4), 128, 0, stream>>>(ODN, PROJ, dn_norm, MIX);
    float* AA = out; float* BX = out + (size_t)M * 512;
    k_rg_prep<<<M, 512, 0, stream>>>(PROJ, rg_conv, rg_conv_b, rg_w_a, rg_b_a, rg_w_x, rg_b_x, rg_lambda, AA, BX);
    k_rg_scan<<<NB * 512 / 256, 256, 0, stream>>>(AA, BX, PROJ, MIX);
    launch_mk(a, 11, 12, 1, grid, stream);
    launch_mk(a, 4, 7, 2, grid, stream);
    k_route<<<M / 4, 256, 0, stream>>>(out, ss2, norm_moe, w_router, b_router, RSTD2, cnt, TOKL, GATEL, RSL);
    launch_mk(a, 8, 11, 3, grid, stream);
}
```

```cpp
#include <hip/hip_runtime.h>
#include <cstdio>
#include <cstdint>

typedef unsigned short bf16;
__device__ __forceinline__ float bf2f(bf16 v) { return __builtin_bit_cast(float, (unsigned)v << 16); }
__device__ __forceinline__ bf16 f2bf(float f) { unsigned u = __builtin_bit_cast(unsigned, f); return (bf16)((u + 0x7fffu + ((u >> 16) & 1u)) >> 16); }

constexpr int NB = 4, T = 4096, D = 1024, M = NB * T, NIN = 3080, NP = 3072, MEML = 256;
constexpr int NE = 32, TOPK = 4;
constexpr float EPS = 1e-6f;
constexpr int PC_Q = 0, PC_K = 512, PC_V = 1024, PC_Z = 1536, PC_RX = 2048, PC_RY = 2560;

constexpr size_t MiB = 1u << 20;
constexpr size_t WS_CTL = 0, CTL_BYTES = 1 * MiB;
constexpr int CW_CNT = 512;
constexpr size_t CTL_SS1 = 128 * 1024, CTL_SS2 = 192 * 1024;
constexpr size_t WS_BA = 1 * MiB, WS_RSTD2 = 1 * MiB + 512 * 1024, WS_DEC = 1 * MiB + 768 * 1024;
constexpr size_t WS_RGW = 2 * MiB, WS_WR = 2 * MiB + 512 * 1024, WS_MEMN = 3 * MiB, WS_KM = 5 * MiB, WS_VT = 7 * MiB;
constexpr size_t WS_RGSUM = 9 * MiB, WS_TOKL = 10 * MiB, WS_GATEL = 12 * MiB, WS_RSL = 14 * MiB;
constexpr size_t WS_WIN = 16 * MiB, WS_WOUT = 22 * MiB, WS_WCQ = 24 * MiB, WS_WCKV = 26 * MiB, WS_WCO = 30 * MiB;
constexpr size_t WS_WGU = 32 * MiB, WS_WD = 160 * MiB;
constexpr size_t WS_XN = 224 * MiB;
constexpr size_t WS_PROJ = 256 * MiB;
constexpr size_t WS_HB = 256 * MiB, WS_Q = 288 * MiB, WS_P = 320 * MiB, WS_HID = 256 * MiB;
constexpr size_t WS_DN = 352 * MiB;
constexpr size_t WS_O2 = 352 * MiB, WS_SC = 384 * MiB  ;
constexpr size_t WS_ODN = 442 * MiB, WS_HLOC = 474 * MiB, WS_CP = 490 * MiB, WS_END = 506 * MiB;
constexpr size_t WS_Y = 32 * MiB;
constexpr size_t WS_QKVN = 32 * MiB;

__global__ void k_transpose(const float* W, int ldn, bf16* out, int K, const float* gain,
                            int zb, long in_s1, long in_s2, long out_s1, long out_s2) {
    __shared__ float tile[32][33];
    const int z = blockIdx.z; W += (z / zb) * in_s1 + (z % zb) * in_s2; out += (z / zb) * out_s1 + (z % zb) * out_s2;
    const int r0 = blockIdx.x * 32, k0 = blockIdx.y * 32, tx = threadIdx.x & 31, ty = threadIdx.x >> 5;
    for (int i = ty; i < 32; i += 8) { const int k = k0 + i; tile[i][tx] = W[(size_t)k * ldn + r0 + tx] * (gain ? gain[k] : 1.f); }
    __syncthreads();
    for (int i = ty; i < 32; i += 8) out[(size_t)(r0 + i) * K + k0 + tx] = f2bf(tile[tx][i]);
}
__global__ void k_router_w(const float* wr, const float* g, bf16* hi, bf16* lo) {
    const int i = blockIdx.x * blockDim.x + threadIdx.x; if (i >= NE * D) return;
    const int e = i / D, k = i % D; const float v = wr[k * NE + e] * g[k]; const bf16 h = f2bf(v); hi[i] = h; lo[i] = f2bf(v - bf2f(h));
}

__device__ __forceinline__ float wave_sum(float v) {
#pragma unroll
    for (int o = 1; o < 64; o <<= 1) v += __shfl_xor(v, o);
    return v;
}
__global__ void k_rmsnorm_rows(const float* x, const float* g, bf16* out, int nrows, const float* w8, int ldw, float* ba) {
    const int row = blockIdx.x * (blockDim.x >> 6) + (threadIdx.x >> 6), lane = threadIdx.x & 63; if (row >= nrows) return;
    const float* xr = x + (size_t)row * D; float v[16]; float s = 0.f;
#pragma unroll
    for (int j = 0; j < 16; ++j) { v[j] = xr[lane + 64 * j]; s += v[j] * v[j]; }
    const float rstd = rsqrtf(wave_sum(s) * (1.f / D) + EPS);
    float acc[8];
#pragma unroll
    for (int q = 0; q < 8; ++q) acc[q] = 0.f;
#pragma unroll
    for (int j = 0; j < 16; ++j) { const int k = lane + 64 * j; const float u = v[j] * rstd * g[k]; out[(size_t)row * D + k] = f2bf(u);
        if (w8) {
#pragma unroll
            for (int q = 0; q < 8; ++q) acc[q] += u * w8[(size_t)k * ldw + q]; } }
    if (w8) {
#pragma unroll
        for (int q = 0; q < 8; ++q) { const float t = wave_sum(acc[q]); if (lane == 0) ba[(size_t)row * 8 + q] = t; } }
}

__device__ __forceinline__ float sigmoidf_(float x) { return 1.f / (1.f + __expf(-x)); }
__device__ __forceinline__ float siluf_(float x) { return x * sigmoidf_(x); }
__device__ __forceinline__ float softplusf_(float x) { return fmaxf(x, 0.f) + log1pf(__expf(-fabsf(x))); }
__device__ __forceinline__ float gelu_tanh(float x) { const float u = 0.7978845608028654f * (x + 0.044715f * x * x * x); return 0.5f * x * (1.f + tanhf(u)); }
__device__ __forceinline__ float ffn_act(float gt, float up) { gt = fminf(gt, 7.f); up = fminf(fmaxf(up, -7.f), 7.f); return (up + 1.f) * (gt * sigmoidf_(1.702f * gt)); }

struct GP {
    const bf16* A; int lda; const bf16* Bt; int ldb; int K;
    float* F0; float* F1; bf16* H0; bf16* H1; const float* C0; const float* C1; const int* I0; const float* G0; const unsigned* cnt;
};
template <int MODE> __global__ void __launch_bounds__(256) k_gemm(GP p) {
    __shared__ float As[16][65], Bs[16][65], Bs2[16][65];
    __shared__ int rowsrc[64]; __shared__ int rowaux[64]; __shared__ float rowg[64];
    const int tid = threadIdx.x, tx = tid & 15, ty = tid >> 4;
    int row0 = blockIdx.y * 64, col0 = blockIdx.x * 64; const bf16* A = p.A; const bf16* Bt = p.Bt;
    int e = 0, nvalid = 64, slot0 = 0;
    if (MODE == 4) { const int b = blockIdx.z >> 2, h = blockIdx.z & 3; row0 += b * T; A += h * 256; Bt += (size_t)(b * 256) * 1024 + h * 256; }
    if (MODE == 5) { const int b = blockIdx.z >> 2, h = blockIdx.z & 3; row0 += b * T; A += h * 256; Bt += (size_t)(h * 256) * 1024 + b * 256; }
    if (MODE == 7 || MODE == 8) {
        e = blockIdx.z; const int cnt = (int)p.cnt[e]; if (row0 >= cnt) return; nvalid = min(64, cnt - row0);
        for (int i = 0; i < e; ++i) slot0 += (((int)p.cnt[i] + 255) / 256) * 256;
        if (tid < 64) { const int pos = row0 + tid; const int v = pos < cnt ? p.I0[e * M + pos] : 0; rowaux[tid] = v; rowsrc[tid] = (MODE == 7) ? (v >> 2) : (slot0 + pos); rowg[tid] = pos < cnt ? p.G0[e * M + pos] : 0.f; }
        Bt += (size_t)e * (MODE == 7 ? 2048 : 1024) * 1024;
        __syncthreads();
    }
    float acc[4][4], acc2[4][4];
#pragma unroll
    for (int i = 0; i < 4; ++i)
#pragma unroll
        for (int j = 0; j < 4; ++j) { acc[i][j] = 0.f; acc2[i][j] = 0.f; }
    for (int k0 = 0; k0 < p.K; k0 += 16) {
        for (int i = tid; i < 64 * 16; i += 256) { const int r = i >> 4, k = i & 15;
            const int ar = (MODE == 7 || MODE == 8) ? rowsrc[r] : row0 + r;
            As[k][r] = bf2f(A[(size_t)ar * p.lda + k0 + k]);
            int bc = col0 + r;
            if (MODE == 7) { const int c = col0 + r; bc = (c >> 7) * 256 + (c & 127); Bs2[k][r] = bf2f(Bt[(size_t)(bc + 128) * p.ldb + k0 + k]); }
            Bs[k][r] = bf2f(Bt[(size_t)bc * p.ldb + k0 + k]); }
        __syncthreads();
#pragma unroll
        for (int k = 0; k < 16; ++k) { float a[4], b[4], b2[4];
#pragma unroll
            for (int i = 0; i < 4; ++i) { a[i] = As[k][ty * 4 + i]; b[i] = Bs[k][tx * 4 + i]; if (MODE == 7) b2[i] = Bs2[k][tx * 4 + i]; }
#pragma unroll
            for (int i = 0; i < 4; ++i)
#pragma unroll
                for (int j = 0; j < 4; ++j) { acc[i][j] += a[i] * b[j]; if (MODE == 7) acc2[i][j] += a[i] * b2[j]; } }
        __syncthreads();
    }
#pragma unroll
    for (int i = 0; i < 4; ++i) {
        const int rl = ty * 4 + i, row = row0 + rl; float hsq = 0.f;
#pragma unroll
        for (int j = 0; j < 4; ++j) { const int col = col0 + tx * 4 + j; const float v = acc[i][j];
            if (MODE == 0) p.H0[(size_t)row * NP + col] = f2bf(v);
            if (MODE == 1) { if (col < 1024) p.H0[(size_t)row * 1024 + col] = f2bf(v); else p.H1[(size_t)(col - 1024) * 1024 + row] = f2bf(v); }
            if (MODE == 2 || MODE == 6) { const size_t o = (size_t)row * D + col; const float h = p.C0[o] + v; p.F0[o] = h; p.H0[o] = f2bf(h); hsq += h * h; }
            if (MODE == 3) { const float rs = rsqrtf(p.C0[row] * (1.f / D) + EPS); p.H0[(size_t)row * D + col] = f2bf(v * rs * 0.0625f); }
            if (MODE == 4) { const int h = blockIdx.z & 3; p.F0[(size_t)row * 1024 + h * 256 + col] = v; }
            if (MODE == 5) { const int h = blockIdx.z & 3; p.H0[(size_t)row * 1024 + h * 256 + col] = f2bf(v); }
            if (MODE == 7) { if (rl < nvalid) { const float rs = p.C0[rowaux[rl] >> 2]; const float gt = v * rs + p.C1[e * 1024 + col], up = acc2[i][j] * rs + p.F1[e * 1024 + col];
                    p.H0[(size_t)(slot0 + row) * 1024 + col] = f2bf(ffn_act(gt, up)); } }
            if (MODE == 8) { if (rl < nvalid) p.H0[(size_t)rowaux[rl] * 1024 + col] = f2bf((v + p.C0[e * 1024 + col]) * rowg[rl]); }
        }
        if (MODE == 2 || MODE == 6) atomicAdd(&p.F1[row], hsq);
    }
}

__global__ void k_dn_prep(const bf16* proj, const float* conv, float* qkvn) {
    const int row = blockIdx.x, t = row % T, c = blockIdx.y * 128 + threadIdx.x;
    float s = 0.f;
#pragma unroll
    for (int j = 0; j < 4; ++j) { const int tt = t + j - 3; if (tt >= 0) s += conv[j * 1536 + c] * bf2f(proj[(size_t)(row + j - 3) * NP + c]); }
    s = siluf_(s);
    if (blockIdx.y < 8) { __shared__ float red[2]; float q = wave_sum(s * s); if ((threadIdx.x & 63) == 0) red[threadIdx.x >> 6] = q; __syncthreads(); q = red[0] + red[1]; s *= rsqrtf(q + EPS); }
    qkvn[(size_t)row * 1536 + c] = s;
}
__global__ void __launch_bounds__(256) k_dn_rec(const float* qkvn, const float* ba, const float* a_log, const float* dt_bias, float* odn) {
    const int sl = blockIdx.x & 7, h = (blockIdx.x >> 3) & 3, b = blockIdx.x >> 5, tid = threadIdx.x, dvl = tid & 15, part = tid >> 4;
    __shared__ float qs[128], ks[128], red[16][17], red2[16][17];
    float S[8];
#pragma unroll
    for (int i = 0; i < 8; ++i) S[i] = 0.f;
    const float Aexp = __expf(a_log[h]), dtb = dt_bias[h], scale = 0.08838834764831845f;
    for (int t = 0; t < T; ++t) {
        const size_t row = (size_t)b * T + t;
        if (tid < 128) { qs[tid] = qkvn[row * 1536 + h * 128 + tid]; ks[tid] = qkvn[row * 1536 + 512 + h * 128 + tid]; }
        const float v = qkvn[row * 1536 + 1024 + h * 128 + sl * 16 + dvl];
        const float beta = sigmoidf_(ba[row * 8 + h]), g = -Aexp * softplusf_(ba[row * 8 + 4 + h] + dtb), eg = __expf(g);
        __syncthreads();
        float pk = 0.f;
#pragma unroll
        for (int i = 0; i < 8; ++i) pk += ks[part * 8 + i] * S[i];
        red[part][dvl] = pk; __syncthreads();
        float kS = 0.f;
#pragma unroll
        for (int i = 0; i < 16; ++i) kS += red[i][dvl];
        const float vn = beta * (v - eg * kS);
        float po = 0.f;
#pragma unroll
        for (int i = 0; i < 8; ++i) { S[i] = eg * S[i] + ks[part * 8 + i] * vn; po += qs[part * 8 + i] * S[i]; }
        red2[part][dvl] = po; __syncthreads();
        if (part == 0) { float o = 0.f;
#pragma unroll
            for (int i = 0; i < 16; ++i) o += red2[i][dvl];
            odn[row * 512 + h * 128 + sl * 16 + dvl] = o * scale; }
    }
}
__global__ void k_fin_dn(const float* odn, const bf16* proj, const float* dn_norm, bf16* mix) {
    const int row = blockIdx.x, h = blockIdx.y, dv = threadIdx.x; __shared__ float red[2];
    const float o = odn[(size_t)row * 512 + h * 128 + dv]; float q = wave_sum(o * o); if ((dv & 63) == 0) red[dv >> 6] = q; __syncthreads();
    const float rs = rsqrtf((red[0] + red[1]) * (1.f / 128) + EPS);
    mix[(size_t)row * D + h * 128 + dv] = f2bf(o * rs * dn_norm[dv] * siluf_(bf2f(proj[(size_t)row * NP + PC_Z + h * 128 + dv])));
}
__global__ void __launch_bounds__(512) k_rg_prep(const bf16* proj, const float* conv, const float* convb, const float* w_a, const float* b_a,
                                                   const float* w_x, const float* b_x, const float* lam, float* aa, float* bx) {
    const int row = blockIdx.x, t = row % T, ch = threadIdx.x; __shared__ float xr[512];
    float s = convb[ch];
#pragma unroll
    for (int j = 0; j < 4; ++j) { const int tt = t + j - 3; if (tt >= 0) s += conv[j * 512 + ch] * bf2f(proj[(size_t)(row + j - 3) * NP + PC_RX + ch]); }
    xr[ch] = s; __syncthreads();
    const int nb = ch >> 7, o = ch & 127; float ra = b_a[ch], rx_ = b_x[ch];
    for (int i = 0; i < 128; ++i) { const float xv = xr[nb * 128 + i]; ra += xv * w_a[(nb * 128 + i) * 128 + o]; rx_ += xv * w_x[(nb * 128 + i) * 128 + o]; }
    const float r = sigmoidf_(ra), ig = sigmoidf_(rx_);
    const float log_a = 8.f * r * (-softplusf_(-lam[ch])); const float a = __expf(log_a);
    float mult = sqrtf(fmaxf(-expm1f(2.f * log_a), 0.f)); if (t == 0) mult = 1.f;
    aa[(size_t)row * 512 + ch] = a; bx[(size_t)row * 512 + ch] = mult * (ig * s);
}
__global__ void k_rg_scan(const float* aa, const float* bx, const bf16* proj, bf16* mix) {
    const int i = blockIdx.x * blockDim.x + threadIdx.x, b = i >> 9, ch = i & 511; float h = 0.f;
    for (int t0 = 0; t0 < T; t0 += 8) { float a[8], x[8], y[8];
#pragma unroll
        for (int j = 0; j < 8; ++j) { const size_t row = (size_t)b * T + t0 + j; a[j] = aa[row * 512 + ch]; x[j] = bx[row * 512 + ch]; y[j] = bf2f(proj[row * NP + PC_RY + ch]); }
#pragma unroll
        for (int j = 0; j < 8; ++j) { h = a[j] * h + x[j]; mix[((size_t)b * T + t0 + j) * D + 512 + ch] = f2bf(h * gelu_tanh(y[j])); } }
}
__global__ void k_softmax(const float* sc, bf16* p) {
    const int row = blockIdx.x, h = blockIdx.y, k = threadIdx.x; __shared__ float red[4];
    const float s = sc[(size_t)row * 1024 + h * 256 + k]; float m = s;
#pragma unroll
    for (int o = 1; o < 64; o <<= 1) m = fmaxf(m, __shfl_xor(m, o));
    if ((k & 63) == 0) red[k >> 6] = m; __syncthreads(); m = fmaxf(fmaxf(red[0], red[1]), fmaxf(red[2], red[3])); __syncthreads();
    const float e = __expf(s - m); float q = wave_sum(e); if ((k & 63) == 0) red[k >> 6] = q; __syncthreads(); q = red[0] + red[1] + red[2] + red[3];
    p[(size_t)row * 1024 + h * 256 + k] = f2bf(e / q);
}
__global__ void k_route(const float* hres, const float* ss, const float* g, const float* wr, const float* br, float* rstd2, unsigned* cnt, int* tokl, float* gatel, float* rsl) {
    const int row = blockIdx.x * (blockDim.x >> 6) + (threadIdx.x >> 6), lane = threadIdx.x & 63, e = lane & 31, half = lane >> 5;
    const float rs = rsqrtf(ss[row] * (1.f / D) + EPS); float acc = 0.f;
    for (int k = half * 512; k < half * 512 + 512; ++k) acc += hres[(size_t)row * D + k] * g[k] * wr[k * NE + e];
    acc += __shfl_xor(acc, 32); float logit = acc * rs + br[e];
    float tl[4]; int te[4];
#pragma unroll
    for (int q = 0; q < 4; ++q) { float m = logit; int mi = e;
#pragma unroll
        for (int o = 1; o < 32; o <<= 1) { const float om = __shfl_xor(m, o); const int oi = __shfl_xor(mi, o); if (om > m || (om == m && oi < mi)) { m = om; mi = oi; } }
        tl[q] = m; te[q] = mi; if (e == mi) logit = -3.0e38f; }
    const float e1 = __expf(tl[1] - tl[0]), e2 = __expf(tl[2] - tl[0]), e3 = __expf(tl[3] - tl[0]), inv = 1.f / (1.f + e1 + e2 + e3);
    const float gt[4] = {inv, e1 * inv, e2 * inv, e3 * inv};
    if (lane < 4) { const int ex = lane == 0 ? te[0] : lane == 1 ? te[1] : lane == 2 ? te[2] : te[3]; const float gv = lane == 0 ? gt[0] : lane == 1 ? gt[1] : lane == 2 ? gt[2] : gt[3];
        const unsigned pos = atomicAdd(&cnt[ex], 1u); tokl[ex * M + pos] = row * 4 + lane; gatel[ex * M + pos] = gv; rsl[ex * M + pos] = rs; }
    if (lane == 0) rstd2[row] = rs;
}
__global__ void k_combine(float* out, const bf16* y, const float* g) {
    const int row = blockIdx.x * (blockDim.x >> 6) + (threadIdx.x >> 6), lane = threadIdx.x & 63; float v[16]; float s = 0.f;
#pragma unroll
    for (int j = 0; j < 16; ++j) { const int c = lane + 64 * j; float h = out[(size_t)row * D + c];
#pragma unroll
        for (int k = 0; k < 4; ++k) h += bf2f(y[((size_t)row * 4 + k) * D + c]);
        v[j] = h; s += h * h; }
    const float rs = rsqrtf(wave_sum(s) * (1.f / D) + EPS);
#pragma unroll
    for (int j = 0; j < 16; ++j) { const int c = lane + 64 * j; out[(size_t)row * D + c] = v[j] * rs * g[c]; }
}

namespace pg8 {
#define PG8_LAS __attribute__((address_space(3)))
typedef unsigned short bf16_t;
typedef short bf16x8 __attribute__((ext_vector_type(8)));
typedef float f32x4 __attribute__((ext_vector_type(4)));
typedef unsigned u32x4 __attribute__((ext_vector_type(4)));
constexpr int BM = 256, BK = 64, HALF = 128, HTB = HALF * BK * 2, STAGE_BYTES = 8 * HTB, NXCD = 8, WGM = 8;

__host__ __device__ __forceinline__ int lds_byte(int r, int c) { const int st = (r >> 4) * 2 + (c >> 5), rr = r & 15, cc = c & 31, ob = rr * 64 + cc * 2; return st * 1024 + (ob ^ (((ob >> 9) & 1) << 5)); }
__host__ __device__ __forceinline__ void stage_rc(int b, int& R, int& C) { const int st = b / 1024, sb = b % 1024, swz = sb ^ (((sb >> 9) & 1) << 5); R = (st >> 1) * 16 + swz / 64; C = (st & 1) * 32 + (swz % 64) / 2; }
__host__ __device__ __forceinline__ int perm32(int rho) { const int n = rho >> 4, i = rho & 15; return 8 * (i >> 2) + 4 * n + (i & 3); }

struct Unit { int pm, pn; const char* a; const char* b; int e, j; };
struct Gemm { int lda, ldb, K; };

struct StaticOrder {
    int nM, nN, nwg, G, c; const char* A; const char* Bt; size_t astep, bstep;
    __device__ void init(const void* A_, const void* Bt_, int M, int N, int lda, int ldb, int G_, int c_) { nM = M / BM; nN = N / BM; nwg = nM * nN; G = G_; c = c_; A = (const char*)A_; Bt = (const char*)Bt_; astep = (size_t)BM * lda * 2; bstep = (size_t)BM * ldb * 2; }
    __device__ bool next(int i, Unit& u) const {
        const long L = (long)i * G + c; if (L >= nwg) return false;
        int wgid = (int)L; { const int q = nwg / NXCD, r = nwg % NXCD, xcd = wgid % NXCD, off = wgid / NXCD; wgid = (xcd < r ? xcd * (q + 1) : r * (q + 1) + (xcd - r) * q) + off; }
        const int nig = WGM * nN, gid = wgid / nig, fm = gid * WGM, gsz = (nM - fm) < WGM ? (nM - fm) : WGM;
        u.pm = fm + ((wgid % nig) % gsz); u.pn = (wgid % nig) / gsz; u.a = A + (size_t)u.pm * astep; u.b = Bt + (size_t)u.pn * bstep; u.e = 0; u.j = 0; return true;
    }
    __device__ __forceinline__ int arow(const Unit&, int) const { return 0; }
};
struct OneUnit {
    Unit u0;
    __device__ bool next(int i, Unit& u) const { if (i != 0) return false; u = u0; return true; }
    __device__ __forceinline__ int arow(const Unit&, int) const { return 0; }
};

__device__ __forceinline__ unsigned cvt_pk_bf16(float lo, float hi) { unsigned r; asm volatile("v_cvt_pk_bf16_f32 %0, %1, %2" : "=v"(r) : "v"(lo), "v"(hi)); return r; }

typedef f32x4 Acc[2][2][4][2];

template <class Epi, class Sched, bool ALIGN_EPI, bool GATHER>
__device__ __forceinline__ void gemm_phase(PG8_LAS unsigned char* lds, const Gemm g, const Sched& S, const Epi& E) {
    const int tid = threadIdx.x, wid = __builtin_amdgcn_readfirstlane(tid >> 6), lane = tid & 63, wr = wid >> 2, wc = wid & 3, fr = lane & 15, fq = lane >> 4;
    const int nt = g.K / BK;
    unsigned voffA[2], voffB[2]; int RA[2], CA[2];
#pragma unroll
    for (int i = 0; i < 2; ++i) { int R, C; stage_rc(tid * 16 + i * 8192, R, C); const int Rb = (R & ~31) + perm32(R & 31);
        voffA[i] = (unsigned)(R * g.lda + C) * 2u; voffB[i] = (unsigned)(Rb * g.ldb + C) * 2u; RA[i] = R; CA[i] = C; }
    const size_t kstep = (size_t)(BK * 2);
    const size_t hstepA = (size_t)HALF * g.lda * 2, hstepB = (size_t)HALF * g.ldb * 2;
    const unsigned ldsw = (unsigned)wid * 1024u;
    const int aoff = lds_byte(wr * 64 + fr, fq * 8), boff = lds_byte(wc * 32 + fr, fq * 8);
    unsigned aoC[2][2], aoN[2][2];
#define PG8_SA(b, h) (((b) * 2 + (h)) * HTB)
#define PG8_SB(b, h) ((4 + (b) * 2 + (h)) * HTB)
#define PG8_STAGE(bufoff, gbase, voff) do { _Pragma("unroll") for (int _i = 0; _i < 2; ++_i) \
        __builtin_amdgcn_global_load_lds((const unsigned*)((const char*)(gbase) + (voff)[_i]), (PG8_LAS unsigned*)(lds + (bufoff) + ldsw + _i * 8192), 16, 0, 0); } while (0)
#define PG8_STAGE_A(bufoff, gbase, h, nx) do { if constexpr (GATHER) { unsigned _v[2]; _v[0] = (nx) ? aoN[h][0] : aoC[h][0]; _v[1] = (nx) ? aoN[h][1] : aoC[h][1]; PG8_STAGE(bufoff, gbase, _v); } \
        else { PG8_STAGE(bufoff, (gbase) + (h) * hstepA, voffA); } } while (0)
#define PG8_GOFF(dst, un) do { _Pragma("unroll") for (int _h = 0; _h < 2; ++_h) _Pragma("unroll") for (int _i = 0; _i < 2; ++_i) \
        dst[_h][_i] = (unsigned)(S.arow(un, _h * HALF + RA[_i]) * g.lda + CA[_i]) * 2u; } while (0)
#define PG8_LDA(dst, b, h) do { _Pragma("unroll") for (int m = 0; m < 4; ++m) _Pragma("unroll") for (int k = 0; k < 2; ++k) dst[m][k] = *(const PG8_LAS bf16x8*)(lds + PG8_SA(b, h) + aoff + m * 2048 + k * 1024); } while (0)
#define PG8_LDB(dst, b, h) do { _Pragma("unroll") for (int n = 0; n < 2; ++n) _Pragma("unroll") for (int k = 0; k < 2; ++k) dst[n][k] = *(const PG8_LAS bf16x8*)(lds + PG8_SB(b, h) + boff + n * 2048 + k * 1024); } while (0)
#define PG8_MMA(ai, bj, At, Bt) do { __builtin_amdgcn_s_setprio(1); _Pragma("unroll") for (int m = 0; m < 4; ++m) _Pragma("unroll") for (int n = 0; n < 2; ++n) _Pragma("unroll") for (int k = 0; k < 2; ++k) \
        acc[ai][bj][m][n] = __builtin_amdgcn_mfma_f32_16x16x32_bf16(Bt[n][k], At[m][k], acc[ai][bj][m][n], 0, 0, 0); __builtin_amdgcn_s_setprio(0); } while (0)
#define PG8_WAIT_V(n) asm volatile("s_waitcnt vmcnt(" #n ")" ::: "memory")
#define PG8_WAIT_L(n) asm volatile("s_waitcnt lgkmcnt(" #n ")" ::: "memory")
#define PG8_BAR __builtin_amdgcn_s_barrier()
#define PG8_SCHED __builtin_amdgcn_sched_barrier(0)
    Unit cur, nxt; int ui = 0;
    if (!S.next(0, cur)) return;
    if constexpr (GATHER) { PG8_GOFF(aoC, cur); }
    Acc acc;
#pragma unroll
    for (int a = 0; a < 2; ++a)
#pragma unroll
        for (int b = 0; b < 2; ++b)
#pragma unroll
            for (int m = 0; m < 4; ++m)
#pragma unroll
                for (int n = 0; n < 2; ++n) acc[a][b][m][n] = (f32x4){0.f, 0.f, 0.f, 0.f};
    bf16x8 At[4][2], B0[2][2], B1[2][2];
    const char* cA = cur.a; const char* cB = cur.b;
    PG8_STAGE(PG8_SB(0, 0), cB, voffB); PG8_STAGE(PG8_SB(0, 1), cB + hstepB, voffB); PG8_STAGE_A(PG8_SA(0, 0), cA, 0, false); PG8_STAGE_A(PG8_SA(0, 1), cA, 1, false);
    if (wr == 1) PG8_BAR;
    PG8_WAIT_V(2); PG8_BAR;
    PG8_STAGE(PG8_SB(1, 0), cB + kstep, voffB); PG8_STAGE_A(PG8_SA(1, 0), cA + kstep, 0, false); PG8_STAGE(PG8_SB(1, 1), cB + hstepB + kstep, voffB);
    PG8_WAIT_V(6); PG8_BAR;
    for (;;) {
        const bool has_next = S.next(ui + 1, nxt);
        if constexpr (GATHER) { if (has_next) { PG8_GOFF(aoN, nxt); } else {
#pragma unroll
            for (int _h = 0; _h < 2; ++_h) { aoN[_h][0] = aoC[_h][0]; aoN[_h][1] = aoC[_h][1]; } } }
        const char* nA = has_next ? nxt.a : cA; const char* nB = has_next ? nxt.b : cB;
        for (int t = 0; t < nt; t += 2) {
            const bool last = (t == nt - 2);
            const char* a1 = cA + (size_t)(t + 1) * kstep;
            const char* a2 = last ? nA : cA + (size_t)(t + 2) * kstep; const char* b2 = last ? nB : cB + (size_t)(t + 2) * kstep;
            const char* a3 = a2 + kstep; const char* b3 = b2 + kstep;
            PG8_LDB(B0, 0, 0); PG8_LDB(B1, 0, 1); PG8_SCHED; PG8_LDA(At, 0, 0); PG8_STAGE_A(PG8_SA(1, 1), a1, 1, false);
            PG8_WAIT_V(8); PG8_WAIT_L(0); PG8_BAR; PG8_MMA(0, 0, At, B0); PG8_MMA(0, 1, At, B1); PG8_BAR; PG8_SCHED;
            PG8_LDA(At, 0, 1); PG8_STAGE(PG8_SB(0, 0), b2, voffB); PG8_STAGE(PG8_SB(0, 1), b2 + hstepB, voffB); PG8_STAGE_A(PG8_SA(0, 0), a2, 0, last);
            PG8_WAIT_V(8); PG8_WAIT_L(0); PG8_BAR; PG8_MMA(1, 0, At, B0); PG8_MMA(1, 1, At, B1); PG8_BAR; PG8_SCHED;
            PG8_LDB(B0, 1, 0); PG8_LDB(B1, 1, 1); PG8_SCHED; PG8_LDA(At, 1, 0); PG8_STAGE_A(PG8_SA(0, 1), a2, 1, last);
            PG8_WAIT_V(8); PG8_WAIT_L(0); PG8_BAR; PG8_MMA(0, 0, At, B0); PG8_MMA(0, 1, At, B1); PG8_BAR; PG8_SCHED;
            PG8_LDA(At, 1, 1); PG8_STAGE(PG8_SB(1, 0), b3, voffB); PG8_STAGE(PG8_SB(1, 1), b3 + hstepB, voffB); PG8_STAGE_A(PG8_SA(1, 0), a3, 0, last);
            PG8_WAIT_V(8); PG8_WAIT_L(0); PG8_BAR; PG8_MMA(1, 0, At, B0); PG8_MMA(1, 1, At, B1); PG8_BAR; PG8_SCHED;
        }
        if constexpr (ALIGN_EPI) { if (wr == 0) PG8_BAR; }
        if constexpr (!Epi::AFTER_DRAIN) { E(acc, cur, wr, wc, fr, fq); }
        if (!has_next) break;
#pragma unroll
        for (int a = 0; a < 2; ++a)
#pragma unroll
            for (int b = 0; b < 2; ++b)
#pragma unroll
                for (int m = 0; m < 4; ++m)
#pragma unroll
                    for (int n = 0; n < 2; ++n) acc[a][b][m][n] = (f32x4){0.f, 0.f, 0.f, 0.f};
        cur = nxt; cA = nA; cB = nB; ++ui;
        if constexpr (GATHER) {
#pragma unroll
            for (int _h = 0; _h < 2; ++_h) { aoC[_h][0] = aoN[_h][0]; aoC[_h][1] = aoN[_h][1]; } }
        if constexpr (ALIGN_EPI) { if (wr == 1) PG8_BAR; }
    }
    PG8_WAIT_V(0);
    if constexpr (!ALIGN_EPI) { if (wr == 0) PG8_BAR; }
    PG8_BAR;
    if constexpr (Epi::AFTER_DRAIN) { E.fused(acc, cur, wr, wc, fr, fq, lds); }
#undef PG8_SA
#undef PG8_SB
#undef PG8_STAGE
#undef PG8_STAGE_A
#undef PG8_GOFF
#undef PG8_LDA
#undef PG8_LDB
#undef PG8_MMA
#undef PG8_WAIT_V
#undef PG8_WAIT_L
#undef PG8_BAR
#undef PG8_SCHED
}

struct EpiStore {
    static constexpr bool AFTER_DRAIN = false; bf16_t* O; int ldc;
    __device__ __forceinline__ void operator()(const Acc& acc, const Unit& u, int wr, int wc, int fr, int fq) const {
        const int row0 = u.pm * BM + wr * 64 + fr, col0 = u.pn * BM + wc * 32 + 8 * fq;
#pragma unroll
        for (int ai = 0; ai < 2; ++ai)
#pragma unroll
            for (int m = 0; m < 4; ++m) { bf16_t* rowp = O + (size_t)(row0 + ai * HALF + m * 16) * ldc + col0;
#pragma unroll
                for (int bj = 0; bj < 2; ++bj) { const f32x4 v0 = acc[ai][bj][m][0], v1 = acc[ai][bj][m][1];
                    u32x4 w; w.x = cvt_pk_bf16(v0[0], v0[1]); w.y = cvt_pk_bf16(v0[2], v0[3]); w.z = cvt_pk_bf16(v1[0], v1[1]); w.w = cvt_pk_bf16(v1[2], v1[3]);
                    *(u32x4*)(rowp + bj * HALF) = w; } }
    }
};
struct EpiResid {
    static constexpr bool AFTER_DRAIN = false; const float* R; float* H; bf16_t* HB; float* SS;
    __device__ __forceinline__ void operator()(const Acc& acc, const Unit& u, int wr, int wc, int fr, int fq) const {
        const int row0 = u.pm * BM + wr * 64 + fr, col0 = u.pn * BM + wc * 32 + 8 * fq;
#pragma unroll
        for (int ai = 0; ai < 2; ++ai)
#pragma unroll
            for (int m = 0; m < 4; ++m) { const int row = row0 + ai * HALF + m * 16; const size_t off = (size_t)row * D + col0; float sq = 0.f;
#pragma unroll
                for (int bj = 0; bj < 2; ++bj) { const f32x4 r0 = *(const f32x4*)(R + off + bj * HALF), r1 = *(const f32x4*)(R + off + bj * HALF + 4);
                    const f32x4 v0 = acc[ai][bj][m][0] + r0, v1 = acc[ai][bj][m][1] + r1;
                    *(f32x4*)(H + off + bj * HALF) = v0; *(f32x4*)(H + off + bj * HALF + 4) = v1;
                    u32x4 w; w.x = cvt_pk_bf16(v0[0], v0[1]); w.y = cvt_pk_bf16(v0[2], v0[3]); w.z = cvt_pk_bf16(v1[0], v1[1]); w.w = cvt_pk_bf16(v1[2], v1[3]);
                    *(u32x4*)(HB + off + bj * HALF) = w;
                    sq += (v0[0] * v0[0] + v0[1] * v0[1]) + (v0[2] * v0[2] + v0[3] * v0[3]) + (v1[0] * v1[0] + v1[1] * v1[1]) + (v1[2] * v1[2] + v1[3] * v1[3]); }
                sq += __shfl_xor(sq, 16); sq += __shfl_xor(sq, 32);
                if (fq == 0) atomicAdd(SS + row, sq); }
    }
};
struct EpiRowScale {
    static constexpr bool AFTER_DRAIN = false; bf16_t* O; const float* SS; float s;
    __device__ __forceinline__ void operator()(const Acc& acc, const Unit& u, int wr, int wc, int fr, int fq) const {
        const int row0 = u.pm * BM + wr * 64 + fr, col0 = u.pn * BM + wc * 32 + 8 * fq;
#pragma unroll
        for (int ai = 0; ai < 2; ++ai)
#pragma unroll
            for (int m = 0; m < 4; ++m) { const int row = row0 + ai * HALF + m * 16; const float rs = rsqrtf(SS[row] * (1.f / D) + EPS) * s; bf16_t* rowp = O + (size_t)row * D + col0;
#pragma unroll
                for (int bj = 0; bj < 2; ++bj) { const f32x4 v0 = acc[ai][bj][m][0] * rs, v1 = acc[ai][bj][m][1] * rs;
                    u32x4 w; w.x = cvt_pk_bf16(v0[0], v0[1]); w.y = cvt_pk_bf16(v0[2], v0[3]); w.z = cvt_pk_bf16(v1[0], v1[1]); w.w = cvt_pk_bf16(v1[2], v1[3]);
                    *(u32x4*)(rowp + bj * HALF) = w; } }
    }
};
struct EpiSoftmax {
    static constexpr bool AFTER_DRAIN = true; bf16_t* P;
    __device__ __forceinline__ void operator()(const Acc&, const Unit&, int, int, int, int) const {}
    __device__ __forceinline__ void fused(Acc& acc, const Unit& u, int wr, int wc, int fr, int fq, PG8_LAS unsigned char* lds) const {
        PG8_LAS float* xm = (PG8_LAS float*)lds; PG8_LAS float* xs = xm + 1024;
#pragma unroll
        for (int ai = 0; ai < 2; ++ai)
#pragma unroll
            for (int m = 0; m < 4; ++m) { float mx = -3.0e38f;
#pragma unroll
                for (int bj = 0; bj < 2; ++bj)
#pragma unroll
                    for (int n = 0; n < 2; ++n) { const f32x4 v = acc[ai][bj][m][n]; mx = fmaxf(mx, fmaxf(fmaxf(v[0], v[1]), fmaxf(v[2], v[3]))); }
                mx = fmaxf(mx, __shfl_xor(mx, 16)); mx = fmaxf(mx, __shfl_xor(mx, 32));
                if (fq == 0) xm[(ai * HALF + wr * 64 + m * 16 + fr) * 4 + wc] = mx; }
        __syncthreads();
#pragma unroll
        for (int ai = 0; ai < 2; ++ai)
#pragma unroll
            for (int m = 0; m < 4; ++m) { const int r = ai * HALF + wr * 64 + m * 16 + fr; const f32x4 q = *(const PG8_LAS f32x4*)(xm + r * 4);
                const float mx = fmaxf(fmaxf(q[0], q[1]), fmaxf(q[2], q[3])); float sm = 0.f;
#pragma unroll
                for (int bj = 0; bj < 2; ++bj)
#pragma unroll
                    for (int n = 0; n < 2; ++n) { f32x4 v = acc[ai][bj][m][n]; v[0] = __expf(v[0] - mx); v[1] = __expf(v[1] - mx); v[2] = __expf(v[2] - mx); v[3] = __expf(v[3] - mx);
                        acc[ai][bj][m][n] = v; sm += (v[0] + v[1]) + (v[2] + v[3]); }
                sm += __shfl_xor(sm, 16); sm += __shfl_xor(sm, 32);
                if (fq == 0) xs[r * 4 + wc] = sm; }
        __syncthreads();
        const int row0 = u.pm * BM, col0 = u.pn * BM + wc * 32 + 8 * fq;
#pragma unroll
        for (int ai = 0; ai < 2; ++ai)
#pragma unroll
            for (int m = 0; m < 4; ++m) { const int r = ai * HALF + wr * 64 + m * 16 + fr; const f32x4 q = *(const PG8_LAS f32x4*)(xs + r * 4);
                const float inv = 1.f / ((q[0] + q[1]) + (q[2] + q[3])); bf16_t* rowp = P + (size_t)(row0 + r) * D + col0;
#pragma unroll
                for (int bj = 0; bj < 2; ++bj) { const f32x4 v0 = acc[ai][bj][m][0] * inv, v1 = acc[ai][bj][m][1] * inv;
                    u32x4 w; w.x = cvt_pk_bf16(v0[0], v0[1]); w.y = cvt_pk_bf16(v0[2], v0[3]); w.z = cvt_pk_bf16(v1[0], v1[1]); w.w = cvt_pk_bf16(v1[2], v1[3]);
                    *(u32x4*)(rowp + bj * HALF) = w; } }
        __syncthreads();
    }
};
struct EpiFFN1 {
    static constexpr bool AFTER_DRAIN = false; bf16_t* HID; const float* RSL; const float* bg; const float* bu; const PG8_LAS int* cntl;
    __device__ __forceinline__ void operator()(const Acc& acc, const Unit& u, int wr, int wc, int fr, int fq) const {
        const int cnt = cntl[u.e], c0 = u.pn * HALF + wc * 32 + 8 * fq;
        const f32x4 g0 = *(const f32x4*)(bg + u.e * 1024 + c0), g1 = *(const f32x4*)(bg + u.e * 1024 + c0 + 4), u0 = *(const f32x4*)(bu + u.e * 1024 + c0), u1 = *(const f32x4*)(bu + u.e * 1024 + c0 + 4);
#pragma unroll
        for (int ai = 0; ai < 2; ++ai)
#pragma unroll
            for (int m = 0; m < 4; ++m) { const int r = ai * HALF + wr * 64 + m * 16 + fr, pos = u.j * BM + r; const float rs = pos < cnt ? RSL[u.e * M + pos] : 0.f;
                const f32x4 a0 = acc[ai][0][m][0] * rs + g0, a1 = acc[ai][0][m][1] * rs + g1, b0 = acc[ai][1][m][0] * rs + u0, b1 = acc[ai][1][m][1] * rs + u1;
                u32x4 w; w.x = cvt_pk_bf16(ffn_act(a0[0], b0[0]), ffn_act(a0[1], b0[1])); w.y = cvt_pk_bf16(ffn_act(a0[2], b0[2]), ffn_act(a0[3], b0[3]));
                w.z = cvt_pk_bf16(ffn_act(a1[0], b1[0]), ffn_act(a1[1], b1[1])); w.w = cvt_pk_bf16(ffn_act(a1[2], b1[2]), ffn_act(a1[3], b1[3]));
                *(u32x4*)(HID + (size_t)(u.pm * BM + r) * 1024 + c0) = w; }
    }
};
struct EpiFFN2 {
    static constexpr bool AFTER_DRAIN = false; bf16_t* Y; const int* TOKL; const float* GATEL; const float* bd; const PG8_LAS int* cntl;
    __device__ __forceinline__ void operator()(const Acc& acc, const Unit& u, int wr, int wc, int fr, int fq) const {
        const int cnt = cntl[u.e], c0 = u.pn * BM + wc * 32 + 8 * fq;
        f32x4 bv[2][2];
#pragma unroll
        for (int bj = 0; bj < 2; ++bj) { bv[bj][0] = *(const f32x4*)(bd + u.e * 1024 + c0 + bj * HALF); bv[bj][1] = *(const f32x4*)(bd + u.e * 1024 + c0 + bj * HALF + 4); }
#pragma unroll
        for (int ai = 0; ai < 2; ++ai)
#pragma unroll
            for (int m = 0; m < 4; ++m) { const int r = ai * HALF + wr * 64 + m * 16 + fr, pos = u.j * BM + r;
                if (pos < cnt) { const int dst = TOKL[u.e * M + pos]; const float gt = GATEL[u.e * M + pos]; bf16_t* rowp = Y + (size_t)dst * 1024 + c0;
#pragma unroll
                    for (int bj = 0; bj < 2; ++bj) { const f32x4 v0 = (acc[ai][bj][m][0] + bv[bj][0]) * gt, v1 = (acc[ai][bj][m][1] + bv[bj][1]) * gt;
                        u32x4 w; w.x = cvt_pk_bf16(v0[0], v0[1]); w.y = cvt_pk_bf16(v0[2], v0[3]); w.z = cvt_pk_bf16(v1[0], v1[1]); w.w = cvt_pk_bf16(v1[2], v1[3]);
                        *(u32x4*)(rowp + bj * HALF) = w; } } }
    }
};
template <int NPN, bool IS_FFN1> struct MoeOrder {
    int G, c; const PG8_LAS int* tstart; const PG8_LAS int* cntl; const char* A; const char* W; const int* TOKL;
    __device__ bool next(int i, Unit& u) const {
        const int L = i * G + c, nrt = tstart[32]; if (L >= nrt * NPN) return false;
        const int rt = L / NPN, pn = L % NPN; int e = 0;
        for (int q = 1; q < 32; ++q) e += (tstart[q] <= rt) ? 1 : 0;
        u.pm = rt; u.pn = pn; u.e = e; u.j = rt - tstart[e];
        if (IS_FFN1) { u.a = A; u.b = W + ((size_t)e * 2048 + (size_t)pn * 256) * 2048; }
        else { u.a = A + (size_t)rt * 256 * 2048; u.b = W + ((size_t)e * 1024 + (size_t)pn * 256) * 2048; }
        return true;
    }
    __device__ __forceinline__ int arow(const Unit& u, int r) const { const int pos = u.j * BM + r; return pos < cntl[u.e] ? (TOKL[u.e * M + pos] >> 2) : 0; }
};
}

#define GAS __attribute__((address_space(1)))
#define LAS __attribute__((address_space(3)))
typedef unsigned v4u __attribute__((ext_vector_type(4)));
typedef float f32x4 __attribute__((ext_vector_type(4)));
typedef GAS unsigned gu32;
constexpr int NWAVES = 8, NTHR = 512;
constexpr int RING_BYTES = 131072, LDSCTL_OFF = RING_BYTES, LDS_BYTES = 163840;
constexpr int LW_BAR = 0, LW_TSTART = 16, LW_CNT = 64, LW_NWORDS = 128;
constexpr int CW_BAR = 1024;

#define XB_TMO      128
#define XB_XCNT(j)  (256  + 64 * (j))
#define XB_XSUB(j)  (1280 + 64 * (j))
#define XB_XGEN(j)  (2304 + 64 * (j))
#define XB_TOP      3328
#define XB_TOPGEN   3392
#define XCD_BAR_WORDS 3456
#define XB_SPIN_CAP (1u << 18)
__device__ __forceinline__ unsigned xb_ld(unsigned* p)              { return __hip_atomic_load(p, __ATOMIC_RELAXED, __HIP_MEMORY_SCOPE_AGENT); }
__device__ __forceinline__ unsigned xb_add(unsigned* p, unsigned v) { return __hip_atomic_fetch_add(p, v, __ATOMIC_RELAXED, __HIP_MEMORY_SCOPE_AGENT); }
__device__ __forceinline__ unsigned xb_xcc_id() { return (unsigned)__builtin_amdgcn_s_getreg((3 << 11) | 20) & 0xFu; }
#define XB_SPIN(cond, bar) do { unsigned _sp = 0; while (cond) { __builtin_amdgcn_s_sleep(1); \
    if ((++_sp & 255u) == 0u) { if (xb_ld(&(bar)[XB_TMO])) break; if (_sp > XB_SPIN_CAP) { atomicAdd(&(bar)[XB_TMO], 1u); break; } } } } while (0)
struct XcdBarrier { unsigned* bar; unsigned x; volatile LAS unsigned* st; };
__device__ __forceinline__ XcdBarrier xcd_barrier_post(unsigned* bar, volatile LAS unsigned* st) {
    XcdBarrier b; b.bar = bar; b.x = xb_xcc_id(); b.st = st;
    if (threadIdx.x == 0) (void)xb_add(&bar[XB_XCNT(b.x)], 1u);
    return b;
}
__device__ __forceinline__ void xcd_barrier_complete(unsigned* bar, unsigned x, unsigned& nloc, unsigned& nx) {
    const unsigned G = gridDim.x * gridDim.y * gridDim.z;
    unsigned sum, cnt, mine, sp = 0u;
    for (;;) {
        sum = 0u; cnt = 0u; mine = 0u;
#pragma unroll
        for (unsigned j = 0; j < 16; ++j) { const unsigned c = xb_ld(&bar[XB_XCNT(j)]); sum += c; cnt += (c > 0u) ? 1u : 0u; mine = (j == x) ? c : mine; }
        if (sum == G) break;
        __builtin_amdgcn_s_sleep(1);
        if ((++sp & 255u) == 0u) { if (xb_ld(&bar[XB_TMO])) break; if (sp > XB_SPIN_CAP) { atomicAdd(&bar[XB_TMO], 1u); break; } }
    }
    nloc = mine > 0u ? mine : 1u; nx = cnt > 0u ? cnt : 1u;
}
__device__ __forceinline__ void xcd_barrier(const XcdBarrier& b) {
    asm volatile("s_waitcnt vmcnt(0)" ::: "memory");
    __syncthreads();
    if (threadIdx.x == 0) {
        unsigned* bar = b.bar;
        __builtin_amdgcn_s_waitcnt(0);
        unsigned nloc = b.st[0], nx = b.st[1];
        if (nloc == 0u) { xcd_barrier_complete(bar, b.x, nloc, nx); b.st[0] = nloc; b.st[1] = nx; }
        const unsigned old = xb_add(&bar[XB_XSUB(b.x)], 1u);
        const unsigned gen = old / nloc;
        if (old + 1u == (gen + 1u) * nloc) {
            __builtin_amdgcn_fence(__ATOMIC_RELEASE, "agent");
            asm volatile("s_waitcnt vmcnt(0)" ::: "memory");
            const unsigned og = xb_add(&bar[XB_TOP], 1u);
            const unsigned tg = og / nx;
            if (og + 1u == (tg + 1u) * nx) xb_add(&bar[XB_TOPGEN], 1u);
            else XB_SPIN(xb_ld(&bar[XB_TOPGEN]) == tg, bar);
            __builtin_amdgcn_fence(__ATOMIC_ACQUIRE, "agent");
            xb_add(&bar[XB_XGEN(b.x)], 1u);
            asm volatile("s_waitcnt vmcnt(0)" ::: "memory");
        } else {
            XB_SPIN(xb_ld(&bar[XB_XGEN(b.x)]) == gen, bar);
            __builtin_amdgcn_fence(__ATOMIC_ACQUIRE, "agent");
            asm volatile("s_waitcnt vmcnt(0)" ::: "memory");
        }
    }
    __syncthreads();
}

struct Args { const float* in[31]; float* out; unsigned char* ws; int ph_lo, ph_hi, bli, pad; };

#define LDS_WAIT() asm volatile("s_waitcnt lgkmcnt(0)" ::: "memory")
__device__ __forceinline__ unsigned pk2(float lo, float hi) { return (unsigned)f2bf(lo) | ((unsigned)f2bf(hi) << 16); }
__device__ __forceinline__ void transpose_item(const float* W, int ldn, int col0, int k0, bf16* dst, int pitch, const float* gain, LAS float* scr, int lane) {
#pragma unroll 8
    for (int i = 0; i < 32; ++i) { const int kk = 2 * i + (lane >> 5); float v = W[(size_t)(k0 + kk) * ldn + col0 + (lane & 31)]; if (gain) v *= gain[k0 + kk]; scr[kk * 33 + (lane & 31)] = v; }
    LDS_WAIT(); asm volatile("" ::: "memory");
    const int c = lane & 7;
#pragma unroll
    for (int j = 0; j < 4; ++j) { const int n = (lane >> 3) + 8 * j; const LAS float* s = scr + (8 * c) * 33 + n;
        v4u o; o.x = pk2(s[0 * 33], s[1 * 33]); o.y = pk2(s[2 * 33], s[3 * 33]); o.z = pk2(s[4 * 33], s[5 * 33]); o.w = pk2(s[6 * 33], s[7 * 33]);
        *(GAS v4u*)(dst + (size_t)n * pitch + k0 + 8 * c) = o; }
    LDS_WAIT(); asm volatile("" ::: "memory");
}

__device__ __forceinline__ const float* arg_in(const Args& a, int k) { asm volatile("" : "+s"(k)); return a.in[k]; }
#define INP(k) arg_in(args, k)
#define PHASE_PTRS unsigned char* wsl = args.ws; asm volatile("" : "+s"(wsl)); float* out = args.out; asm volatile("" : "+s"(out)); unsigned* ctl = (unsigned*)(wsl + WS_CTL); const float *x = INP(0), *mem = INP(1), *norm_mix = INP(2), *w_in = INP(3), *w_out = INP(15), *norm_cross = INP(16), *norm_mem = INP(17), *w_cq = INP(18), *w_ckv = INP(19), *w_co = INP(20); const float *norm_moe = INP(21), *w_router = INP(22), *w_gate = INP(24), *b_gate = INP(25), *w_up = INP(26), *b_up = INP(27), *w_down = INP(28), *b_down = INP(29), *norm_final = INP(30); float* ss1 = (float*)(wsl + CTL_SS1); float* ss2 = (float*)(wsl + CTL_SS2); bf16 *Win_t = (bf16*)(wsl + WS_WIN), *Wout_t = (bf16*)(wsl + WS_WOUT), *Wcq_t = (bf16*)(wsl + WS_WCQ), *Wckv_t = (bf16*)(wsl + WS_WCKV), *Wco_t = (bf16*)(wsl + WS_WCO), *Wgu_t = (bf16*)(wsl + WS_WGU), *Wd_t = (bf16*)(wsl + WS_WD); bf16 *XN = (bf16*)(wsl + WS_XN), *MIX = XN, *HB2 = XN, *PROJ = (bf16*)(wsl + WS_PROJ), *HB = (bf16*)(wsl + WS_HB), *Qb = (bf16*)(wsl + WS_Q), *Pb = (bf16*)(wsl + WS_P), *HID = (bf16*)(wsl + WS_HID); bf16 *O2 = (bf16*)(wsl + WS_O2), *Y = (bf16*)(wsl + WS_Y), *MEMN = (bf16*)(wsl + WS_MEMN), *KM = (bf16*)(wsl + WS_KM), *VT = (bf16*)(wsl + WS_VT); const float *dn_conv = INP(4), *dn_a_log = INP(5), *dn_dt_bias = INP(6), *dn_norm = INP(7), *rg_conv = INP(8), *rg_conv_b = INP(9); const float *rg_w_a = INP(10), *rg_b_a = INP(11), *rg_w_x = INP(12), *rg_b_x = INP(13), *rg_lambda = INP(14), *b_router = INP(23); float* QKVN = (float*)(wsl + WS_QKVN); float* ODN = (float*)(wsl + WS_ODN); float* BAf = (float*)(wsl + WS_BA); float* AA = out; float* BX = out + (size_t)M * 512; const int* TOKL = (const int*)(wsl + WS_TOKL); const float* GATEL = (const float*)(wsl + WS_GATEL); const float* RSL = (const float*)(wsl + WS_RSL); (void)ctl;
__global__ void __launch_bounds__(NTHR, 2) mk_fwd(Args args) {
    extern __shared__ __attribute__((aligned(16))) unsigned char lds_raw[];
    LAS unsigned char* lds = (LAS unsigned char*)lds_raw;
    volatile LAS unsigned* LW = (volatile LAS unsigned*)(lds + LDSCTL_OFF);
    const int tid = threadIdx.x, lane = tid & 63, wave = __builtin_amdgcn_readfirstlane(tid >> 6), G = gridDim.x, bx = blockIdx.x;
    for (int u = tid; u < LW_NWORDS; u += NTHR) LW[u] = 0u;
    __syncthreads();
    XcdBarrier bar = xcd_barrier_post((unsigned*)(args.ws + WS_CTL) + CW_BAR + args.bli * XCD_BAR_WORDS, LW + LW_BAR);
    const int lo = args.ph_lo, hi = args.ph_hi;
#ifndef SKIPMASK
#define SKIPMASK 0
#endif
#define IN(k) (!((SKIPMASK >> (k)) & 1) && lo <= (k) && (k) < hi)
#define SEAM(k) do { if (IN(k) && IN((k) + 1)) xcd_barrier(bar); } while (0)
    const int gw = bx * NWAVES + wave, NGW = G * NWAVES;

    if (IN(0)) {
        PHASE_PTRS
        LAS float* scr = (LAS float*)(lds + wave * 16384);
        constexpr int I_IN = 16 * 96, I_SQ = 16 * 32, I_KV = 16 * 64;
        constexpr int NIT = I_IN + 3 * I_SQ + I_KV;
        for (int it = gw; it < NIT; it += NGW) {
            int r = it;
            if (r < I_IN) { const int kb = r / 96, nb = r % 96, n0 = nb * 32; transpose_item(w_in, NIN, n0 < 2048 ? n0 : n0 + 8, kb * 64, Win_t + (size_t)n0 * D, D, nullptr, scr, lane); continue; } r -= I_IN;
            if (r < I_SQ) { const int kb = r / 32, nb = r % 32; transpose_item(w_out, D, nb * 32, kb * 64, Wout_t + (size_t)nb * 32 * D, D, nullptr, scr, lane); continue; } r -= I_SQ;
            if (r < I_SQ) { const int kb = r / 32, nb = r % 32; transpose_item(w_cq, D, nb * 32, kb * 64, Wcq_t + (size_t)nb * 32 * D, D, norm_cross, scr, lane); continue; } r -= I_SQ;
            if (r < I_SQ) { const int kb = r / 32, nb = r % 32; transpose_item(w_co, D, nb * 32, kb * 64, Wco_t + (size_t)nb * 32 * D, D, nullptr, scr, lane); continue; } r -= I_SQ;
            { const int kb = r / 64, nb = r % 64; transpose_item(w_ckv, 2048, nb * 32, kb * 64, Wckv_t + (size_t)nb * 32 * D, D, nullptr, scr, lane); }
        }
        __syncthreads();
        LAS float* w8 = (LAS float*)lds;
        for (int i = tid; i < D * 8; i += NTHR) w8[i] = w_in[(size_t)(i >> 3) * NIN + 2048 + (i & 7)];
        __syncthreads();
        float* BA = (float*)(wsl + WS_BA);
        for (int row = gw; row < M + NB * MEML; row += NGW) {
            const bool ismem = row >= M; const float* xr = ismem ? mem + (size_t)(row - M) * D : x + (size_t)row * D; const float* gn = ismem ? norm_mem : norm_mix;
            bf16* orow = ismem ? MEMN + (size_t)(row - M) * D : XN + (size_t)row * D;
            f32x4 v[4]; float s = 0.f;
#pragma unroll
            for (int j = 0; j < 4; ++j) { v[j] = *(const f32x4*)(xr + 4 * lane + 256 * j); s += (v[j][0] * v[j][0] + v[j][1] * v[j][1]) + (v[j][2] * v[j][2] + v[j][3] * v[j][3]); }
            const float rstd = rsqrtf(wave_sum(s) * (1.f / D) + EPS);
            float acc[8];
#pragma unroll
            for (int q = 0; q < 8; ++q) acc[q] = 0.f;
#pragma unroll
            for (int j = 0; j < 4; ++j) { const f32x4 gg = *(const f32x4*)(gn + 4 * lane + 256 * j); const f32x4 u = v[j] * rstd * gg;
                *(unsigned long long*)(orow + 4 * lane + 256 * j) = (unsigned long long)pk2(u[0], u[1]) | ((unsigned long long)pk2(u[2], u[3]) << 32);
                if (!ismem) {
#pragma unroll
                    for (int i = 0; i < 4; ++i) { const int k = 4 * lane + 256 * j + i; const f32x4 wa = *(const LAS f32x4*)(w8 + k * 8), wb = *(const LAS f32x4*)(w8 + k * 8 + 4);
                        acc[0] += u[i] * wa[0]; acc[1] += u[i] * wa[1]; acc[2] += u[i] * wa[2]; acc[3] += u[i] * wa[3]; acc[4] += u[i] * wb[0]; acc[5] += u[i] * wb[1]; acc[6] += u[i] * wb[2]; acc[7] += u[i] * wb[3]; } } }
            if (!ismem) {
#pragma unroll
                for (int q = 0; q < 8; ++q) { const float t = wave_sum(acc[q]); if (lane == q) BA[(size_t)row * 8 + q] = t; } }
        }
        __syncthreads();
    }
    SEAM(0);
    if (IN(1)) {
        PHASE_PTRS
        { pg8::Gemm g{D, D, D}; pg8::StaticOrder S; S.init(XN, Win_t, M, NP, D, D, G, bx); pg8::EpiStore E{PROJ, NP};
          pg8::gemm_phase<pg8::EpiStore, pg8::StaticOrder, true, false>(lds, g, S, E); }
        { pg8::Gemm g{D, D, D}; pg8::StaticOrder S; S.init(MEMN, Wckv_t, NB * MEML, D, D, D, G, bx); pg8::EpiStore E{KM, D};
          pg8::gemm_phase<pg8::EpiStore, pg8::StaticOrder, true, false>(lds, g, S, E); }
        { pg8::Gemm g{D, D, D}; pg8::StaticOrder S; S.init(Wckv_t + (size_t)D * D, MEMN, D, NB * MEML, D, D, G, (bx + 128) % G); pg8::EpiStore E{VT, D};
          pg8::gemm_phase<pg8::EpiStore, pg8::StaticOrder, true, false>(lds, g, S, E); }
    }
    SEAM(1);
    if (IN(2)) {
        PHASE_PTRS
        for (int it = gw; it < M * 12; it += NGW) {
            const int row = it / 12, yb = it % 12, t = row % T, c0 = yb * 128 + 2 * lane; float s0 = 0.f, s1 = 0.f;
#pragma unroll
            for (int j = 0; j < 4; ++j) { if (t + j - 3 >= 0) { const unsigned pr = *(const unsigned*)(PROJ + (size_t)(row + j - 3) * NP + c0);
                s0 += dn_conv[j * 1536 + c0] * bf2f((bf16)(pr & 0xffff)); s1 += dn_conv[j * 1536 + c0 + 1] * bf2f((bf16)(pr >> 16)); } }
            s0 = siluf_(s0); s1 = siluf_(s1);
            if (yb < 8) { const float r = rsqrtf(wave_sum(s0 * s0 + s1 * s1) + EPS); s0 *= r; s1 *= r; }
            *(float2*)(QKVN + (size_t)row * 1536 + c0) = make_float2(s0, s1);
        }
        LAS float* xr = (LAS float*)lds;
        for (int grp = bx; grp < M / 8; grp += G) {
            const int ch = tid;
#pragma unroll
            for (int r8 = 0; r8 < 8; ++r8) { const int row = grp * 8 + r8, t = row % T; float sv = rg_conv_b[ch];
#pragma unroll
                for (int j = 0; j < 4; ++j) if (t + j - 3 >= 0) sv += rg_conv[j * 512 + ch] * bf2f(PROJ[(size_t)(row + j - 3) * NP + PC_RX + ch]);
                xr[r8 * 512 + ch] = sv; }
            __syncthreads();
            const int nb = ch >> 7, o = ch & 127; float ra[8], rx_[8];
#pragma unroll
            for (int r8 = 0; r8 < 8; ++r8) { ra[r8] = rg_b_a[ch]; rx_[r8] = rg_b_x[ch]; }
            for (int i = 0; i < 128; ++i) { const float wa = rg_w_a[(nb * 128 + i) * 128 + o], wx = rg_w_x[(nb * 128 + i) * 128 + o];
#pragma unroll
                for (int r8 = 0; r8 < 8; ++r8) { const float xv = xr[r8 * 512 + nb * 128 + i]; ra[r8] += xv * wa; rx_[r8] += xv * wx; } }
            const float lsl = -softplusf_(-rg_lambda[ch]);
#pragma unroll
            for (int r8 = 0; r8 < 8; ++r8) { const int row = grp * 8 + r8; const float r = sigmoidf_(ra[r8]), ig = sigmoidf_(rx_[r8]), log_a = 8.f * r * lsl, a = __expf(log_a);
                float mult = sqrtf(fmaxf(-expm1f(2.f * log_a), 0.f)); if (row % T == 0) mult = 1.f;
                AA[(size_t)row * 512 + ch] = a; BX[(size_t)row * 512 + ch] = mult * (ig * xr[r8 * 512 + ch]); }
            __syncthreads();
        }
    }
    SEAM(2);
    if (IN(3)) {
        PHASE_PTRS
        if (bx < 128) {
            const int sl = bx & 7, h = (bx >> 3) & 3, b = bx >> 5, dvl = tid & 15, part = (tid >> 4) & 15; const bool act = tid < 256;
            LAS float* qs = (LAS float*)lds; LAS float* ks = qs + 128; LAS float* red = ks + 128; LAS float* red2 = red + 16 * 17;
            float S[8];
#pragma unroll
            for (int i = 0; i < 8; ++i) S[i] = 0.f;
            const float Aexp = __expf(dn_a_log[h]), dtb = dn_dt_bias[h], scale = 0.08838834764831845f;
            for (int t = 0; t < T; ++t) {
                const size_t row = (size_t)b * T + t;
                if (tid < 128) { qs[tid] = QKVN[row * 1536 + h * 128 + tid]; ks[tid] = QKVN[row * 1536 + 512 + h * 128 + tid]; }
                const float v = QKVN[row * 1536 + 1024 + h * 128 + sl * 16 + dvl];
                const float beta = sigmoidf_(BAf[row * 8 + h]), gg = -Aexp * softplusf_(BAf[row * 8 + 4 + h] + dtb), eg = __expf(gg);
                __syncthreads();
                float pk = 0.f;
#pragma unroll
                for (int i = 0; i < 8; ++i) pk += ks[part * 8 + i] * S[i];
                if (act) red[part * 17 + dvl] = pk;
                __syncthreads();
                float kS = 0.f;
#pragma unroll
                for (int i = 0; i < 16; ++i) kS += red[i * 17 + dvl];
                const float vn = beta * (v - eg * kS); float po = 0.f;
#pragma unroll
                for (int i = 0; i < 8; ++i) { S[i] = eg * S[i] + ks[part * 8 + i] * vn; po += qs[part * 8 + i] * S[i]; }
                if (act) red2[part * 17 + dvl] = po;
                __syncthreads();
                if (tid < 16) { float o = 0.f;
#pragma unroll
                    for (int i = 0; i < 16; ++i) o += red2[i * 17 + dvl];
                    ODN[row * 512 + h * 128 + sl * 16 + dvl] = o * scale; }
            }
        } else if (bx < 132) {
            const int i = (bx - 128) * NTHR + tid, b = i >> 9, ch = i & 511; float hh = 0.f;
            for (int t0 = 0; t0 < T; t0 += 8) { float a[8], xx[8], y[8];
#pragma unroll
                for (int j = 0; j < 8; ++j) { const size_t row = (size_t)b * T + t0 + j; a[j] = AA[row * 512 + ch]; xx[j] = BX[row * 512 + ch]; y[j] = bf2f(PROJ[row * NP + PC_RY + ch]); }
#pragma unroll
                for (int j = 0; j < 8; ++j) { hh = a[j] * hh + xx[j]; MIX[((size_t)b * T + t0 + j) * D + 512 + ch] = f2bf(hh * gelu_tanh(y[j])); } }
        }
    }
    SEAM(3);
    if (IN(4)) {
        PHASE_PTRS
        for (int it = gw; it < M * 4; it += NGW) {
            const int row = it >> 2, h = it & 3, c0 = h * 128 + 2 * lane; const float2 o = *(const float2*)(ODN + (size_t)row * 512 + c0);
            const float rs = rsqrtf(wave_sum(o.x * o.x + o.y * o.y) * (1.f / 128) + EPS); const unsigned zz = *(const unsigned*)(PROJ + (size_t)row * NP + PC_Z + c0);
            *(unsigned*)(MIX + (size_t)row * D + c0) = pk2(o.x * rs * dn_norm[2 * lane] * siluf_(bf2f((bf16)(zz & 0xffff))), o.y * rs * dn_norm[2 * lane + 1] * siluf_(bf2f((bf16)(zz >> 16))));
        }
        __syncthreads();
        LAS float* scr = (LAS float*)(lds + wave * 16384);
        constexpr int I_GU = 32 * 2 * 16 * 32, I_D = 32 * 16 * 32;
        for (int it = gw; it < I_GU + I_D; it += NGW) {
            if (it < I_GU) { const int nb = it & 31, kb = (it >> 5) & 15, which = (it >> 9) & 1, e = it >> 10, n0 = nb * 32;
                transpose_item((which ? w_up : w_gate) + (size_t)e * D * D, D, n0, kb * 64, Wgu_t + ((size_t)e * 2048 + (n0 >> 7) * 256 + (n0 & 127) + which * 128) * D, D, norm_moe, scr, lane); }
            else { const int r = it - I_GU, nb = r & 31, kb = (r >> 5) & 15, e = r >> 9;
                transpose_item(w_down + (size_t)e * D * D, D, nb * 32, kb * 64, Wd_t + ((size_t)e * 1024 + nb * 32) * D, D, nullptr, scr, lane); }
        }
    }
    SEAM(4);
    if (IN(5)) {
        PHASE_PTRS
        pg8::Gemm g{D, D, D}; pg8::StaticOrder S; S.init(MIX, Wout_t, M, D, D, D, G, bx); pg8::EpiResid E{x, out, HB, ss1};
        pg8::gemm_phase<pg8::EpiResid, pg8::StaticOrder, true, false>(lds, g, S, E);
    }
    SEAM(5);
    if (IN(6)) {
        PHASE_PTRS
        { const int ut = bx; if (ut < (M / 256) * 4) {
            const int pm = ut >> 2, h = ut & 3, b = pm / (T / 256);
            { pg8::Gemm g{D, D, D}; pg8::OneUnit S; S.u0 = pg8::Unit{pm, h, (const char*)(HB + (size_t)pm * 256 * D), (const char*)(Wcq_t + (size_t)h * 256 * D), 0, 0};
              pg8::EpiRowScale E{Qb, ss1, 0.0625f}; pg8::gemm_phase<pg8::EpiRowScale, pg8::OneUnit, false, false>(lds, g, S, E); }
            asm volatile("s_waitcnt vmcnt(0)" ::: "memory"); __syncthreads();
            { pg8::Gemm g{D, D, 256}; pg8::OneUnit S; S.u0 = pg8::Unit{pm, h, (const char*)(Qb + (size_t)pm * 256 * D + h * 256), (const char*)(KM + (size_t)b * 256 * D + h * 256), 0, 0};
              pg8::EpiSoftmax E{Pb}; pg8::gemm_phase<pg8::EpiSoftmax, pg8::OneUnit, false, false>(lds, g, S, E); }
            asm volatile("s_waitcnt vmcnt(0)" ::: "memory"); __syncthreads();
            { pg8::Gemm g{D, D, 256}; pg8::OneUnit S; S.u0 = pg8::Unit{pm, h, (const char*)(Pb + (size_t)pm * 256 * D + h * 256), (const char*)(VT + (size_t)h * 256 * D + b * 256), 0, 0};
              pg8::EpiStore E{O2, D}; pg8::gemm_phase<pg8::EpiStore, pg8::OneUnit, false, false>(lds, g, S, E); }
            asm volatile("s_waitcnt vmcnt(0)" ::: "memory"); __syncthreads();
        } }
    }
    SEAM(6);
    if (IN(7)) {
        PHASE_PTRS
        pg8::Gemm g{D, D, D}; pg8::StaticOrder S; S.init(O2, Wco_t, M, D, D, D, G, bx); pg8::EpiResid E{out, out, HB2, ss2};
        pg8::gemm_phase<pg8::EpiResid, pg8::StaticOrder, true, false>(lds, g, S, E);
    }
    SEAM(7);
    if (IN(8)) {
        PHASE_PTRS
        unsigned* cntg = ctl + CW_CNT; int* TOKLw = (int*)(wsl + WS_TOKL); float* GATELw = (float*)(wsl + WS_GATEL); float* RSLw = (float*)(wsl + WS_RSL);
        for (int row = gw; row < M; row += NGW) {
            const int e = lane & 31, half = lane >> 5; const float rs = rsqrtf(ss2[row] * (1.f / D) + EPS); float acc = 0.f;
            for (int k = half * 512; k < half * 512 + 512; ++k) acc += out[(size_t)row * D + k] * norm_moe[k] * w_router[k * NE + e];
            acc += __shfl_xor(acc, 32); float logit = acc * rs + b_router[e];
            float tl[4]; int te[4];
#pragma unroll
            for (int q = 0; q < 4; ++q) { float m = logit; int mi = e;
#pragma unroll
                for (int o = 1; o < 32; o <<= 1) { const float om = __shfl_xor(m, o); const int oi = __shfl_xor(mi, o); if (om > m || (om == m && oi < mi)) { m = om; mi = oi; } }
                tl[q] = m; te[q] = mi; if (e == mi) logit = -3.0e38f; }
            const float e1 = __expf(tl[1] - tl[0]), e2 = __expf(tl[2] - tl[0]), e3 = __expf(tl[3] - tl[0]), inv = 1.f / (1.f + e1 + e2 + e3);
            if (lane < 4) { const int ex = lane == 0 ? te[0] : lane == 1 ? te[1] : lane == 2 ? te[2] : te[3]; const float gv = (lane == 0 ? 1.f : lane == 1 ? e1 : lane == 2 ? e2 : e3) * inv;
                const unsigned pos = atomicAdd(&cntg[ex], 1u); TOKLw[ex * M + pos] = row * 4 + lane; GATELw[ex * M + pos] = gv; RSLw[ex * M + pos] = rs; }
        }
    }
    SEAM(8);
    if (IN(9) || IN(10)) {
        PHASE_PTRS
        const unsigned* cntg = ctl + CW_CNT;
        if (tid < 32) LW[LW_CNT + tid] = cntg[tid];
        __syncthreads();
        if (tid == 0) { int s = 0; for (int e = 0; e < 32; ++e) { LW[LW_TSTART + e] = (unsigned)s; s += ((int)LW[LW_CNT + e] + 255) >> 8; } LW[LW_TSTART + 32] = (unsigned)s; }
        __syncthreads();
    }
    const LAS int* tstart = (const LAS int*)(lds + LDSCTL_OFF) + LW_TSTART; const LAS int* cntl = (const LAS int*)(lds + LDSCTL_OFF) + LW_CNT;
    if (IN(9)) {
        PHASE_PTRS
        pg8::Gemm g{D, D, D}; pg8::MoeOrder<8, true> S{G, bx, tstart, cntl, (const char*)HB2, (const char*)Wgu_t, TOKL};
        pg8::EpiFFN1 E{HID, RSL, b_gate, b_up, cntl};
        pg8::gemm_phase<pg8::EpiFFN1, pg8::MoeOrder<8, true>, true, true>(lds, g, S, E);
    }
    SEAM(9);
    if (IN(10)) {
        PHASE_PTRS
        pg8::Gemm g{D, D, D}; pg8::MoeOrder<4, false> S{G, bx, tstart, cntl, (const char*)HID, (const char*)Wd_t, TOKL};
        pg8::EpiFFN2 E{Y, TOKL, GATEL, b_down, cntl};
        pg8::gemm_phase<pg8::EpiFFN2, pg8::MoeOrder<4, false>, true, false>(lds, g, S, E);
    }
    SEAM(10);
    if (IN(11)) {
        PHASE_PTRS
        for (int row = gw; row < M; row += NGW) {
            f32x4 v[4]; float s = 0.f;
#pragma unroll
            for (int j = 0; j < 4; ++j) { const int c = 4 * lane + 256 * j; f32x4 h = *(const f32x4*)(out + (size_t)row * D + c);
#pragma unroll
                for (int k = 0; k < 4; ++k) { const unsigned long long yy = *(const unsigned long long*)(Y + ((size_t)row * 4 + k) * D + c);
                    h[0] += bf2f((bf16)(yy & 0xffff)); h[1] += bf2f((bf16)((yy >> 16) & 0xffff)); h[2] += bf2f((bf16)((yy >> 32) & 0xffff)); h[3] += bf2f((bf16)(yy >> 48)); }
                v[j] = h; s += (h[0] * h[0] + h[1] * h[1]) + (h[2] * h[2] + h[3] * h[3]); }
            const float rs = rsqrtf(wave_sum(s) * (1.f / D) + EPS);
#pragma unroll
            for (int j = 0; j < 4; ++j) { const int c = 4 * lane + 256 * j; const f32x4 gg = *(const f32x4*)(norm_final + c); *(f32x4*)(out + (size_t)row * D + c) = v[j] * rs * gg; }
        }
    }
#undef IN
#undef SEAM
}

static void launch_mk(Args a, int lo, int hi, int bli, int grid, hipStream_t stream) {
    a.ph_lo = lo; a.ph_hi = hi; a.bli = bli; a.pad = 0;
    hipLaunchKernelGGL(mk_fwd, dim3(grid), dim3(NTHR), LDS_BYTES, stream, a);
}
extern "C" void kernel_launch(void* const* d_in, const int* in_sizes, int n_in, void* d_out, int out_size, void* d_ws, size_t ws_size, hipStream_t stream) {
    if (n_in != 31 || out_size != M * D || ws_size < WS_END) { fprintf(stderr, "kernel_launch: unexpected shapes n_in %d out %d ws %zu\n", n_in, out_size, ws_size); return; }
    static int grid = 0;
    if (grid == 0) {
        int dev = 0, cus = 0;
        if (hipGetDevice(&dev) != hipSuccess || hipDeviceGetAttribute(&cus, hipDeviceAttributeMultiprocessorCount, dev) != hipSuccess) { grid = -1; return; }
        if (hipFuncSetAttribute((const void*)mk_fwd, hipFuncAttributeMaxDynamicSharedMemorySize, LDS_BYTES) != hipSuccess) { fprintf(stderr, "kernel_launch: hipFuncSetAttribute failed\n"); grid = -1; return; }
        int per_cu = 0; (void)hipOccupancyMaxActiveBlocksPerMultiprocessor(&per_cu, (const void*)mk_fwd, NTHR, LDS_BYTES); (void)hipGetLastError();
        if (per_cu < 1) fprintf(stderr, "kernel_launch: occupancy query reports %d blocks per CU\n", per_cu);
        if (cus < 256) { fprintf(stderr, "kernel_launch: needs 256 CUs, device has %d\n", cus); grid = -1; return; }
        grid = 256;
    }
    if (grid < 0) return;
    const float* const* in = (const float* const*)d_in;
    const float *dn_conv = in[4], *dn_a_log = in[5], *dn_dt_bias = in[6], *dn_norm = in[7];
    const float *rg_conv = in[8], *rg_conv_b = in[9], *rg_w_a = in[10], *rg_b_a = in[11], *rg_w_x = in[12], *rg_b_x = in[13], *rg_lambda = in[14];
    const float *norm_moe = in[21], *w_router = in[22], *b_router = in[23];
    char* ws = (char*)d_ws; float* out = (float*)d_out;
    unsigned* ctl = (unsigned*)(ws + WS_CTL); unsigned* cnt = ctl + CW_CNT; float* ss2 = (float*)(ws + CTL_SS2);
    float* BA = (float*)(ws + WS_BA); float* RSTD2 = (float*)(ws + WS_RSTD2);
    int* TOKL = (int*)(ws + WS_TOKL); float* GATEL = (float*)(ws + WS_GATEL); float* RSL = (float*)(ws + WS_RSL);
    bf16 *MIX = (bf16*)(ws + WS_XN), *PROJ = (bf16*)(ws + WS_PROJ);
    float* ODN = (float*)(ws + WS_ODN); float* QKVN = (float*)(ws + WS_QKVN);
    Args a{};
    for (int i = 0; i < 31; ++i) a.in[i] = (const float*)d_in[i];
    a.out = out; a.ws = (unsigned char*)d_ws;

    (void)hipMemsetAsync(ws + WS_CTL, 0, CTL_BYTES, stream);
    launch_mk(a, 0, 12, 0, grid, stream);
}
```

```cpp
#include <hip/hip_runtime.h>
#include <cstdio>
#include <cstdint>

typedef unsigned short bf16;
__device__ __forceinline__ float bf2f(bf16 v) { return __builtin_bit_cast(float, (unsigned)v << 16); }
__device__ __forceinline__ bf16 f2bf(float f) { unsigned u = __builtin_bit_cast(unsigned, f); return (bf16)((u + 0x7fffu + ((u >> 16) & 1u)) >> 16); }

constexpr int NB = 4, T = 4096, D = 1024, M = NB * T, NIN = 3080, NP = 3072, MEML = 256;
constexpr int NE = 32, TOPK = 4;
constexpr float EPS = 1e-6f;
constexpr int PC_Q = 0, PC_K = 512, PC_V = 1024, PC_Z = 1536, PC_RX = 2048, PC_RY = 2560;

constexpr size_t MiB = 1u << 20;
constexpr size_t WS_CTL = 0, CTL_BYTES = 1 * MiB;
constexpr int CW_CNT = 512;
constexpr size_t CTL_SS1 = 128 * 1024, CTL_SS2 = 192 * 1024;
constexpr size_t WS_BA = 1 * MiB, WS_RSTD2 = 1 * MiB + 512 * 1024, WS_DEC = 1 * MiB + 768 * 1024;
constexpr size_t WS_RGW = 2 * MiB, WS_WR = 2 * MiB + 512 * 1024, WS_MEMN = 3 * MiB, WS_KM = 5 * MiB, WS_VT = 7 * MiB;
constexpr size_t WS_RGSUM = 9 * MiB, WS_TOKL = 10 * MiB, WS_GATEL = 12 * MiB, WS_RSL = 14 * MiB;
constexpr size_t WS_WIN = 16 * MiB, WS_WOUT = 22 * MiB, WS_WCQ = 24 * MiB, WS_WCKV = 26 * MiB, WS_WCO = 30 * MiB;
constexpr size_t WS_WGU = 32 * MiB, WS_WD = 160 * MiB;
constexpr size_t WS_XN = 224 * MiB;
constexpr size_t WS_PROJ = 256 * MiB;
constexpr size_t WS_HB = 256 * MiB, WS_Q = 288 * MiB, WS_P = 320 * MiB, WS_HID = 256 * MiB;
constexpr size_t WS_DN = 352 * MiB;
constexpr size_t WS_O2 = 352 * MiB, WS_SC = 384 * MiB  ;
constexpr size_t WS_ODN = 442 * MiB, WS_HLOC = 474 * MiB, WS_CP = 490 * MiB, WS_SSP1 = 506 * MiB, WS_SSP2 = 507 * MiB, WS_END = 508 * MiB;
constexpr size_t WS_Y = 32 * MiB;
constexpr int DNU_BYTES = 73728, DNU_WN = 0, DNU_QG = 16384, DNU_KDT = 32768, DNU_QK = 49152, DNU_UT = 57344;
constexpr size_t WS_QKVN = 32 * MiB;

__host__ __device__ __forceinline__ int kperm(int k) { const int g = (k >> 2) & 3; return (g == 1 || g == 2) ? (k ^ 12) : k; }
__device__ __forceinline__ float wave_sum(float v) {
#pragma unroll
    for (int o = 1; o < 64; o <<= 1) v += __shfl_xor(v, o);
    return v;
}
__device__ __forceinline__ float sigmoidf_(float x) { return 1.f / (1.f + __expf(-x)); }
__device__ __forceinline__ float siluf_(float x) { return x * sigmoidf_(x); }
__device__ __forceinline__ float softplusf_(float x) { return fmaxf(x, 0.f) + log1pf(__expf(-fabsf(x))); }
__device__ __forceinline__ float gelu_tanh(float x) { const float u = 0.7978845608028654f * (x + 0.044715f * x * x * x); return 0.5f * x * (1.f + tanhf(u)); }
__device__ __forceinline__ float ffn_act(float gt, float up) { gt = fminf(gt, 7.f); up = fminf(fmaxf(up, -7.f), 7.f); return (up + 1.f) * (gt * sigmoidf_(1.702f * gt)); }

namespace pg8 {
#define PG8_LAS __attribute__((address_space(3)))
typedef unsigned short bf16_t;
typedef short bf16x8 __attribute__((ext_vector_type(8)));
typedef float f32x4 __attribute__((ext_vector_type(4)));
typedef unsigned u32x4 __attribute__((ext_vector_type(4)));
constexpr int BM = 256, BK = 64, HALF = 128, HTB = HALF * BK * 2, STAGE_BYTES = 8 * HTB, NXCD = 8, WGM = 8;

__host__ __device__ __forceinline__ int lds_byte(int r, int c) { const int st = (r >> 4) * 2 + (c >> 5), rr = r & 15, cc = c & 31, ob = rr * 64 + cc * 2; return st * 1024 + (ob ^ (((ob >> 9) & 1) << 5)); }
__host__ __device__ __forceinline__ void stage_rc(int b, int& R, int& C) { const int st = b / 1024, sb = b % 1024, swz = sb ^ (((sb >> 9) & 1) << 5); R = (st >> 1) * 16 + swz / 64; C = (st & 1) * 32 + (swz % 64) / 2; }
__host__ __device__ __forceinline__ int perm32(int rho) { const int n = rho >> 4, i = rho & 15; return 8 * (i >> 2) + 4 * n + (i & 3); }

struct Unit { int pm, pn; const char* a; const char* b; int e, j; };
struct Gemm { int lda, ldb, K; };

struct StaticOrder {
    int nM, nN, nwg, G, c; const char* A; const char* Bt; size_t astep, bstep;
    __device__ void init(const void* A_, const void* Bt_, int M, int N, int lda, int ldb, int G_, int c_) { nM = M / BM; nN = N / BM; nwg = nM * nN; G = G_; c = c_; A = (const char*)A_; Bt = (const char*)Bt_; astep = (size_t)BM * lda * 2; bstep = (size_t)BM * ldb * 2; }
    __device__ bool next(int i, Unit& u) const {
        const long L = (long)i * G + c; if (L >= nwg) return false;
        int wgid = (int)L; { const int q = nwg / NXCD, r = nwg % NXCD, xcd = wgid % NXCD, off = wgid / NXCD; wgid = (xcd < r ? xcd * (q + 1) : r * (q + 1) + (xcd - r) * q) + off; }
        const int nig = WGM * nN, gid = wgid / nig, fm = gid * WGM, gsz = (nM - fm) < WGM ? (nM - fm) : WGM;
        u.pm = fm + ((wgid % nig) % gsz); u.pn = (wgid % nig) / gsz; u.a = A + (size_t)u.pm * astep; u.b = Bt + (size_t)u.pn * bstep; u.e = 0; u.j = 0; return true;
    }
    __device__ __forceinline__ int arow(const Unit&, int) const { return 0; }
};
struct OneUnit {
    Unit u0;
    __device__ bool next(int i, Unit& u) const { if (i != 0) return false; u = u0; return true; }
    __device__ __forceinline__ int arow(const Unit&, int) const { return 0; }
};

__device__ __forceinline__ unsigned cvt_pk_bf16(float lo, float hi) { unsigned r; asm volatile("v_cvt_pk_bf16_f32 %0, %1, %2" : "=v"(r) : "v"(lo), "v"(hi)); return r; }

typedef f32x4 Acc[2][2][4][2];

template <class Epi, class Sched, bool ALIGN_EPI, bool GATHER>
__device__ __forceinline__ void gemm_phase(PG8_LAS unsigned char* lds, const Gemm g, const Sched& S, const Epi& E) {
    const int tid = threadIdx.x, wid = __builtin_amdgcn_readfirstlane(tid >> 6), lane = tid & 63, wr = wid >> 2, wc = wid & 3, fr = lane & 15, fq = lane >> 4;
    const int nt = g.K / BK;
    unsigned voffA[2], voffB[2]; int RA[2], CA[2];
#pragma unroll
    for (int i = 0; i < 2; ++i) { int R, C; stage_rc(tid * 16 + i * 8192, R, C); const int Rb = (R & ~31) + perm32(R & 31);
        voffA[i] = (unsigned)(R * g.lda + C) * 2u; voffB[i] = (unsigned)(Rb * g.ldb + C) * 2u; RA[i] = R; CA[i] = C; }
    const size_t kstep = (size_t)(BK * 2);
    const size_t hstepA = (size_t)HALF * g.lda * 2, hstepB = (size_t)HALF * g.ldb * 2;
    const unsigned ldsw = (unsigned)wid * 1024u;
    const int aoff = lds_byte(wr * 64 + fr, fq * 8), boff = lds_byte(wc * 32 + fr, fq * 8);
    unsigned aoC[2][2], aoN[2][2];
#define PG8_SA(b, h) (((b) * 2 + (h)) * HTB)
#define PG8_SB(b, h) ((4 + (b) * 2 + (h)) * HTB)
#define PG8_STAGE(bufoff, gbase, voff) do { _Pragma("unroll") for (int _i = 0; _i < 2; ++_i) \
        __builtin_amdgcn_global_load_lds((const unsigned*)((const char*)(gbase) + (voff)[_i]), (PG8_LAS unsigned*)(lds + (bufoff) + ldsw + _i * 8192), 16, 0, 0); } while (0)
#define PG8_STAGE_A(bufoff, gbase, h, nx) do { if constexpr (GATHER) { unsigned _v[2]; _v[0] = (nx) ? aoN[h][0] : aoC[h][0]; _v[1] = (nx) ? aoN[h][1] : aoC[h][1]; PG8_STAGE(bufoff, gbase, _v); } \
        else { PG8_STAGE(bufoff, (gbase) + (h) * hstepA, voffA); } } while (0)
#define PG8_GOFF(dst, un) do { _Pragma("unroll") for (int _h = 0; _h < 2; ++_h) _Pragma("unroll") for (int _i = 0; _i < 2; ++_i) \
        dst[_h][_i] = (unsigned)(S.arow(un, _h * HALF + RA[_i]) * g.lda + CA[_i]) * 2u; } while (0)
#define PG8_LDA(dst, b, h) do { _Pragma("unroll") for (int m = 0; m < 4; ++m) _Pragma("unroll") for (int k = 0; k < 2; ++k) dst[m][k] = *(const PG8_LAS bf16x8*)(lds + PG8_SA(b, h) + aoff + m * 2048 + k * 1024); } while (0)
#define PG8_LDB(dst, b, h) do { _Pragma("unroll") for (int n = 0; n < 2; ++n) _Pragma("unroll") for (int k = 0; k < 2; ++k) dst[n][k] = *(const PG8_LAS bf16x8*)(lds + PG8_SB(b, h) + boff + n * 2048 + k * 1024); } while (0)
#define PG8_MMA(ai, bj, At, Bt) do { __builtin_amdgcn_s_setprio(1); _Pragma("unroll") for (int m = 0; m < 4; ++m) _Pragma("unroll") for (int n = 0; n < 2; ++n) _Pragma("unroll") for (int k = 0; k < 2; ++k) \
        acc[ai][bj][m][n] = __builtin_amdgcn_mfma_f32_16x16x32_bf16(Bt[n][k], At[m][k], acc[ai][bj][m][n], 0, 0, 0); __builtin_amdgcn_s_setprio(0); } while (0)
#define PG8_WAIT_V(n) asm volatile("s_waitcnt vmcnt(" #n ")" ::: "memory")
#define PG8_WAIT_L(n) asm volatile("s_waitcnt lgkmcnt(" #n ")" ::: "memory")
#define PG8_BAR __builtin_amdgcn_s_barrier()
#define PG8_SCHED __builtin_amdgcn_sched_barrier(0)
    Unit cur, nxt; int ui = 0;
    if (!S.next(0, cur)) return;
    if constexpr (GATHER) { PG8_GOFF(aoC, cur); }
    Acc acc;
#pragma unroll
    for (int a = 0; a < 2; ++a)
#pragma unroll
        for (int b = 0; b < 2; ++b)
#pragma unroll
            for (int m = 0; m < 4; ++m)
#pragma unroll
                for (int n = 0; n < 2; ++n) acc[a][b][m][n] = (f32x4){0.f, 0.f, 0.f, 0.f};
    bf16x8 At[4][2], B0[2][2], B1[2][2];
    const char* cA = cur.a; const char* cB = cur.b;
    PG8_STAGE(PG8_SB(0, 0), cB, voffB); PG8_STAGE(PG8_SB(0, 1), cB + hstepB, voffB); PG8_STAGE_A(PG8_SA(0, 0), cA, 0, false); PG8_STAGE_A(PG8_SA(0, 1), cA, 1, false);
    if (wr == 1) PG8_BAR;
    PG8_WAIT_V(2); PG8_BAR;
    PG8_STAGE(PG8_SB(1, 0), cB + kstep, voffB); PG8_STAGE_A(PG8_SA(1, 0), cA + kstep, 0, false); PG8_STAGE(PG8_SB(1, 1), cB + hstepB + kstep, voffB);
    PG8_WAIT_V(6); PG8_BAR;
    for (;;) {
        const bool has_next = S.next(ui + 1, nxt);
        if constexpr (GATHER) { if (has_next) { PG8_GOFF(aoN, nxt); } else {
#pragma unroll
            for (int _h = 0; _h < 2; ++_h) { aoN[_h][0] = aoC[_h][0]; aoN[_h][1] = aoC[_h][1]; } } }
        const char* nA = has_next ? nxt.a : cA; const char* nB = has_next ? nxt.b : cB;
#pragma nounroll
        for (int t = 0; t < nt; t += 2) {
            const bool last = (t == nt - 2);
            const char* a1 = cA + (size_t)(t + 1) * kstep;
            const char* a2 = last ? nA : cA + (size_t)(t + 2) * kstep; const char* b2 = last ? nB : cB + (size_t)(t + 2) * kstep;
            const char* a3 = a2 + kstep; const char* b3 = b2 + kstep;
            PG8_LDB(B0, 0, 0); PG8_LDB(B1, 0, 1); PG8_SCHED; PG8_LDA(At, 0, 0); PG8_STAGE_A(PG8_SA(1, 1), a1, 1, false);
            PG8_WAIT_V(8); PG8_WAIT_L(0); PG8_BAR; PG8_MMA(0, 0, At, B0); PG8_MMA(0, 1, At, B1); PG8_BAR; PG8_SCHED;
            PG8_LDA(At, 0, 1); PG8_STAGE(PG8_SB(0, 0), b2, voffB); PG8_STAGE(PG8_SB(0, 1), b2 + hstepB, voffB); PG8_STAGE_A(PG8_SA(0, 0), a2, 0, last);
            PG8_WAIT_V(8); PG8_WAIT_L(0); PG8_BAR; PG8_MMA(1, 0, At, B0); PG8_MMA(1, 1, At, B1); PG8_BAR; PG8_SCHED;
            PG8_LDB(B0, 1, 0); PG8_LDB(B1, 1, 1); PG8_SCHED; PG8_LDA(At, 1, 0); PG8_STAGE_A(PG8_SA(0, 1), a2, 1, last);
            PG8_WAIT_V(8); PG8_WAIT_L(0); PG8_BAR; PG8_MMA(0, 0, At, B0); PG8_MMA(0, 1, At, B1); PG8_BAR; PG8_SCHED;
            PG8_LDA(At, 1, 1); PG8_STAGE(PG8_SB(1, 0), b3, voffB); PG8_STAGE(PG8_SB(1, 1), b3 + hstepB, voffB); PG8_STAGE_A(PG8_SA(1, 0), a3, 0, last);
            PG8_WAIT_V(8); PG8_WAIT_L(0); PG8_BAR; PG8_MMA(1, 0, At, B0); PG8_MMA(1, 1, At, B1); PG8_BAR; PG8_SCHED;
        }
        if constexpr (ALIGN_EPI) { if (wr == 0) PG8_BAR; }
        if constexpr (!Epi::AFTER_DRAIN) { E(acc, cur, wr, wc, fr, fq); }
        if (!has_next) break;
#pragma unroll
        for (int a = 0; a < 2; ++a)
#pragma unroll
            for (int b = 0; b < 2; ++b)
#pragma unroll
                for (int m = 0; m < 4; ++m)
#pragma unroll
                    for (int n = 0; n < 2; ++n) acc[a][b][m][n] = (f32x4){0.f, 0.f, 0.f, 0.f};
        cur = nxt; cA = nA; cB = nB; ++ui;
        if constexpr (GATHER) {
#pragma unroll
            for (int _h = 0; _h < 2; ++_h) { aoC[_h][0] = aoN[_h][0]; aoC[_h][1] = aoN[_h][1]; } }
        if constexpr (ALIGN_EPI) { if (wr == 1) PG8_BAR; }
    }
    PG8_WAIT_V(0);
    if constexpr (!ALIGN_EPI) { if (wr == 0) PG8_BAR; }
    PG8_BAR;
    if constexpr (Epi::AFTER_DRAIN) { E.fused(acc, cur, wr, wc, fr, fq, lds); }
#undef PG8_SA
#undef PG8_SB
#undef PG8_STAGE
#undef PG8_STAGE_A
#undef PG8_GOFF
#undef PG8_LDA
#undef PG8_LDB
#undef PG8_MMA
#undef PG8_WAIT_V
#undef PG8_WAIT_L
#undef PG8_BAR
#undef PG8_SCHED
}

struct EpiStore {
    static constexpr bool AFTER_DRAIN = false; bf16_t* O; int ldc;
    __device__ __forceinline__ void operator()(const Acc& acc, const Unit& u, int wr, int wc, int fr, int fq) const {
        const int row0 = u.pm * BM + wr * 64 + fr, col0 = u.pn * BM + wc * 32 + 8 * fq;
#pragma unroll
        for (int ai = 0; ai < 2; ++ai)
#pragma unroll
            for (int m = 0; m < 4; ++m) { bf16_t* rowp = O + (size_t)(row0 + ai * HALF + m * 16) * ldc + col0;
#pragma unroll
                for (int bj = 0; bj < 2; ++bj) { const f32x4 v0 = acc[ai][bj][m][0], v1 = acc[ai][bj][m][1];
                    u32x4 w; w.x = cvt_pk_bf16(v0[0], v0[1]); w.y = cvt_pk_bf16(v0[2], v0[3]); w.z = cvt_pk_bf16(v1[0], v1[1]); w.w = cvt_pk_bf16(v1[2], v1[3]);
                    *(u32x4*)(rowp + bj * HALF) = w; } }
    }
};
__device__ __forceinline__ float row_ss(const float* SS, int row) { const f32x4 a = *(const f32x4*)(SS + row * 16), b = *(const f32x4*)(SS + row * 16 + 4), c = *(const f32x4*)(SS + row * 16 + 8), d = *(const f32x4*)(SS + row * 16 + 12);
    return (((a[0] + a[1]) + (a[2] + a[3])) + ((b[0] + b[1]) + (b[2] + b[3]))) + (((c[0] + c[1]) + (c[2] + c[3])) + ((d[0] + d[1]) + (d[2] + d[3]))); }
struct EpiResid {
    static constexpr bool AFTER_DRAIN = false; const float* R; float* H; bf16_t* HB; float* SS;
    __device__ __forceinline__ void operator()(const Acc& acc, const Unit& u, int wr, int wc, int fr, int fq) const {
        const int row0 = u.pm * BM + wr * 64 + fr, col0 = u.pn * BM + wc * 32 + 8 * fq;
#pragma unroll
        for (int ai = 0; ai < 2; ++ai)
#pragma unroll
            for (int m = 0; m < 4; ++m) { const int row = row0 + ai * HALF + m * 16; const size_t off = (size_t)row * D + col0; float sq = 0.f;
#pragma unroll
                for (int bj = 0; bj < 2; ++bj) { const f32x4 r0 = *(const f32x4*)(R + off + bj * HALF), r1 = *(const f32x4*)(R + off + bj * HALF + 4);
                    const f32x4 v0 = acc[ai][bj][m][0] + r0, v1 = acc[ai][bj][m][1] + r1;
                    *(f32x4*)(H + off + bj * HALF) = v0; *(f32x4*)(H + off + bj * HALF + 4) = v1;
                    u32x4 w; w.x = cvt_pk_bf16(v0[0], v0[1]); w.y = cvt_pk_bf16(v0[2], v0[3]); w.z = cvt_pk_bf16(v1[0], v1[1]); w.w = cvt_pk_bf16(v1[2], v1[3]);
                    *(u32x4*)(HB + off + bj * HALF) = w;
                    sq += (v0[0] * v0[0] + v0[1] * v0[1]) + (v0[2] * v0[2] + v0[3] * v0[3]) + (v1[0] * v1[0] + v1[1] * v1[1]) + (v1[2] * v1[2] + v1[3] * v1[3]); }
                sq += __shfl_xor(sq, 16); sq += __shfl_xor(sq, 32);
                if (fq == 0) SS[row * 16 + u.pn * 4 + wc] = sq; }
    }
};
struct EpiRowScale {
    static constexpr bool AFTER_DRAIN = false; bf16_t* O; const float* SS; float s;
    __device__ __forceinline__ void operator()(const Acc& acc, const Unit& u, int wr, int wc, int fr, int fq) const {
        const int row0 = u.pm * BM + wr * 64 + fr, col0 = u.pn * BM + wc * 32 + 8 * fq;
#pragma unroll
        for (int ai = 0; ai < 2; ++ai)
#pragma unroll
            for (int m = 0; m < 4; ++m) { const int row = row0 + ai * HALF + m * 16; const float rs = rsqrtf(row_ss(SS, row) * (1.f / D) + EPS) * s; bf16_t* rowp = O + (size_t)row * D + col0;
#pragma unroll
                for (int bj = 0; bj < 2; ++bj) { const f32x4 v0 = acc[ai][bj][m][0] * rs, v1 = acc[ai][bj][m][1] * rs;
                    u32x4 w; w.x = cvt_pk_bf16(v0[0], v0[1]); w.y = cvt_pk_bf16(v0[2], v0[3]); w.z = cvt_pk_bf16(v1[0], v1[1]); w.w = cvt_pk_bf16(v1[2], v1[3]);
                    *(u32x4*)(rowp + bj * HALF) = w; } }
    }
};
struct EpiSoftmax {
    static constexpr bool AFTER_DRAIN = true; bf16_t* P;
    __device__ __forceinline__ void operator()(const Acc&, const Unit&, int, int, int, int) const {}
    __device__ __forceinline__ void fused(Acc& acc, const Unit& u, int wr, int wc, int fr, int fq, PG8_LAS unsigned char* lds) const {
        PG8_LAS float* xm = (PG8_LAS float*)lds; PG8_LAS float* xs = xm + 1024;
#pragma unroll
        for (int ai = 0; ai < 2; ++ai)
#pragma unroll
            for (int m = 0; m < 4; ++m) { float mx = -3.0e38f;
#pragma unroll
                for (int bj = 0; bj < 2; ++bj)
#pragma unroll
                    for (int n = 0; n < 2; ++n) { const f32x4 v = acc[ai][bj][m][n]; mx = fmaxf(mx, fmaxf(fmaxf(v[0], v[1]), fmaxf(v[2], v[3]))); }
                mx = fmaxf(mx, __shfl_xor(mx, 16)); mx = fmaxf(mx, __shfl_xor(mx, 32));
                if (fq == 0) xm[(ai * HALF + wr * 64 + m * 16 + fr) * 4 + wc] = mx; }
        __syncthreads();
#pragma unroll
        for (int ai = 0; ai < 2; ++ai)
#pragma unroll
            for (int m = 0; m < 4; ++m) { const int r = ai * HALF + wr * 64 + m * 16 + fr; const f32x4 q = *(const PG8_LAS f32x4*)(xm + r * 4);
                const float mx = fmaxf(fmaxf(q[0], q[1]), fmaxf(q[2], q[3])); float sm = 0.f;
#pragma unroll
                for (int bj = 0; bj < 2; ++bj)
#pragma unroll
                    for (int n = 0; n < 2; ++n) { f32x4 v = acc[ai][bj][m][n]; v[0] = __expf(v[0] - mx); v[1] = __expf(v[1] - mx); v[2] = __expf(v[2] - mx); v[3] = __expf(v[3] - mx);
                        acc[ai][bj][m][n] = v; sm += (v[0] + v[1]) + (v[2] + v[3]); }
                sm += __shfl_xor(sm, 16); sm += __shfl_xor(sm, 32);
                if (fq == 0) xs[r * 4 + wc] = sm; }
        __syncthreads();
        const int row0 = u.pm * BM, col0 = u.pn * BM + wc * 32 + 8 * fq;
#pragma unroll
        for (int ai = 0; ai < 2; ++ai)
#pragma unroll
            for (int m = 0; m < 4; ++m) { const int r = ai * HALF + wr * 64 + m * 16 + fr; const f32x4 q = *(const PG8_LAS f32x4*)(xs + r * 4);
                const float inv = 1.f / ((q[0] + q[1]) + (q[2] + q[3])); bf16_t* rowp = P + (size_t)(row0 + r) * D + col0;
#pragma unroll
                for (int bj = 0; bj < 2; ++bj) { const f32x4 v0 = acc[ai][bj][m][0] * inv, v1 = acc[ai][bj][m][1] * inv;
                    u32x4 w; w.x = cvt_pk_bf16(v0[0], v0[1]); w.y = cvt_pk_bf16(v0[2], v0[3]); w.z = cvt_pk_bf16(v1[0], v1[1]); w.w = cvt_pk_bf16(v1[2], v1[3]);
                    *(u32x4*)(rowp + bj * HALF) = w; } }
        __syncthreads();
    }
};
struct EpiFFN1 {
    static constexpr bool AFTER_DRAIN = false; bf16_t* HID; const float* RSL; const float* bg; const float* bu; const PG8_LAS int* cntl;
    __device__ __forceinline__ void operator()(const Acc& acc, const Unit& u, int wr, int wc, int fr, int fq) const {
        const int cnt = cntl[u.e], c0 = u.pn * HALF + wc * 32 + 8 * fq;
        const f32x4 g0 = *(const f32x4*)(bg + u.e * 1024 + c0), g1 = *(const f32x4*)(bg + u.e * 1024 + c0 + 4), u0 = *(const f32x4*)(bu + u.e * 1024 + c0), u1 = *(const f32x4*)(bu + u.e * 1024 + c0 + 4);
#pragma unroll
        for (int ai = 0; ai < 2; ++ai)
#pragma unroll
            for (int m = 0; m < 4; ++m) { const int r = ai * HALF + wr * 64 + m * 16 + fr, pos = u.j * BM + r; const float rs = pos < cnt ? RSL[u.e * M + pos] : 0.f;
                const f32x4 a0 = acc[ai][0][m][0] * rs + g0, a1 = acc[ai][0][m][1] * rs + g1, b0 = acc[ai][1][m][0] * rs + u0, b1 = acc[ai][1][m][1] * rs + u1;
                u32x4 w; w.x = cvt_pk_bf16(ffn_act(a0[0], b0[0]), ffn_act(a0[1], b0[1])); w.y = cvt_pk_bf16(ffn_act(a0[2], b0[2]), ffn_act(a0[3], b0[3]));
                w.z = cvt_pk_bf16(ffn_act(a1[0], b1[0]), ffn_act(a1[1], b1[1])); w.w = cvt_pk_bf16(ffn_act(a1[2], b1[2]), ffn_act(a1[3], b1[3]));
                *(u32x4*)(HID + (size_t)(u.pm * BM + r) * 1024 + c0) = w; }
    }
};
struct EpiFFN2 {
    static constexpr bool AFTER_DRAIN = false; bf16_t* Y; const int* TOKL; const float* GATEL; const float* bd; const PG8_LAS int* cntl;
    __device__ __forceinline__ void operator()(const Acc& acc, const Unit& u, int wr, int wc, int fr, int fq) const {
        const int cnt = cntl[u.e], c0 = u.pn * BM + wc * 32 + 8 * fq;
        f32x4 bv[2][2];
#pragma unroll
        for (int bj = 0; bj < 2; ++bj) { bv[bj][0] = *(const f32x4*)(bd + u.e * 1024 + c0 + bj * HALF); bv[bj][1] = *(const f32x4*)(bd + u.e * 1024 + c0 + bj * HALF + 4); }
#pragma unroll
        for (int ai = 0; ai < 2; ++ai)
#pragma unroll
            for (int m = 0; m < 4; ++m) { const int r = ai * HALF + wr * 64 + m * 16 + fr, pos = u.j * BM + r;
                if (pos < cnt) { const int dst = TOKL[u.e * M + pos]; const float gt = GATEL[u.e * M + pos]; bf16_t* rowp = Y + (size_t)dst * 1024 + c0;
#pragma unroll
                    for (int bj = 0; bj < 2; ++bj) { const f32x4 v0 = (acc[ai][bj][m][0] + bv[bj][0]) * gt, v1 = (acc[ai][bj][m][1] + bv[bj][1]) * gt;
                        u32x4 w; w.x = cvt_pk_bf16(v0[0], v0[1]); w.y = cvt_pk_bf16(v0[2], v0[3]); w.z = cvt_pk_bf16(v1[0], v1[1]); w.w = cvt_pk_bf16(v1[2], v1[3]);
                        *(u32x4*)(rowp + bj * HALF) = w; } } }
    }
};
template <int NPN, bool IS_FFN1> struct MoeOrder {
    int G, c; const PG8_LAS int* tstart; const PG8_LAS int* cntl; const char* A; const char* W; const int* TOKL;
    __device__ bool next(int i, Unit& u) const {
        const int L = i * G + c, nrt = tstart[32]; if (L >= nrt * NPN) return false;
        const int rt = L / NPN, pn = L % NPN; int e = 0;
        for (int q = 1; q < 32; ++q) e += (tstart[q] <= rt) ? 1 : 0;
        u.pm = rt; u.pn = pn; u.e = e; u.j = rt - tstart[e];
        if (IS_FFN1) { u.a = A; u.b = W + ((size_t)e * 2048 + (size_t)pn * 256) * 2048; }
        else { u.a = A + (size_t)rt * 256 * 2048; u.b = W + ((size_t)e * 1024 + (size_t)pn * 256) * 2048; }
        return true;
    }
    __device__ __forceinline__ int arow(const Unit& u, int r) const { const int pos = u.j * BM + r; return pos < cntl[u.e] ? (TOKL[u.e * M + pos] >> 2) : 0; }
};
}

#define GAS __attribute__((address_space(1)))
#define LAS __attribute__((address_space(3)))
typedef unsigned v4u __attribute__((ext_vector_type(4)));
typedef float f32x4 __attribute__((ext_vector_type(4)));
typedef GAS unsigned gu32;
typedef __bf16 bf16x2_t __attribute__((ext_vector_type(2)));
typedef float f32x2_t __attribute__((ext_vector_type(2)));
__device__ __forceinline__ unsigned cvtpk_s(float lo, float hi) { f32x2_t v = {lo, hi}; bf16x2_t b = __builtin_convertvector(v, bf16x2_t); return __builtin_bit_cast(unsigned, b); }
typedef short bf16x8 __attribute__((ext_vector_type(8)));
typedef float f32x16 __attribute__((ext_vector_type(16)));
#ifndef NVGPR_CAP
#define NVGPR_CAP 256
#endif
constexpr int NWAVES = 8, NTHR = 512;
constexpr int RING_BYTES = 131072, LDS_BYTES = 163840, LDSCTL_OFF = LDS_BYTES - 512;
constexpr int LW_BAR = 0, LW_TSTART = 16, LW_CNT = 64, LW_NWORDS = 128;
constexpr int CW_BAR = 1024;

#define XB_TMO      128
#define XB_XCNT(j)  (256  + 64 * (j))
#define XB_XSUB(j)  (1280 + 64 * (j))
#define XB_XGEN(j)  (2304 + 64 * (j))
#define XB_TOP      3328
#define XB_TOPGEN   3392
#define XCD_BAR_WORDS 3456
#define XB_SPIN_CAP (1u << 18)
__device__ __forceinline__ unsigned xb_ld(unsigned* p)              { return __hip_atomic_load(p, __ATOMIC_RELAXED, __HIP_MEMORY_SCOPE_AGENT); }
__device__ __forceinline__ unsigned xb_add(unsigned* p, unsigned v) { return __hip_atomic_fetch_add(p, v, __ATOMIC_RELAXED, __HIP_MEMORY_SCOPE_AGENT); }
__device__ __forceinline__ unsigned xb_xcc_id() { return (unsigned)__builtin_amdgcn_s_getreg((3 << 11) | 20) & 0xFu; }
#define XB_SPIN(cond, bar) do { unsigned _sp = 0; while (cond) { __builtin_amdgcn_s_sleep(1); \
    if ((++_sp & 255u) == 0u) { if (xb_ld(&(bar)[XB_TMO])) break; if (_sp > XB_SPIN_CAP) { atomicAdd(&(bar)[XB_TMO], 1u); break; } } } } while (0)
struct XcdBarrier { unsigned* bar; unsigned x; volatile LAS unsigned* st; };
__device__ __forceinline__ XcdBarrier xcd_barrier_post(unsigned* bar, volatile LAS unsigned* st) {
    XcdBarrier b; b.bar = bar; b.x = xb_xcc_id(); b.st = st;
    if (threadIdx.x == 0) (void)xb_add(&bar[XB_XCNT(b.x)], 1u);
    return b;
}
__device__ __forceinline__ void xcd_barrier_complete(unsigned* bar, unsigned x, unsigned& nloc, unsigned& nx) {
    const unsigned G = gridDim.x * gridDim.y * gridDim.z;
    unsigned sum, cnt, mine, sp = 0u;
    for (;;) {
        sum = 0u; cnt = 0u; mine = 0u;
#pragma unroll
        for (unsigned j = 0; j < 16; ++j) { const unsigned c = xb_ld(&bar[XB_XCNT(j)]); sum += c; cnt += (c > 0u) ? 1u : 0u; mine = (j == x) ? c : mine; }
        if (sum == G) break;
        __builtin_amdgcn_s_sleep(1);
        if ((++sp & 255u) == 0u) { if (xb_ld(&bar[XB_TMO])) break; if (sp > XB_SPIN_CAP) { atomicAdd(&bar[XB_TMO], 1u); break; } }
    }
    nloc = mine > 0u ? mine : 1u; nx = cnt > 0u ? cnt : 1u;
}
__device__ __forceinline__ void xcd_barrier(const XcdBarrier& b) {
    asm volatile("s_waitcnt vmcnt(0)" ::: "memory");
    __syncthreads();
    if (threadIdx.x == 0) {
        unsigned* bar = b.bar;
        __builtin_amdgcn_s_waitcnt(0);
        unsigned nloc = b.st[0], nx = b.st[1];
        if (nloc == 0u) { xcd_barrier_complete(bar, b.x, nloc, nx); b.st[0] = nloc; b.st[1] = nx; }
        const unsigned old = xb_add(&bar[XB_XSUB(b.x)], 1u);
        const unsigned gen = old / nloc;
        if (old + 1u == (gen + 1u) * nloc) {
            __builtin_amdgcn_fence(__ATOMIC_RELEASE, "agent");
            asm volatile("s_waitcnt vmcnt(0)" ::: "memory");
            const unsigned og = xb_add(&bar[XB_TOP], 1u);
            const unsigned tg = og / nx;
            if (og + 1u == (tg + 1u) * nx) xb_add(&bar[XB_TOPGEN], 1u);
            else XB_SPIN(xb_ld(&bar[XB_TOPGEN]) == tg, bar);
            __builtin_amdgcn_fence(__ATOMIC_ACQUIRE, "agent");
            xb_add(&bar[XB_XGEN(b.x)], 1u);
            asm volatile("s_waitcnt vmcnt(0)" ::: "memory");
        } else {
            XB_SPIN(xb_ld(&bar[XB_XGEN(b.x)]) == gen, bar);
            __builtin_amdgcn_fence(__ATOMIC_ACQUIRE, "agent");
            asm volatile("s_waitcnt vmcnt(0)" ::: "memory");
        }
    }
    __syncthreads();
}

struct Args { const float* in[31]; float* out; unsigned char* ws; int ph_lo, ph_hi, bli, pad; };

#define LDS_WAIT() asm volatile("s_waitcnt lgkmcnt(0)" ::: "memory")
__device__ __forceinline__ unsigned pk2(float lo, float hi) { return (unsigned)f2bf(lo) | ((unsigned)f2bf(hi) << 16); }
__device__ __forceinline__ void transpose_item(const float* W, int ldn, int col0, int k0, bf16* dst, int pitch, const float* gain, LAS float* scr, int lane) {
#pragma unroll 8
    for (int i = 0; i < 32; ++i) { const int kk = 2 * i + (lane >> 5); float v = W[(size_t)(k0 + kk) * ldn + col0 + (lane & 31)]; if (gain) v *= gain[k0 + kk]; scr[kk * 33 + (lane & 31)] = v; }
    LDS_WAIT(); asm volatile("" ::: "memory");
    const int c = lane & 7;
#pragma unroll
    for (int j = 0; j < 4; ++j) { const int n = (lane >> 3) + 8 * j; const LAS float* s = scr + (8 * c) * 33 + n;
        v4u o; o.x = pk2(s[0 * 33], s[1 * 33]); o.y = pk2(s[2 * 33], s[3 * 33]); o.z = pk2(s[4 * 33], s[5 * 33]); o.w = pk2(s[6 * 33], s[7 * 33]);
        *(GAS v4u*)(dst + (size_t)n * pitch + k0 + 8 * c) = o; }
    LDS_WAIT(); asm volatile("" ::: "memory");
}

__device__ __forceinline__ const float* arg_in(const Args& a, int k) { asm volatile("" : "+s"(k)); return a.in[k]; }
#define INP(k) arg_in(args, k)
#define PHASE_PTRS unsigned char* wsl = args.ws; asm volatile("" : "+s"(wsl)); float* out = args.out; asm volatile("" : "+s"(out)); unsigned* ctl = (unsigned*)(wsl + WS_CTL); const float *x = INP(0), *mem = INP(1), *norm_mix = INP(2), *w_in = INP(3), *w_out = INP(15), *norm_cross = INP(16), *norm_mem = INP(17), *w_cq = INP(18), *w_ckv = INP(19), *w_co = INP(20); const float *norm_moe = INP(21), *w_router = INP(22), *w_gate = INP(24), *b_gate = INP(25), *w_up = INP(26), *b_up = INP(27), *w_down = INP(28), *b_down = INP(29), *norm_final = INP(30); float* ss1 = (float*)(wsl + WS_SSP1); float* ss2 = (float*)(wsl + WS_SSP2); bf16 *Win_t = (bf16*)(wsl + WS_WIN), *Wout_t = (bf16*)(wsl + WS_WOUT), *Wcq_t = (bf16*)(wsl + WS_WCQ), *Wckv_t = (bf16*)(wsl + WS_WCKV), *Wco_t = (bf16*)(wsl + WS_WCO), *Wgu_t = (bf16*)(wsl + WS_WGU), *Wd_t = (bf16*)(wsl + WS_WD); bf16 *XN = (bf16*)(wsl + WS_XN), *MIX = XN, *HB2 = XN, *PROJ = (bf16*)(wsl + WS_PROJ), *HB = (bf16*)(wsl + WS_HB), *Qb = (bf16*)(wsl + WS_Q), *Pb = (bf16*)(wsl + WS_P), *HID = (bf16*)(wsl + WS_HID); bf16 *O2 = (bf16*)(wsl + WS_O2), *Y = (bf16*)(wsl + WS_Y), *MEMN = (bf16*)(wsl + WS_MEMN), *KM = (bf16*)(wsl + WS_KM), *VT = (bf16*)(wsl + WS_VT); const float *dn_conv = INP(4), *dn_a_log = INP(5), *dn_dt_bias = INP(6), *dn_norm = INP(7), *rg_conv = INP(8), *rg_conv_b = INP(9); const float *rg_w_a = INP(10), *rg_b_a = INP(11), *rg_w_x = INP(12), *rg_b_x = INP(13), *rg_lambda = INP(14), *b_router = INP(23); float* QKVN = (float*)(wsl + WS_QKVN); float* ODN = (float*)(wsl + WS_ODN); float* BAf = (float*)(wsl + WS_BA); float* AA = out; float* BX = out + (size_t)M * 512; const int* TOKL = (const int*)(wsl + WS_TOKL); const float* GATEL = (const float*)(wsl + WS_GATEL); const float* RSL = (const float*)(wsl + WS_RSL); (void)ctl;
__global__ void __launch_bounds__(NTHR, 2) mk_fwd(Args args) {
    extern __shared__ __attribute__((aligned(16))) unsigned char lds_raw[];
    LAS unsigned char* lds = (LAS unsigned char*)lds_raw;
    volatile LAS unsigned* LW = (volatile LAS unsigned*)(lds + LDSCTL_OFF);
    const int tid = threadIdx.x, lane = tid & 63, wave = __builtin_amdgcn_readfirstlane(tid >> 6), G = gridDim.x, bx = blockIdx.x;
    for (int u = tid; u < LW_NWORDS; u += NTHR) LW[u] = 0u;
    __syncthreads();
    XcdBarrier bar = xcd_barrier_post((unsigned*)(args.ws + WS_CTL) + CW_BAR + args.bli * XCD_BAR_WORDS, LW + LW_BAR);
    const int lo = args.ph_lo, hi = args.ph_hi;
#ifndef SKIPMASK
#define SKIPMASK 0
#endif
#define IN(k) (!((SKIPMASK >> (k)) & 1) && lo <= (k) && (k) < hi)
#define SEAM(k) do { if (IN(k) && IN((k) + 1)) xcd_barrier(bar); } while (0)
    const int gw = bx * NWAVES + wave, NGW = G * NWAVES;

    if (IN(0)) {
        PHASE_PTRS
        LAS float* scr = (LAS float*)(lds + wave * 16384);
        constexpr int I_IN = 16 * 96, I_SQ = 16 * 32, I_KV = 16 * 64;
        constexpr int NIT = I_IN + 3 * I_SQ + I_KV;
        for (int it = gw; it < NIT; it += NGW) {
            int r = it;
            if (r < I_IN) { const int kb = r / 96, nb = r % 96, n0 = nb * 32; transpose_item(w_in, NIN, n0 < 2048 ? n0 : n0 + 8, kb * 64, Win_t + (size_t)n0 * D, D, nullptr, scr, lane); continue; } r -= I_IN;
            if (r < I_SQ) { const int kb = r / 32, nb = r % 32; transpose_item(w_out, D, nb * 32, kb * 64, Wout_t + (size_t)nb * 32 * D, D, nullptr, scr, lane); continue; } r -= I_SQ;
            if (r < I_SQ) { const int kb = r / 32, nb = r % 32; transpose_item(w_cq, D, nb * 32, kb * 64, Wcq_t + (size_t)nb * 32 * D, D, norm_cross, scr, lane); continue; } r -= I_SQ;
            if (r < I_SQ) { const int kb = r / 32, nb = r % 32; transpose_item(w_co, D, nb * 32, kb * 64, Wco_t + (size_t)nb * 32 * D, D, nullptr, scr, lane); continue; } r -= I_SQ;
            { const int kb = r / 64, nb = r % 64; transpose_item(w_ckv, 2048, nb * 32, kb * 64, Wckv_t + (size_t)nb * 32 * D, D, nullptr, scr, lane); }
        }
        __syncthreads();
        LAS float* w8 = (LAS float*)lds;
        for (int i = tid; i < D * 8; i += NTHR) w8[i] = w_in[(size_t)(i >> 3) * NIN + 2048 + (i & 7)];
        __syncthreads();
        float* BA = (float*)(wsl + WS_BA);
        for (int row = gw; row < M + NB * MEML; row += NGW) {
            const bool ismem = row >= M; const float* xr = ismem ? mem + (size_t)(row - M) * D : x + (size_t)row * D; const float* gn = ismem ? norm_mem : norm_mix;
            bf16* orow = ismem ? MEMN + (size_t)(row - M) * D : XN + (size_t)row * D;
            f32x4 v[4]; float s = 0.f;
#pragma unroll
            for (int j = 0; j < 4; ++j) { v[j] = *(const f32x4*)(xr + 4 * lane + 256 * j); s += (v[j][0] * v[j][0] + v[j][1] * v[j][1]) + (v[j][2] * v[j][2] + v[j][3] * v[j][3]); }
            const float rstd = rsqrtf(wave_sum(s) * (1.f / D) + EPS);
            float acc[8];
#pragma unroll
            for (int q = 0; q < 8; ++q) acc[q] = 0.f;
#pragma unroll
            for (int j = 0; j < 4; ++j) { const f32x4 gg = *(const f32x4*)(gn + 4 * lane + 256 * j); const f32x4 u = v[j] * rstd * gg;
                *(unsigned long long*)(orow + 4 * lane + 256 * j) = (unsigned long long)pk2(u[0], u[1]) | ((unsigned long long)pk2(u[2], u[3]) << 32);
                if (!ismem) {
#pragma unroll
                    for (int i = 0; i < 4; ++i) { const int k = 4 * lane + 256 * j + i; const f32x4 wa = *(const LAS f32x4*)(w8 + k * 8), wb = *(const LAS f32x4*)(w8 + k * 8 + 4);
                        acc[0] += u[i] * wa[0]; acc[1] += u[i] * wa[1]; acc[2] += u[i] * wa[2]; acc[3] += u[i] * wa[3]; acc[4] += u[i] * wb[0]; acc[5] += u[i] * wb[1]; acc[6] += u[i] * wb[2]; acc[7] += u[i] * wb[3]; } } }
            if (!ismem) {
#pragma unroll
                for (int q = 0; q < 8; ++q) { const float t = wave_sum(acc[q]); if (lane == q) BA[(size_t)row * 8 + q] = t; } }
        }
        __syncthreads();
    }
    SEAM(0);
    if (IN(1)) {
        PHASE_PTRS
        { pg8::Gemm g{D, D, D}; pg8::StaticOrder S; S.init(XN, Win_t, M, NP, D, D, G, bx); pg8::EpiStore E{PROJ, NP};
          pg8::gemm_phase<pg8::EpiStore, pg8::StaticOrder, true, false>(lds, g, S, E); }
        { pg8::Gemm g{D, D, D}; pg8::StaticOrder S; S.init(MEMN, Wckv_t, NB * MEML, D, D, D, G, bx); pg8::EpiStore E{KM, D};
          pg8::gemm_phase<pg8::EpiStore, pg8::StaticOrder, true, false>(lds, g, S, E); }
        { pg8::Gemm g{D, D, D}; pg8::StaticOrder S; S.init(Wckv_t + (size_t)D * D, MEMN, D, NB * MEML, D, D, G, (bx + 128) % G); pg8::EpiStore E{VT, D};
          pg8::gemm_phase<pg8::EpiStore, pg8::StaticOrder, true, false>(lds, g, S, E); }
    }
    SEAM(1);
    if (IN(2)) {
        PHASE_PTRS
        for (int unit = bx; unit < NB * 64; unit += G) {
            const int b = unit >> 6, n = unit & 63; const size_t row0 = (size_t)b * T + n * 64;
            for (int itp = 0; itp < 2; ++itp) {
                const int half = __builtin_amdgcn_readfirstlane(tid >> 8), ht = tid & 255, hw = wave & 3, h = itp * 2 + half;
                LAS unsigned char* HL = lds + half * 53248;
                LAS bf16* QN = (LAS bf16*)HL; LAS bf16* KN = (LAS bf16*)(HL + 17408); LAS float* AL = (LAS float*)(HL + 34816); LAS float* GC = (LAS float*)(HL + 52224); LAS float* BT = GC + 64;
                unsigned char* ub = wsl + WS_DN + (size_t)((b * 4 + h) * 64 + n) * DNU_BYTES;
                if (hw == 0) { const size_t row = row0 + lane; const float beta = sigmoidf_(BAf[row * 8 + h]); float gv = -__expf(dn_a_log[h]) * softplusf_(BAf[row * 8 + 4 + h] + dn_dt_bias[h]);
#pragma unroll
                    for (int o = 1; o < 64; o <<= 1) { const float tv = __shfl_up(gv, o); if (lane >= o) gv += tv; }
                    GC[lane] = gv; BT[lane] = beta; }
                { const int gch = ht & 15;
#pragma unroll
                  for (int tensor = 0; tensor < 2; ++tensor) { const int cb = tensor * 512 + h * 128 + gch * 8; float wv[4][8];
#pragma unroll
                    for (int j = 0; j < 4; ++j) { const f32x4 w0 = *(const f32x4*)(dn_conv + j * 1536 + cb), w1 = *(const f32x4*)(dn_conv + j * 1536 + cb + 4);
                        wv[j][0] = w0[0]; wv[j][1] = w0[1]; wv[j][2] = w0[2]; wv[j][3] = w0[3]; wv[j][4] = w1[0]; wv[j][5] = w1[1]; wv[j][6] = w1[2]; wv[j][7] = w1[3]; }
#pragma unroll
                    for (int ii = 0; ii < 4; ++ii) { const int c = (ht >> 4) + 16 * ii, t = n * 64 + c; float a8[8];
#pragma unroll
                        for (int e = 0; e < 8; ++e) a8[e] = 0.f;
#pragma unroll
                        for (int j = 0; j < 4; ++j) { if (t + j - 3 >= 0) { const v4u pr = *(const v4u*)(PROJ + (row0 + c + j - 3) * NP + cb);
#pragma unroll
                                for (int e = 0; e < 4; ++e) { a8[2 * e] += wv[j][2 * e] * bf2f((bf16)(pr[e] & 0xffff)); a8[2 * e + 1] += wv[j][2 * e + 1] * bf2f((bf16)(pr[e] >> 16)); } } }
                        float ssq = 0.f;
#pragma unroll
                        for (int e = 0; e < 8; ++e) { a8[e] = siluf_(a8[e]); ssq += a8[e] * a8[e]; }
                        ssq += __shfl_xor(ssq, 1); ssq += __shfl_xor(ssq, 2); ssq += __shfl_xor(ssq, 4); ssq += __shfl_xor(ssq, 8);
                        const float rn = rsqrtf(ssq + EPS); v4u o; o.x = pk2(a8[0] * rn, a8[1] * rn); o.y = pk2(a8[2] * rn, a8[3] * rn); o.z = pk2(a8[4] * rn, a8[5] * rn); o.w = pk2(a8[6] * rn, a8[7] * rn);
                        *(LAS v4u*)((tensor ? KN : QN) + c * 136 + gch * 8) = o; } } }
                __syncthreads();
                if (hw < 3) { const int ci = hw == 0 ? 0 : 1, si = hw == 2 ? 1 : 0, l31 = lane & 31, hh = lane >> 5; f32x16 kk, qk;
#pragma unroll
                    for (int r = 0; r < 16; ++r) { kk[r] = 0.f; qk[r] = 0.f; }
#pragma unroll
                    for (int ks = 0; ks < 8; ++ks) { const bf16x8 ak = *(const LAS bf16x8*)(KN + (32 * ci + l31) * 136 + 16 * ks + 8 * hh), aq = *(const LAS bf16x8*)(QN + (32 * ci + l31) * 136 + 16 * ks + 8 * hh);
                        const bf16x8 bk = *(const LAS bf16x8*)(KN + (32 * si + l31) * 136 + 16 * ks + 8 * hh);
                        kk = __builtin_amdgcn_mfma_f32_32x32x16_bf16(ak, bk, kk, 0, 0, 0); qk = __builtin_amdgcn_mfma_f32_32x32x16_bf16(aq, bk, qk, 0, 0, 0); }
                    const int sc = 32 * si + l31; const float gs = GC[sc]; bf16* QKg = (bf16*)(ub + DNU_QK);
#pragma unroll
                    for (int r = 0; r < 16; ++r) { const int c = 32 * ci + (r & 3) + 8 * (r >> 2) + 4 * hh; const float dec = c >= sc ? __expf(GC[c] - gs) : 0.f;
                        AL[c * 68 + sc] = c > sc ? BT[c] * kk[r] * dec : 0.f; QKg[c * 64 + kperm(sc)] = f2bf(qk[r] * 0.08838834764831845f * dec); } }
                __syncthreads();
                { float xs[64];
                  if (ht < 128) { const int cv = PC_V + h * 128 + ht; const float w0 = dn_conv[cv], w1 = dn_conv[1536 + cv], w2 = dn_conv[2 * 1536 + cv], w3 = dn_conv[3 * 1536 + cv];
                      float p3 = 0.f, p2 = 0.f, p1 = 0.f; if (n > 0) { p3 = bf2f(PROJ[(row0 - 3) * NP + cv]); p2 = bf2f(PROJ[(row0 - 2) * NP + cv]); p1 = bf2f(PROJ[(row0 - 1) * NP + cv]); }
#pragma unroll
                      for (int c = 0; c < 64; ++c) { const float cu = bf2f(PROJ[(row0 + c) * NP + cv]); xs[c] = siluf_(w0 * p3 + w1 * p2 + w2 * p1 + w3 * cu) * BT[c]; p3 = p2; p2 = p1; p1 = cu; } }
                  else { const int dk = ht - 128;
#pragma unroll
                      for (int c = 0; c < 64; ++c) xs[c] = bf2f(KN[c * 136 + dk]) * BT[c] * __expf(GC[c]); }
#pragma unroll
                  for (int i = 1; i < 64; ++i) { float acc = xs[i];
#pragma unroll
                      for (int j = 0; j < i; ++j) acc -= AL[i * 68 + j] * xs[j];
                      xs[i] = acc; }
                  if (ht < 128) { bf16* UT = (bf16*)(ub + DNU_UT) + ht * 64;
#pragma unroll
                      for (int c8 = 0; c8 < 8; ++c8) { v4u o; o.x = pk2(xs[8 * c8], xs[8 * c8 + 1]); o.y = pk2(xs[8 * c8 + 2], xs[8 * c8 + 3]); o.z = pk2(xs[8 * c8 + 4], xs[8 * c8 + 5]); o.w = pk2(xs[8 * c8 + 6], xs[8 * c8 + 7]); *(v4u*)(UT + 8 * c8) = o; } }
                  else { bf16* Wn = (bf16*)(ub + DNU_WN) + kperm(ht - 128);
#pragma unroll
                      for (int c = 0; c < 64; ++c) Wn[c * 128] = f2bf(-xs[c]); } }
                { const int c = ht >> 2, d0 = (ht & 3) * 32; const float sc = 0.08838834764831845f * __expf(GC[c]); bf16* Qg = (bf16*)(ub + DNU_QG);
#pragma unroll
                  for (int q = 0; q < 4; ++q) { v4u o;
#pragma unroll
                      for (int e = 0; e < 4; ++e) { const int p0 = d0 + 8 * q + 2 * e; o[e] = pk2(bf2f(QN[c * 136 + kperm(p0)]) * sc, bf2f(QN[c * 136 + kperm(p0 + 1)]) * sc); }
                      *(v4u*)(Qg + c * 128 + d0 + 8 * q) = o; }
                  const int dk = ht >> 1, c0 = (ht & 1) * 32; const float gl = GC[63]; bf16* KdT = (bf16*)(ub + DNU_KDT);
#pragma unroll
                  for (int q = 0; q < 4; ++q) { v4u o;
#pragma unroll
                      for (int e = 0; e < 4; ++e) { const int ca = kperm(c0 + 8 * q + 2 * e), cb2 = kperm(c0 + 8 * q + 2 * e + 1); o[e] = pk2(bf2f(KN[ca * 136 + dk]) * __expf(gl - GC[ca]), bf2f(KN[cb2 * 136 + dk]) * __expf(gl - GC[cb2])); }
                      *(v4u*)(KdT + dk * 64 + c0 + 8 * q) = o; }
                  if (ht == 0) ((float*)(wsl + WS_DEC))[(b * 4 + h) * 64 + n] = __expf(gl); }
                __syncthreads();
            }
        }
        LAS float* xr = (LAS float*)lds;
        for (int grp = bx; grp < M / 8; grp += G) {
            const int ch = tid;
#pragma unroll
            for (int r8 = 0; r8 < 8; ++r8) { const int row = grp * 8 + r8, t = row % T; float sv = rg_conv_b[ch];
#pragma unroll
                for (int j = 0; j < 4; ++j) if (t + j - 3 >= 0) sv += rg_conv[j * 512 + ch] * bf2f(PROJ[(size_t)(row + j - 3) * NP + PC_RX + ch]);
                xr[r8 * 512 + ch] = sv; }
            __syncthreads();
            const int nb = ch >> 7, o = ch & 127; float ra[8], rx_[8];
#pragma unroll
            for (int r8 = 0; r8 < 8; ++r8) { ra[r8] = rg_b_a[ch]; rx_[r8] = rg_b_x[ch]; }
            for (int i = 0; i < 128; ++i) { const float wa = rg_w_a[(nb * 128 + i) * 128 + o], wx = rg_w_x[(nb * 128 + i) * 128 + o];
#pragma unroll
                for (int r8 = 0; r8 < 8; ++r8) { const float xv = xr[r8 * 512 + nb * 128 + i]; ra[r8] += xv * wa; rx_[r8] += xv * wx; } }
            const float lsl = -softplusf_(-rg_lambda[ch]);
#pragma unroll
            for (int r8 = 0; r8 < 8; ++r8) { const int row = grp * 8 + r8; const float r = sigmoidf_(ra[r8]), ig = sigmoidf_(rx_[r8]), log_a = 8.f * r * lsl, a = __expf(log_a);
                float mult = sqrtf(fmaxf(-expm1f(2.f * log_a), 0.f)); if (row % T == 0) mult = 1.f;
                AA[(size_t)row * 512 + ch] = a; BX[(size_t)row * 512 + ch] = mult * (ig * xr[r8 * 512 + ch]); }
            __syncthreads();
        }
    }
    SEAM(2);
    if (IN(3)) {
        PHASE_PTRS
        if (bx < 16) {
            const int b = bx >> 2, h = bx & 3, l31 = lane & 31, hh = lane >> 5, sl = wave;
            const unsigned char* ubase = wsl + WS_DN + (size_t)((b * 4 + h) * 64) * DNU_BYTES; const float* DECp = (const float*)(wsl + WS_DEC) + (b * 4 + h) * 64;
            constexpr int DN_STG = 57344;
            unsigned soff[7];
#pragma unroll
            for (int i = 0; i < 7; ++i) { const int p = wave + 8 * i, q = p * 64 + lane; int src16;
                if (p < 32) { const int r = q >> 4, ch = (q & 15) ^ (r & 15); src16 = r * 16 + ch; } else { const int r = q >> 3, ch = (q & 7) ^ ((r >> 1) & 7); src16 = r * 8 + ch; }
                soff[i] = (unsigned)src16 * 16u; }
#define DN_STAGE(nn, buf) do { const unsigned char* _g = ubase + (size_t)(nn) * DNU_BYTES; _Pragma("unroll") for (int _i = 0; _i < 7; ++_i) \
                __builtin_amdgcn_global_load_lds((const unsigned*)(_g + soff[_i]), (LAS unsigned*)(lds + (buf) * DN_STG + (wave + 8 * _i) * 1024), 16, 0, 0); } while (0)
#define DN_ULOAD(nn) do { const unsigned char* _g = ubase + (size_t)(nn) * DNU_BYTES + DNU_UT + utrow; _Pragma("unroll") for (int _x = 0; _x < 8; ++_x) un[_x] = *(const unsigned long long*)(_g + 16 * _x); } while (0)
            unsigned a256[8], a128[4];
#pragma unroll
            for (int ks = 0; ks < 8; ++ks) a256[ks] = (unsigned)(l31 * 256 + 16 * ((2 * ks + hh) ^ (l31 & 15)));
#pragma unroll
            for (int ks = 0; ks < 4; ++ks) a128[ks] = (unsigned)(l31 * 128 + 16 * ((2 * ks + hh) ^ ((l31 >> 1) & 7)));
            const unsigned utrow = (unsigned)((32 * (sl & 3) + l31) * 128 + 8 * hh); unsigned long long un[8];
            f32x16 S[4];
#pragma unroll
            for (int t = 0; t < 4; ++t)
#pragma unroll
                for (int r = 0; r < 16; ++r) S[t][r] = 0.f;
            DN_STAGE(0, 0); DN_ULOAD(0);
            asm volatile("s_waitcnt vmcnt(0)" ::: "memory"); __syncthreads();
            for (int n = 0; n < 64; ++n) {
                const int buf = n & 1;
                if (n + 1 < 64) DN_STAGE(n + 1, buf ^ 1);
                if (wave < 4) {
                    const LAS unsigned char* L = lds + buf * DN_STG; const float dcy = __builtin_bit_cast(float, __hip_atomic_load((const unsigned*)(DECp + n), __ATOMIC_RELAXED, __HIP_MEMORY_SCOPE_AGENT)); const size_t row0 = (size_t)b * T + n * 64;
                    bf16x8 Sb[8];
#pragma unroll
                    for (int t = 0; t < 4; ++t)
#pragma unroll
                        for (int s2 = 0; s2 < 2; ++s2) { v4u w; w.x = cvtpk_s(S[t][8 * s2], S[t][8 * s2 + 1]); w.y = cvtpk_s(S[t][8 * s2 + 2], S[t][8 * s2 + 3]); w.z = cvtpk_s(S[t][8 * s2 + 4], S[t][8 * s2 + 5]); w.w = cvtpk_s(S[t][8 * s2 + 6], S[t][8 * s2 + 7]);
                            Sb[2 * t + s2] = __builtin_bit_cast(bf16x8, w); }
                    f32x16 VN[2];
#pragma unroll
                    for (int mt = 0; mt < 2; ++mt)
#pragma unroll
                        for (int g4 = 0; g4 < 4; ++g4) { const unsigned long long uu = un[4 * mt + g4];
                            VN[mt][4 * g4] = bf2f((bf16)(uu & 0xffff)); VN[mt][4 * g4 + 1] = bf2f((bf16)((uu >> 16) & 0xffff)); VN[mt][4 * g4 + 2] = bf2f((bf16)((uu >> 32) & 0xffff)); VN[mt][4 * g4 + 3] = bf2f((bf16)(uu >> 48)); }
#pragma unroll
                    for (int ks = 0; ks < 8; ++ks)
#pragma unroll
                        for (int mt = 0; mt < 2; ++mt) VN[mt] = __builtin_amdgcn_mfma_f32_32x32x16_bf16(*(const LAS bf16x8*)(L + DNU_WN + mt * 8192 + a256[ks]), Sb[ks], VN[mt], 0, 0, 0);
                    if (n + 1 < 64) DN_ULOAD(n + 1);
                    bf16x8 vb[4];
#pragma unroll
                    for (int mt = 0; mt < 2; ++mt)
#pragma unroll
                        for (int s2 = 0; s2 < 2; ++s2) { v4u w; w.x = cvtpk_s(VN[mt][8 * s2], VN[mt][8 * s2 + 1]); w.y = cvtpk_s(VN[mt][8 * s2 + 2], VN[mt][8 * s2 + 3]); w.z = cvtpk_s(VN[mt][8 * s2 + 4], VN[mt][8 * s2 + 5]); w.w = cvtpk_s(VN[mt][8 * s2 + 6], VN[mt][8 * s2 + 7]);
                            vb[2 * mt + s2] = __builtin_bit_cast(bf16x8, w); }
#pragma unroll
                    for (int t = 0; t < 4; ++t) { S[t] = S[t] * dcy;
#pragma unroll
                        for (int kc = 0; kc < 4; ++kc) S[t] = __builtin_amdgcn_mfma_f32_32x32x16_bf16(*(const LAS bf16x8*)(L + DNU_KDT + t * 4096 + a128[kc]), vb[kc], S[t], 0, 0, 0); }
#pragma unroll
                    for (int mt = 0; mt < 2; ++mt) { f32x16 O;
#pragma unroll
                        for (int r = 0; r < 16; ++r) O[r] = 0.f;
#pragma unroll
                        for (int ks = 0; ks < 8; ++ks) O = __builtin_amdgcn_mfma_f32_32x32x16_bf16(*(const LAS bf16x8*)(L + DNU_QG + mt * 8192 + a256[ks]), Sb[ks], O, 0, 0, 0);
#pragma unroll
                        for (int kc = 0; kc < 2 + 2 * mt; ++kc) O = __builtin_amdgcn_mfma_f32_32x32x16_bf16(*(const LAS bf16x8*)(L + DNU_QK + mt * 4096 + a128[kc]), vb[kc], O, 0, 0, 0);
                        float* op = ODN + (row0 + 32 * mt + 4 * hh) * 512 + h * 128 + 32 * sl + l31;
#pragma unroll
                        for (int r = 0; r < 16; ++r) op[(size_t)((r & 3) + 8 * (r >> 2)) * 512] = O[r]; }
                }
                asm volatile("s_waitcnt vmcnt(0)" ::: "memory"); __syncthreads();
            }
#undef DN_STAGE
#undef DN_ULOAD
        } else if (bx >= 128 && bx < 132) {
            const int i = (bx - 128) * NTHR + tid, b = i >> 9, ch = i & 511; float hh = 0.f;
            for (int t0 = 0; t0 < T; t0 += 8) { float a[8], xx[8], y[8];
#pragma unroll
                for (int j = 0; j < 8; ++j) { const size_t row = (size_t)b * T + t0 + j; a[j] = AA[row * 512 + ch]; xx[j] = BX[row * 512 + ch]; y[j] = bf2f(PROJ[row * NP + PC_RY + ch]); }
#pragma unroll
                for (int j = 0; j < 8; ++j) { hh = a[j] * hh + xx[j]; MIX[((size_t)b * T + t0 + j) * D + 512 + ch] = f2bf(hh * gelu_tanh(y[j])); } }
        }
    }
    SEAM(3);
    if (IN(4)) {
        PHASE_PTRS
        for (int it = gw; it < M * 4; it += NGW) {
            const int row = it >> 2, h = it & 3, c0 = h * 128 + 2 * lane; const float2 o = *(const float2*)(ODN + (size_t)row * 512 + c0);
            const float rs = rsqrtf(wave_sum(o.x * o.x + o.y * o.y) * (1.f / 128) + EPS); const unsigned zz = *(const unsigned*)(PROJ + (size_t)row * NP + PC_Z + c0);
            *(unsigned*)(MIX + (size_t)row * D + c0) = pk2(o.x * rs * dn_norm[2 * lane] * siluf_(bf2f((bf16)(zz & 0xffff))), o.y * rs * dn_norm[2 * lane + 1] * siluf_(bf2f((bf16)(zz >> 16))));
        }
        __syncthreads();
        LAS float* scr = (LAS float*)(lds + wave * 16384);
        constexpr int I_GU = 32 * 2 * 16 * 32, I_D = 32 * 16 * 32;
        for (int it = gw; it < I_GU + I_D; it += NGW) {
            if (it < I_GU) { const int nb = it & 31, kb = (it >> 5) & 15, which = (it >> 9) & 1, e = it >> 10, n0 = nb * 32;
                transpose_item((which ? w_up : w_gate) + (size_t)e * D * D, D, n0, kb * 64, Wgu_t + ((size_t)e * 2048 + (n0 >> 7) * 256 + (n0 & 127) + which * 128) * D, D, norm_moe, scr, lane); }
            else { const int r = it - I_GU, nb = r & 31, kb = (r >> 5) & 15, e = r >> 9;
                transpose_item(w_down + (size_t)e * D * D, D, nb * 32, kb * 64, Wd_t + ((size_t)e * 1024 + nb * 32) * D, D, nullptr, scr, lane); }
        }
    }
    SEAM(4);
    if (IN(5)) {
        PHASE_PTRS
        pg8::Gemm g{D, D, D}; pg8::StaticOrder S; S.init(MIX, Wout_t, M, D, D, D, G, bx); pg8::EpiResid E{x, out, HB, ss1};
        pg8::gemm_phase<pg8::EpiResid, pg8::StaticOrder, true, false>(lds, g, S, E);
    }
    SEAM(5);
    if (IN(6)) {
        PHASE_PTRS
        { const int ut = bx; if (ut < (M / 256) * 4) {
            const int pm = ut >> 2, h = ut & 3, b = pm / (T / 256);
            { pg8::Gemm g{D, D, D}; pg8::OneUnit S; S.u0 = pg8::Unit{pm, h, (const char*)(HB + (size_t)pm * 256 * D), (const char*)(Wcq_t + (size_t)h * 256 * D), 0, 0};
              pg8::EpiRowScale E{Qb, ss1, 0.0625f}; pg8::gemm_phase<pg8::EpiRowScale, pg8::OneUnit, false, false>(lds, g, S, E); }
            asm volatile("s_waitcnt vmcnt(0)" ::: "memory"); __syncthreads();
            { pg8::Gemm g{D, D, 256}; pg8::OneUnit S; S.u0 = pg8::Unit{pm, h, (const char*)(Qb + (size_t)pm * 256 * D + h * 256), (const char*)(KM + (size_t)b * 256 * D + h * 256), 0, 0};
              pg8::EpiSoftmax E{Pb}; pg8::gemm_phase<pg8::EpiSoftmax, pg8::OneUnit, false, false>(lds, g, S, E); }
            asm volatile("s_waitcnt vmcnt(0)" ::: "memory"); __syncthreads();
            { pg8::Gemm g{D, D, 256}; pg8::OneUnit S; S.u0 = pg8::Unit{pm, h, (const char*)(Pb + (size_t)pm * 256 * D + h * 256), (const char*)(VT + (size_t)h * 256 * D + b * 256), 0, 0};
              pg8::EpiStore E{O2, D}; pg8::gemm_phase<pg8::EpiStore, pg8::OneUnit, false, false>(lds, g, S, E); }
            asm volatile("s_waitcnt vmcnt(0)" ::: "memory"); __syncthreads();
        } }
    }
    SEAM(6);
    if (IN(7)) {
        PHASE_PTRS
        pg8::Gemm g{D, D, D}; pg8::StaticOrder S; S.init(O2, Wco_t, M, D, D, D, G, bx); pg8::EpiResid E{out, out, HB2, ss2};
        pg8::gemm_phase<pg8::EpiResid, pg8::StaticOrder, true, false>(lds, g, S, E);
    }
    SEAM(7);
    if (IN(8)) {
        PHASE_PTRS
        unsigned* cntg = ctl + CW_CNT; int* TOKLw = (int*)(wsl + WS_TOKL); float* GATELw = (float*)(wsl + WS_GATEL); float* RSLw = (float*)(wsl + WS_RSL);
        for (int row = gw; row < M; row += NGW) {
            const int e = lane & 31, half = lane >> 5; const float rs = rsqrtf(pg8::row_ss(ss2, row) * (1.f / D) + EPS); float acc = 0.f;
            for (int k = half * 512; k < half * 512 + 512; ++k) acc += out[(size_t)row * D + k] * norm_moe[k] * w_router[k * NE + e];
            acc += __shfl_xor(acc, 32); float logit = acc * rs + b_router[e];
            float tl[4]; int te[4];
#pragma unroll
            for (int q = 0; q < 4; ++q) { float m = logit; int mi = e;
#pragma unroll
                for (int o = 1; o < 32; o <<= 1) { const float om = __shfl_xor(m, o); const int oi = __shfl_xor(mi, o); if (om > m || (om == m && oi < mi)) { m = om; mi = oi; } }
                tl[q] = m; te[q] = mi; if (e == mi) logit = -3.0e38f; }
            const float e1 = __expf(tl[1] - tl[0]), e2 = __expf(tl[2] - tl[0]), e3 = __expf(tl[3] - tl[0]), inv = 1.f / (1.f + e1 + e2 + e3);
            if (lane < 4) { const int ex = lane == 0 ? te[0] : lane == 1 ? te[1] : lane == 2 ? te[2] : te[3]; const float gv = (lane == 0 ? 1.f : lane == 1 ? e1 : lane == 2 ? e2 : e3) * inv;
                const unsigned pos = atomicAdd(&cntg[ex], 1u); TOKLw[ex * M + pos] = row * 4 + lane; GATELw[ex * M + pos] = gv; RSLw[ex * M + pos] = rs; }
        }
    }
    SEAM(8);
    if (IN(9) || IN(10)) {
        PHASE_PTRS
        const unsigned* cntg = ctl + CW_CNT;
        if (tid < 32) LW[LW_CNT + tid] = cntg[tid];
        __syncthreads();
        if (tid == 0) { int s = 0; for (int e = 0; e < 32; ++e) { LW[LW_TSTART + e] = (unsigned)s; s += ((int)LW[LW_CNT + e] + 255) >> 8; } LW[LW_TSTART + 32] = (unsigned)s; }
        __syncthreads();
    }
    const LAS int* tstart = (const LAS int*)(lds + LDSCTL_OFF) + LW_TSTART; const LAS int* cntl = (const LAS int*)(lds + LDSCTL_OFF) + LW_CNT;
    if (IN(9)) {
        PHASE_PTRS
        pg8::Gemm g{D, D, D}; pg8::MoeOrder<8, true> S{G, bx, tstart, cntl, (const char*)HB2, (const char*)Wgu_t, TOKL};
        pg8::EpiFFN1 E{HID, RSL, b_gate, b_up, cntl};
        pg8::gemm_phase<pg8::EpiFFN1, pg8::MoeOrder<8, true>, true, true>(lds, g, S, E);
    }
    SEAM(9);
    if (IN(10)) {
        PHASE_PTRS
        pg8::Gemm g{D, D, D}; pg8::MoeOrder<4, false> S{G, bx, tstart, cntl, (const char*)HID, (const char*)Wd_t, TOKL};
        pg8::EpiFFN2 E{Y, TOKL, GATEL, b_down, cntl};
        pg8::gemm_phase<pg8::EpiFFN2, pg8::MoeOrder<4, false>, true, false>(lds, g, S, E);
    }
    SEAM(10);
    if (IN(11)) {
        PHASE_PTRS
        for (int row = gw; row < M; row += NGW) {
            f32x4 v[4]; float s = 0.f;
#pragma unroll
            for (int j = 0; j < 4; ++j) { const int c = 4 * lane + 256 * j; f32x4 h = *(const f32x4*)(out + (size_t)row * D + c);
#pragma unroll
                for (int k = 0; k < 4; ++k) { const unsigned long long yy = *(const unsigned long long*)(Y + ((size_t)row * 4 + k) * D + c);
                    h[0] += bf2f((bf16)(yy & 0xffff)); h[1] += bf2f((bf16)((yy >> 16) & 0xffff)); h[2] += bf2f((bf16)((yy >> 32) & 0xffff)); h[3] += bf2f((bf16)(yy >> 48)); }
                v[j] = h; s += (h[0] * h[0] + h[1] * h[1]) + (h[2] * h[2] + h[3] * h[3]); }
            const float rs = rsqrtf(wave_sum(s) * (1.f / D) + EPS);
#pragma unroll
            for (int j = 0; j < 4; ++j) { const int c = 4 * lane + 256 * j; const f32x4 gg = *(const f32x4*)(norm_final + c); *(f32x4*)(out + (size_t)row * D + c) = v[j] * rs * gg; }
        }
    }
#undef IN
#undef SEAM
}

static void launch_mk(Args a, int lo, int hi, int bli, int grid, hipStream_t stream) {
    a.ph_lo = lo; a.ph_hi = hi; a.bli = bli; a.pad = 0;
    hipLaunchKernelGGL(mk_fwd, dim3(grid), dim3(NTHR), LDS_BYTES, stream, a);
}
extern "C" void kernel_launch(void* const* d_in, const int* in_sizes, int n_in, void* d_out, int out_size, void* d_ws, size_t ws_size, hipStream_t stream) {
    if (n_in != 31 || out_size != M * D || ws_size < WS_END) { fprintf(stderr, "kernel_launch: unexpected shapes n_in %d out %d ws %zu\n", n_in, out_size, ws_size); return; }
    static int grid = 0;
    if (grid == 0) {
        int dev = 0, cus = 0;
        if (hipGetDevice(&dev) != hipSuccess || hipDeviceGetAttribute(&cus, hipDeviceAttributeMultiprocessorCount, dev) != hipSuccess) { grid = -1; return; }
        if (hipFuncSetAttribute((const void*)mk_fwd, hipFuncAttributeMaxDynamicSharedMemorySize, LDS_BYTES) != hipSuccess) { fprintf(stderr, "kernel_launch: hipFuncSetAttribute failed\n"); grid = -1; return; }
        int per_cu = 0; (void)hipOccupancyMaxActiveBlocksPerMultiprocessor(&per_cu, (const void*)mk_fwd, NTHR, LDS_BYTES); (void)hipGetLastError();
        if (per_cu < 1) fprintf(stderr, "kernel_launch: occupancy query reports %d blocks per CU\n", per_cu);
        if (cus < 256) { fprintf(stderr, "kernel_launch: needs 256 CUs, device has %d\n", cus); grid = -1; return; }
        grid = 256;
    }
    if (grid < 0) return;
    const float* const* in = (const float* const*)d_in;
    const float *dn_conv = in[4], *dn_a_log = in[5], *dn_dt_bias = in[6], *dn_norm = in[7];
    const float *rg_conv = in[8], *rg_conv_b = in[9], *rg_w_a = in[10], *rg_b_a = in[11], *rg_w_x = in[12], *rg_b_x = in[13], *rg_lambda = in[14];
    const float *norm_moe = in[21], *w_router = in[22], *b_router = in[23];
    char* ws = (char*)d_ws; float* out = (float*)d_out;
    unsigned* ctl = (unsigned*)(ws + WS_CTL); unsigned* cnt = ctl + CW_CNT; float* ss2 = (float*)(ws + CTL_SS2);
    float* BA = (float*)(ws + WS_BA); float* RSTD2 = (float*)(ws + WS_RSTD2);
    int* TOKL = (int*)(ws + WS_TOKL); float* GATEL = (float*)(ws + WS_GATEL); float* RSL = (float*)(ws + WS_RSL);
    bf16 *MIX = (bf16*)(ws + WS_XN), *PROJ = (bf16*)(ws + WS_PROJ);
    float* ODN = (float*)(ws + WS_ODN); float* QKVN = (float*)(ws + WS_QKVN);
    Args a{};
    for (int i = 0; i < 31; ++i) a.in[i] = (const float*)d_in[i];
    a.out = out; a.ws = (unsigned char*)d_ws;

    (void)hipMemsetAsync(ws + WS_CTL, 0, CTL_BYTES, stream);
    launch_mk(a, 0, 12, 0, grid, stream);
}
```

```cpp
#include <hip/hip_runtime.h>
#include <cstdio>
#include <cstdint>

typedef unsigned short bf16;
#ifndef TS_LO
#define TS_LO -1
#define TS_HI -1
#endif
#define TS_MULT 4
__device__ __forceinline__ float bf2f(bf16 v) { return __builtin_bit_cast(float, (unsigned)v << 16); }
__device__ __forceinline__ bf16 f2bf(float f) { unsigned u = __builtin_bit_cast(unsigned, f); return (bf16)((u + 0x7fffu + ((u >> 16) & 1u)) >> 16); }

constexpr int NB = 4, T = 4096, D = 1024, M = NB * T, NIN = 3080, NP = 3072, MEML = 256;
constexpr int NE = 32, TOPK = 4;
constexpr float EPS = 1e-6f;
constexpr int PC_Q = 0, PC_K = 512, PC_V = 1024, PC_Z = 1536, PC_RX = 2048, PC_RY = 2560;

constexpr size_t MiB = 1u << 20;
constexpr size_t WS_CTL = 0, CTL_BYTES = 1 * MiB;
constexpr int CW_CNT = 16384, CNT_STRIDE = 64;
constexpr size_t CTL_SS1 = 128 * 1024, CTL_SS2 = 192 * 1024;
constexpr size_t WS_BA = 1 * MiB, WS_RSTD2 = 1 * MiB + 512 * 1024, WS_DEC = 1 * MiB + 768 * 1024;
constexpr size_t WS_RGW = 2 * MiB, WS_WR = 2 * MiB + 512 * 1024, WS_MEMN = 3 * MiB, WS_KM = 5 * MiB, WS_VT = 7 * MiB;
constexpr size_t WS_RGSUM = 9 * MiB, WS_TOKL = 10 * MiB, WS_GATEL = 12 * MiB, WS_RSL = 14 * MiB;
constexpr size_t WS_WIN = 16 * MiB, WS_WOUT = 22 * MiB, WS_WCQ = 24 * MiB, WS_WCKV = 26 * MiB, WS_WCO = 30 * MiB;
constexpr size_t WS_WGU = 32 * MiB, WS_WD = 160 * MiB;
constexpr size_t WS_XN = 224 * MiB;
constexpr size_t WS_PROJ = 256 * MiB;
constexpr size_t WS_HB = 256 * MiB, WS_Q = 288 * MiB, WS_P = 320 * MiB, WS_HID = 256 * MiB;
constexpr size_t WS_DN = 352 * MiB;
constexpr size_t WS_O2 = 352 * MiB, WS_SC = 384 * MiB  ;
constexpr size_t WS_ODN = 442 * MiB, WS_HLOC = 474 * MiB, WS_CP = 490 * MiB, WS_SSP1 = 506 * MiB, WS_SSP2 = 507 * MiB, WS_CARRY = 508 * MiB, WS_TS = 508 * MiB + 768 * 1024, WS_END = 509 * MiB;
constexpr size_t WS_Y = 32 * MiB;
constexpr int DNU_BYTES = 73728, DNU_WN = 0, DNU_QG = 16384, DNU_KDT = 32768, DNU_QK = 49152, DNU_UT = 57344;
constexpr size_t WS_QKVN = 32 * MiB;

__host__ __device__ __forceinline__ int kperm(int k) { const int g = (k >> 2) & 3; return (g == 1 || g == 2) ? (k ^ 12) : k; }
__device__ __forceinline__ float wave_sum(float v) {
#pragma unroll
    for (int o = 1; o < 64; o <<= 1) v += __shfl_xor(v, o);
    return v;
}
__device__ __forceinline__ float sigmoidf_(float x) { return 1.f / (1.f + __expf(-x)); }
__device__ __forceinline__ float siluf_(float x) { return x * sigmoidf_(x); }
__device__ __forceinline__ float softplusf_(float x) { return fmaxf(x, 0.f) + log1pf(__expf(-fabsf(x))); }
__device__ __forceinline__ float gelu_tanh(float x) { const float u = 0.7978845608028654f * (x + 0.044715f * x * x * x); return 0.5f * x * (1.f + tanhf(u)); }
__device__ __forceinline__ float ffn_act(float gt, float up) { gt = fminf(gt, 7.f); up = fminf(fmaxf(up, -7.f), 7.f); return (up + 1.f) * (gt * sigmoidf_(1.702f * gt)); }

namespace pg8 {
#define PG8_LAS __attribute__((address_space(3)))
typedef unsigned short bf16_t;
typedef short bf16x8 __attribute__((ext_vector_type(8)));
typedef float f32x4 __attribute__((ext_vector_type(4)));
typedef unsigned u32x4 __attribute__((ext_vector_type(4)));
constexpr int BM = 256, BK = 64, HALF = 128, HTB = HALF * BK * 2, STAGE_BYTES = 8 * HTB, NXCD = 8, WGM = 8;

__host__ __device__ __forceinline__ int lds_byte(int r, int c) { const int st = (r >> 4) * 2 + (c >> 5), rr = r & 15, cc = c & 31, ob = rr * 64 + cc * 2; return st * 1024 + (ob ^ (((ob >> 9) & 1) << 5)); }
__host__ __device__ __forceinline__ void stage_rc(int b, int& R, int& C) { const int st = b / 1024, sb = b % 1024, swz = sb ^ (((sb >> 9) & 1) << 5); R = (st >> 1) * 16 + swz / 64; C = (st & 1) * 32 + (swz % 64) / 2; }
__host__ __device__ __forceinline__ int perm32(int rho) { const int n = rho >> 4, i = rho & 15; return 8 * (i >> 2) + 4 * n + (i & 3); }

struct Unit { int pm, pn; const char* a; const char* b; int e, j; };
struct Gemm { int lda, ldb, K; };

struct StaticOrder {
    int nM, nN, nwg, G, c, rep = 1; const char* A; const char* Bt; size_t astep, bstep;
    __device__ void init(const void* A_, const void* Bt_, int M, int N, int lda, int ldb, int G_, int c_) { nM = M / BM; nN = N / BM; nwg = nM * nN; G = G_; c = c_; A = (const char*)A_; Bt = (const char*)Bt_; astep = (size_t)BM * lda * 2; bstep = (size_t)BM * ldb * 2; }
    __device__ bool next(int i, Unit& u) const {
        long L = (long)i * G + c; if (L >= (long)nwg * rep) return false; L %= nwg;
        int wgid = (int)L; { const int q = nwg / NXCD, r = nwg % NXCD, xcd = wgid % NXCD, off = wgid / NXCD; wgid = (xcd < r ? xcd * (q + 1) : r * (q + 1) + (xcd - r) * q) + off; }
        const int nig = WGM * nN, gid = wgid / nig, fm = gid * WGM, gsz = (nM - fm) < WGM ? (nM - fm) : WGM;
        u.pm = fm + ((wgid % nig) % gsz); u.pn = (wgid % nig) / gsz; u.a = A + (size_t)u.pm * astep; u.b = Bt + (size_t)u.pn * bstep; u.e = 0; u.j = 0; return true;
    }
    __device__ __forceinline__ int arow(const Unit&, int) const { return 0; }
};
struct OneUnit {
    Unit u0;
    __device__ bool next(int i, Unit& u) const { if (i != 0) return false; u = u0; return true; }
    __device__ __forceinline__ int arow(const Unit&, int) const { return 0; }
};

__device__ __forceinline__ unsigned cvt_pk_bf16(float lo, float hi) { unsigned r; asm volatile("v_cvt_pk_bf16_f32 %0, %1, %2" : "=v"(r) : "v"(lo), "v"(hi)); return r; }

typedef f32x4 Acc[2][2][4][2];

template <class Epi, class Sched, bool ALIGN_EPI, bool GATHER>
__device__ __forceinline__ void gemm_phase(PG8_LAS unsigned char* lds, const Gemm g, const Sched& S, const Epi& E) {
    const int tid = threadIdx.x, wid = __builtin_amdgcn_readfirstlane(tid >> 6), lane = tid & 63, wr = wid >> 2, wc = wid & 3, fr = lane & 15, fq = lane >> 4;
    const int nt = g.K / BK;
    unsigned voffA[2], voffB[2]; int RA[2], CA[2];
#pragma unroll
    for (int i = 0; i < 2; ++i) { int R, C; stage_rc(tid * 16 + i * 8192, R, C); const int Rb = (R & ~31) + perm32(R & 31);
        voffA[i] = (unsigned)(R * g.lda + C) * 2u; voffB[i] = (unsigned)(Rb * g.ldb + C) * 2u; RA[i] = R; CA[i] = C; }
    const size_t kstep = (size_t)(BK * 2);
    const size_t hstepA = (size_t)HALF * g.lda * 2, hstepB = (size_t)HALF * g.ldb * 2;
    const unsigned ldsw = (unsigned)wid * 1024u;
    const int aoff = lds_byte(wr * 64 + fr, fq * 8), boff = lds_byte(wc * 32 + fr, fq * 8);
    unsigned aoC[2][2], aoN[2][2];
#define PG8_SA(b, h) (((b) * 2 + (h)) * HTB)
#define PG8_SB(b, h) ((4 + (b) * 2 + (h)) * HTB)
#define PG8_STAGE(bufoff, gbase, voff) do { _Pragma("unroll") for (int _i = 0; _i < 2; ++_i) \
        __builtin_amdgcn_global_load_lds((const unsigned*)((const char*)(gbase) + (voff)[_i]), (PG8_LAS unsigned*)(lds + (bufoff) + ldsw + _i * 8192), 16, 0, 0); } while (0)
#define PG8_STAGE_A(bufoff, gbase, h, nx) do { if constexpr (GATHER) { unsigned _v[2]; _v[0] = (nx) ? aoN[h][0] : aoC[h][0]; _v[1] = (nx) ? aoN[h][1] : aoC[h][1]; PG8_STAGE(bufoff, gbase, _v); } \
        else { PG8_STAGE(bufoff, (gbase) + (h) * hstepA, voffA); } } while (0)
#define PG8_GOFF(dst, un) do { _Pragma("unroll") for (int _h = 0; _h < 2; ++_h) _Pragma("unroll") for (int _i = 0; _i < 2; ++_i) \
        dst[_h][_i] = (unsigned)(S.arow(un, _h * HALF + RA[_i]) * g.lda + CA[_i]) * 2u; } while (0)
#define PG8_LDA(dst, b, h) do { _Pragma("unroll") for (int m = 0; m < 4; ++m) _Pragma("unroll") for (int k = 0; k < 2; ++k) dst[m][k] = *(const PG8_LAS bf16x8*)(lds + PG8_SA(b, h) + aoff + m * 2048 + k * 1024); } while (0)
#define PG8_LDB(dst, b, h) do { _Pragma("unroll") for (int n = 0; n < 2; ++n) _Pragma("unroll") for (int k = 0; k < 2; ++k) dst[n][k] = *(const PG8_LAS bf16x8*)(lds + PG8_SB(b, h) + boff + n * 2048 + k * 1024); } while (0)
#define PG8_MMA(ai, bj, At, Bt) do { __builtin_amdgcn_s_setprio(1); _Pragma("unroll") for (int m = 0; m < 4; ++m) _Pragma("unroll") for (int n = 0; n < 2; ++n) _Pragma("unroll") for (int k = 0; k < 2; ++k) \
        acc[ai][bj][m][n] = __builtin_amdgcn_mfma_f32_16x16x32_bf16(Bt[n][k], At[m][k], acc[ai][bj][m][n], 0, 0, 0); __builtin_amdgcn_s_setprio(0); } while (0)
#define PG8_WAIT_V(n) asm volatile("s_waitcnt vmcnt(" #n ")" ::: "memory")
#define PG8_WAIT_L(n) asm volatile("s_waitcnt lgkmcnt(" #n ")" ::: "memory")
#define PG8_BAR __builtin_amdgcn_s_barrier()
#define PG8_SCHED __builtin_amdgcn_sched_barrier(0)
    Unit cur, nxt; int ui = 0;
    if (!S.next(0, cur)) return;
    if constexpr (GATHER) { PG8_GOFF(aoC, cur); }
    Acc acc;
#pragma unroll
    for (int a = 0; a < 2; ++a)
#pragma unroll
        for (int b = 0; b < 2; ++b)
#pragma unroll
            for (int m = 0; m < 4; ++m)
#pragma unroll
                for (int n = 0; n < 2; ++n) acc[a][b][m][n] = (f32x4){0.f, 0.f, 0.f, 0.f};
    bf16x8 At[4][2], B0[2][2], B1[2][2];
    const char* cA = cur.a; const char* cB = cur.b;
    PG8_STAGE(PG8_SB(0, 0), cB, voffB); PG8_STAGE(PG8_SB(0, 1), cB + hstepB, voffB); PG8_STAGE_A(PG8_SA(0, 0), cA, 0, false); PG8_STAGE_A(PG8_SA(0, 1), cA, 1, false);
    if (wr == 1) PG8_BAR;
    PG8_WAIT_V(2); PG8_BAR;
    PG8_STAGE(PG8_SB(1, 0), cB + kstep, voffB); PG8_STAGE_A(PG8_SA(1, 0), cA + kstep, 0, false); PG8_STAGE(PG8_SB(1, 1), cB + hstepB + kstep, voffB);
    PG8_WAIT_V(6); PG8_BAR;
    for (;;) {
        const bool has_next = S.next(ui + 1, nxt);
        if constexpr (GATHER) { if (has_next) { PG8_GOFF(aoN, nxt); } else {
#pragma unroll
            for (int _h = 0; _h < 2; ++_h) { aoN[_h][0] = aoC[_h][0]; aoN[_h][1] = aoC[_h][1]; } } }
        const char* nA = has_next ? nxt.a : cA; const char* nB = has_next ? nxt.b : cB;
#pragma nounroll
        for (int t = 0; t < nt; t += 2) {
            const bool last = (t == nt - 2);
            const char* a1 = cA + (size_t)(t + 1) * kstep;
            const char* a2 = last ? nA : cA + (size_t)(t + 2) * kstep; const char* b2 = last ? nB : cB + (size_t)(t + 2) * kstep;
            const char* a3 = a2 + kstep; const char* b3 = b2 + kstep;
            PG8_LDB(B0, 0, 0); PG8_LDB(B1, 0, 1); PG8_SCHED; PG8_LDA(At, 0, 0); PG8_STAGE_A(PG8_SA(1, 1), a1, 1, false);
            PG8_WAIT_V(8); PG8_WAIT_L(0); PG8_BAR; PG8_MMA(0, 0, At, B0); PG8_MMA(0, 1, At, B1); PG8_BAR; PG8_SCHED;
            PG8_LDA(At, 0, 1); PG8_STAGE(PG8_SB(0, 0), b2, voffB); PG8_STAGE(PG8_SB(0, 1), b2 + hstepB, voffB); PG8_STAGE_A(PG8_SA(0, 0), a2, 0, last);
            PG8_WAIT_V(8); PG8_WAIT_L(0); PG8_BAR; PG8_MMA(1, 0, At, B0); PG8_MMA(1, 1, At, B1); PG8_BAR; PG8_SCHED;
            PG8_LDB(B0, 1, 0); PG8_LDB(B1, 1, 1); PG8_SCHED; PG8_LDA(At, 1, 0); PG8_STAGE_A(PG8_SA(0, 1), a2, 1, last);
            PG8_WAIT_V(8); PG8_WAIT_L(0); PG8_BAR; PG8_MMA(0, 0, At, B0); PG8_MMA(0, 1, At, B1); PG8_BAR; PG8_SCHED;
            PG8_LDA(At, 1, 1); PG8_STAGE(PG8_SB(1, 0), b3, voffB); PG8_STAGE(PG8_SB(1, 1), b3 + hstepB, voffB); PG8_STAGE_A(PG8_SA(1, 0), a3, 0, last);
            PG8_WAIT_V(8); PG8_WAIT_L(0); PG8_BAR; PG8_MMA(1, 0, At, B0); PG8_MMA(1, 1, At, B1); PG8_BAR; PG8_SCHED;
        }
        if constexpr (ALIGN_EPI) { if (wr == 0) PG8_BAR; }
        if constexpr (!Epi::AFTER_DRAIN) { E(acc, cur, wr, wc, fr, fq); }
        if (!has_next) break;
#pragma unroll
        for (int a = 0; a < 2; ++a)
#pragma unroll
            for (int b = 0; b < 2; ++b)
#pragma unroll
                for (int m = 0; m < 4; ++m)
#pragma unroll
                    for (int n = 0; n < 2; ++n) acc[a][b][m][n] = (f32x4){0.f, 0.f, 0.f, 0.f};
        cur = nxt; cA = nA; cB = nB; ++ui;
        if constexpr (GATHER) {
#pragma unroll
            for (int _h = 0; _h < 2; ++_h) { aoC[_h][0] = aoN[_h][0]; aoC[_h][1] = aoN[_h][1]; } }
        if constexpr (ALIGN_EPI) { if (wr == 1) PG8_BAR; }
    }
    PG8_WAIT_V(0);
    if constexpr (!ALIGN_EPI) { if (wr == 0) PG8_BAR; }
    PG8_BAR;
    if constexpr (Epi::AFTER_DRAIN) { E.fused(acc, cur, wr, wc, fr, fq, lds); }
#undef PG8_SA
#undef PG8_SB
#undef PG8_STAGE
#undef PG8_STAGE_A
#undef PG8_GOFF
#undef PG8_LDA
#undef PG8_LDB
#undef PG8_MMA
#undef PG8_WAIT_V
#undef PG8_WAIT_L
#undef PG8_BAR
#undef PG8_SCHED
}

struct EpiStore {
    static constexpr bool AFTER_DRAIN = false; bf16_t* O; int ldc;
    __device__ __forceinline__ void operator()(const Acc& acc, const Unit& u, int wr, int wc, int fr, int fq) const {
        const int row0 = u.pm * BM + wr * 64 + fr, col0 = u.pn * BM + wc * 32 + 8 * fq;
#pragma unroll
        for (int ai = 0; ai < 2; ++ai)
#pragma unroll
            for (int m = 0; m < 4; ++m) { bf16_t* rowp = O + (size_t)(row0 + ai * HALF + m * 16) * ldc + col0;
#pragma unroll
                for (int bj = 0; bj < 2; ++bj) { const f32x4 v0 = acc[ai][bj][m][0], v1 = acc[ai][bj][m][1];
                    u32x4 w; w.x = cvt_pk_bf16(v0[0], v0[1]); w.y = cvt_pk_bf16(v0[2], v0[3]); w.z = cvt_pk_bf16(v1[0], v1[1]); w.w = cvt_pk_bf16(v1[2], v1[3]);
                    *(u32x4*)(rowp + bj * HALF) = w; } }
    }
};
__device__ __forceinline__ float row_ss(const float* SS, int row) { const f32x4 a = *(const f32x4*)(SS + row * 16), b = *(const f32x4*)(SS + row * 16 + 4), c = *(const f32x4*)(SS + row * 16 + 8), d = *(const f32x4*)(SS + row * 16 + 12);
    return (((a[0] + a[1]) + (a[2] + a[3])) + ((b[0] + b[1]) + (b[2] + b[3]))) + (((c[0] + c[1]) + (c[2] + c[3])) + ((d[0] + d[1]) + (d[2] + d[3]))); }
struct EpiResid {
    static constexpr bool AFTER_DRAIN = false; const float* R; float* H; bf16_t* HB; float* SS;
    __device__ __forceinline__ void operator()(const Acc& acc, const Unit& u, int wr, int wc, int fr, int fq) const {
        const int row0 = u.pm * BM + wr * 64 + fr, col0 = u.pn * BM + wc * 32 + 8 * fq;
#pragma unroll
        for (int ai = 0; ai < 2; ++ai)
#pragma unroll
            for (int m = 0; m < 4; ++m) { const int row = row0 + ai * HALF + m * 16; const size_t off = (size_t)row * D + col0; float sq = 0.f;
#pragma unroll
                for (int bj = 0; bj < 2; ++bj) { const f32x4 r0 = *(const f32x4*)(R + off + bj * HALF), r1 = *(const f32x4*)(R + off + bj * HALF + 4);
                    const f32x4 v0 = acc[ai][bj][m][0] + r0, v1 = acc[ai][bj][m][1] + r1;
                    *(f32x4*)(H + off + bj * HALF) = v0; *(f32x4*)(H + off + bj * HALF + 4) = v1;
                    u32x4 w; w.x = cvt_pk_bf16(v0[0], v0[1]); w.y = cvt_pk_bf16(v0[2], v0[3]); w.z = cvt_pk_bf16(v1[0], v1[1]); w.w = cvt_pk_bf16(v1[2], v1[3]);
                    *(u32x4*)(HB + off + bj * HALF) = w;
                    sq += (v0[0] * v0[0] + v0[1] * v0[1]) + (v0[2] * v0[2] + v0[3] * v0[3]) + (v1[0] * v1[0] + v1[1] * v1[1]) + (v1[2] * v1[2] + v1[3] * v1[3]); }
                sq += __shfl_xor(sq, 16); sq += __shfl_xor(sq, 32);
                if (fq == 0) SS[row * 16 + u.pn * 4 + wc] = sq; }
    }
};
struct EpiRowScale {
    static constexpr bool AFTER_DRAIN = false; bf16_t* O; const float* SS; float s;
    __device__ __forceinline__ void operator()(const Acc& acc, const Unit& u, int wr, int wc, int fr, int fq) const {
        const int row0 = u.pm * BM + wr * 64 + fr, col0 = u.pn * BM + wc * 32 + 8 * fq;
#pragma unroll
        for (int ai = 0; ai < 2; ++ai)
#pragma unroll
            for (int m = 0; m < 4; ++m) { const int row = row0 + ai * HALF + m * 16; const float rs = rsqrtf(row_ss(SS, row) * (1.f / D) + EPS) * s; bf16_t* rowp = O + (size_t)row * D + col0;
#pragma unroll
                for (int bj = 0; bj < 2; ++bj) { const f32x4 v0 = acc[ai][bj][m][0] * rs, v1 = acc[ai][bj][m][1] * rs;
                    u32x4 w; w.x = cvt_pk_bf16(v0[0], v0[1]); w.y = cvt_pk_bf16(v0[2], v0[3]); w.z = cvt_pk_bf16(v1[0], v1[1]); w.w = cvt_pk_bf16(v1[2], v1[3]);
                    *(u32x4*)(rowp + bj * HALF) = w; } }
    }
};
struct EpiSoftmax {
    static constexpr bool AFTER_DRAIN = true; bf16_t* P;
    __device__ __forceinline__ void operator()(const Acc&, const Unit&, int, int, int, int) const {}
    __device__ __forceinline__ void fused(Acc& acc, const Unit& u, int wr, int wc, int fr, int fq, PG8_LAS unsigned char* lds) const {
        PG8_LAS float* xm = (PG8_LAS float*)lds; PG8_LAS float* xs = xm + 1024;
#pragma unroll
        for (int ai = 0; ai < 2; ++ai)
#pragma unroll
            for (int m = 0; m < 4; ++m) { float mx = -3.0e38f;
#pragma unroll
                for (int bj = 0; bj < 2; ++bj)
#pragma unroll
                    for (int n = 0; n < 2; ++n) { const f32x4 v = acc[ai][bj][m][n]; mx = fmaxf(mx, fmaxf(fmaxf(v[0], v[1]), fmaxf(v[2], v[3]))); }
                mx = fmaxf(mx, __shfl_xor(mx, 16)); mx = fmaxf(mx, __shfl_xor(mx, 32));
                if (fq == 0) xm[(ai * HALF + wr * 64 + m * 16 + fr) * 4 + wc] = mx; }
        __syncthreads();
#pragma unroll
        for (int ai = 0; ai < 2; ++ai)
#pragma unroll
            for (int m = 0; m < 4; ++m) { const int r = ai * HALF + wr * 64 + m * 16 + fr; const f32x4 q = *(const PG8_LAS f32x4*)(xm + r * 4);
                const float mx = fmaxf(fmaxf(q[0], q[1]), fmaxf(q[2], q[3])); float sm = 0.f;
#pragma unroll
                for (int bj = 0; bj < 2; ++bj)
#pragma unroll
                    for (int n = 0; n < 2; ++n) { f32x4 v = acc[ai][bj][m][n]; v[0] = __expf(v[0] - mx); v[1] = __expf(v[1] - mx); v[2] = __expf(v[2] - mx); v[3] = __expf(v[3] - mx);
                        acc[ai][bj][m][n] = v; sm += (v[0] + v[1]) + (v[2] + v[3]); }
                sm += __shfl_xor(sm, 16); sm += __shfl_xor(sm, 32);
                if (fq == 0) xs[r * 4 + wc] = sm; }
        __syncthreads();
        const int row0 = u.pm * BM, col0 = u.pn * BM + wc * 32 + 8 * fq;
#pragma unroll
        for (int ai = 0; ai < 2; ++ai)
#pragma unroll
            for (int m = 0; m < 4; ++m) { const int r = ai * HALF + wr * 64 + m * 16 + fr; const f32x4 q = *(const PG8_LAS f32x4*)(xs + r * 4);
                const float inv = 1.f / ((q[0] + q[1]) + (q[2] + q[3])); bf16_t* rowp = P + (size_t)(row0 + r) * D + col0;
#pragma unroll
                for (int bj = 0; bj < 2; ++bj) { const f32x4 v0 = acc[ai][bj][m][0] * inv, v1 = acc[ai][bj][m][1] * inv;
                    u32x4 w; w.x = cvt_pk_bf16(v0[0], v0[1]); w.y = cvt_pk_bf16(v0[2], v0[3]); w.z = cvt_pk_bf16(v1[0], v1[1]); w.w = cvt_pk_bf16(v1[2], v1[3]);
                    *(u32x4*)(rowp + bj * HALF) = w; } }
        __syncthreads();
    }
};
struct EpiFFN1 {
    static constexpr bool AFTER_DRAIN = false; bf16_t* HID; const float* RSL; const float* bg; const float* bu; const PG8_LAS int* cntl;
    __device__ __forceinline__ void operator()(const Acc& acc, const Unit& u, int wr, int wc, int fr, int fq) const {
        const int cnt = cntl[u.e], c0 = u.pn * HALF + wc * 32 + 8 * fq;
        const f32x4 g0 = *(const f32x4*)(bg + u.e * 1024 + c0), g1 = *(const f32x4*)(bg + u.e * 1024 + c0 + 4), u0 = *(const f32x4*)(bu + u.e * 1024 + c0), u1 = *(const f32x4*)(bu + u.e * 1024 + c0 + 4);
#pragma unroll
        for (int ai = 0; ai < 2; ++ai)
#pragma unroll
            for (int m = 0; m < 4; ++m) { const int r = ai * HALF + wr * 64 + m * 16 + fr, pos = u.j * BM + r; const float rs = pos < cnt ? RSL[u.e * M + pos] : 0.f;
                const f32x4 a0 = acc[ai][0][m][0] * rs + g0, a1 = acc[ai][0][m][1] * rs + g1, b0 = acc[ai][1][m][0] * rs + u0, b1 = acc[ai][1][m][1] * rs + u1;
                u32x4 w; w.x = cvt_pk_bf16(ffn_act(a0[0], b0[0]), ffn_act(a0[1], b0[1])); w.y = cvt_pk_bf16(ffn_act(a0[2], b0[2]), ffn_act(a0[3], b0[3]));
                w.z = cvt_pk_bf16(ffn_act(a1[0], b1[0]), ffn_act(a1[1], b1[1])); w.w = cvt_pk_bf16(ffn_act(a1[2], b1[2]), ffn_act(a1[3], b1[3]));
                *(u32x4*)(HID + (size_t)(u.pm * BM + r) * 1024 + c0) = w; }
    }
};
struct EpiFFN2 {
    static constexpr bool AFTER_DRAIN = false; bf16_t* Y; const int* TOKL; const float* GATEL; const float* bd; const PG8_LAS int* cntl;
    __device__ __forceinline__ void operator()(const Acc& acc, const Unit& u, int wr, int wc, int fr, int fq) const {
        const int cnt = cntl[u.e], c0 = u.pn * BM + wc * 32 + 8 * fq;
        f32x4 bv[2][2];
#pragma unroll
        for (int bj = 0; bj < 2; ++bj) { bv[bj][0] = *(const f32x4*)(bd + u.e * 1024 + c0 + bj * HALF); bv[bj][1] = *(const f32x4*)(bd + u.e * 1024 + c0 + bj * HALF + 4); }
#pragma unroll
        for (int ai = 0; ai < 2; ++ai)
#pragma unroll
            for (int m = 0; m < 4; ++m) { const int r = ai * HALF + wr * 64 + m * 16 + fr, pos = u.j * BM + r;
                if (pos < cnt) { const int dst = TOKL[u.e * M + pos]; const float gt = GATEL[u.e * M + pos]; bf16_t* rowp = Y + (size_t)dst * 1024 + c0;
#pragma unroll
                    for (int bj = 0; bj < 2; ++bj) { const f32x4 v0 = (acc[ai][bj][m][0] + bv[bj][0]) * gt, v1 = (acc[ai][bj][m][1] + bv[bj][1]) * gt;
                        u32x4 w; w.x = cvt_pk_bf16(v0[0], v0[1]); w.y = cvt_pk_bf16(v0[2], v0[3]); w.z = cvt_pk_bf16(v1[0], v1[1]); w.w = cvt_pk_bf16(v1[2], v1[3]);
                        *(u32x4*)(rowp + bj * HALF) = w; } } }
    }
};
template <int NPN, bool IS_FFN1> struct MoeOrder {
    int G, c; const PG8_LAS int* tstart; const PG8_LAS int* cntl; const char* A; const char* W; const int* TOKL; int rep;
    __device__ bool next(int i, Unit& u) const {
        int L = i * G + c; const int nrt = tstart[32]; if (L >= nrt * NPN * rep) return false; L %= nrt * NPN;
        const int rt = L / NPN, pn = L % NPN; int e = 0;
        for (int q = 1; q < 32; ++q) e += (tstart[q] <= rt) ? 1 : 0;
        u.pm = rt; u.pn = pn; u.e = e; u.j = rt - tstart[e];
        if (IS_FFN1) { u.a = A; u.b = W + ((size_t)e * 2048 + (size_t)pn * 256) * 2048; }
        else { u.a = A + (size_t)rt * 256 * 2048; u.b = W + ((size_t)e * 1024 + (size_t)pn * 256) * 2048; }
        return true;
    }
    __device__ __forceinline__ int arow(const Unit& u, int r) const { const int pos = u.j * BM + r; return pos < cntl[u.e] ? (TOKL[u.e * M + pos] >> 2) : 0; }
};
}

#define GAS __attribute__((address_space(1)))
#define LAS __attribute__((address_space(3)))
typedef unsigned v4u __attribute__((ext_vector_type(4)));
typedef float f32x4 __attribute__((ext_vector_type(4)));
typedef GAS unsigned gu32;
typedef __bf16 bf16x2_t __attribute__((ext_vector_type(2)));
typedef float f32x2_t __attribute__((ext_vector_type(2)));
__device__ __forceinline__ unsigned cvtpk_s(float lo, float hi) { f32x2_t v = {lo, hi}; bf16x2_t b = __builtin_convertvector(v, bf16x2_t); return __builtin_bit_cast(unsigned, b); }
typedef short bf16x8 __attribute__((ext_vector_type(8)));
typedef float f32x16 __attribute__((ext_vector_type(16)));
#ifndef NVGPR_CAP
#define NVGPR_CAP 256
#endif
constexpr int NWAVES = 8, NTHR = 512;
constexpr int RING_BYTES = 131072, LDS_BYTES = 163840, LDSCTL_OFF = LDS_BYTES - 512;
constexpr int LW_BAR = 0, LW_TSTART = 16, LW_CNT = 64, LW_NWORDS = 128;
constexpr int CW_BAR = 1024;

#define XB_TMO      128
#define XB_XCNT(j)  (256  + 64 * (j))
#define XB_XSUB(j)  (1280 + 64 * (j))
#define XB_XGEN(j)  (2304 + 64 * (j))
#define XB_TOP      3328
#define XB_TOPGEN   3392
#define XCD_BAR_WORDS 3456
#define XB_SPIN_CAP (1u << 18)
__device__ __forceinline__ unsigned xb_ld(unsigned* p)              { return __hip_atomic_load(p, __ATOMIC_RELAXED, __HIP_MEMORY_SCOPE_AGENT); }
__device__ __forceinline__ unsigned xb_add(unsigned* p, unsigned v) { return __hip_atomic_fetch_add(p, v, __ATOMIC_RELAXED, __HIP_MEMORY_SCOPE_AGENT); }
__device__ __forceinline__ unsigned xb_xcc_id() { return (unsigned)__builtin_amdgcn_s_getreg((3 << 11) | 20) & 0xFu; }
#define XB_SPIN(cond, bar) do { unsigned _sp = 0; while (cond) { __builtin_amdgcn_s_sleep(1); \
    if ((++_sp & 255u) == 0u) { if (xb_ld(&(bar)[XB_TMO])) break; if (_sp > XB_SPIN_CAP) { atomicAdd(&(bar)[XB_TMO], 1u); break; } } } } while (0)
struct XcdBarrier { unsigned* bar; unsigned x; volatile LAS unsigned* st; };
__device__ __forceinline__ XcdBarrier xcd_barrier_post(unsigned* bar, volatile LAS unsigned* st) {
    XcdBarrier b; b.bar = bar; b.x = xb_xcc_id(); b.st = st;
    if (threadIdx.x == 0) (void)xb_add(&bar[XB_XCNT(b.x)], 1u);
    return b;
}
__device__ __forceinline__ void xcd_barrier_complete(unsigned* bar, unsigned x, unsigned& nloc, unsigned& nx) {
    const unsigned G = gridDim.x * gridDim.y * gridDim.z;
    unsigned sum, cnt, mine, sp = 0u;
    for (;;) {
        sum = 0u; cnt = 0u; mine = 0u;
#pragma unroll
        for (unsigned j = 0; j < 16; ++j) { const unsigned c = xb_ld(&bar[XB_XCNT(j)]); sum += c; cnt += (c > 0u) ? 1u : 0u; mine = (j == x) ? c : mine; }
        if (sum == G) break;
        __builtin_amdgcn_s_sleep(1);
        if ((++sp & 255u) == 0u) { if (xb_ld(&bar[XB_TMO])) break; if (sp > XB_SPIN_CAP) { atomicAdd(&bar[XB_TMO], 1u); break; } }
    }
    nloc = mine > 0u ? mine : 1u; nx = cnt > 0u ? cnt : 1u;
}
__device__ __forceinline__ void xcd_barrier(const XcdBarrier& b) {
    asm volatile("s_waitcnt vmcnt(0)" ::: "memory");
    __syncthreads();
    if (threadIdx.x == 0) {
        unsigned* bar = b.bar;
        __builtin_amdgcn_s_waitcnt(0);
        unsigned nloc = b.st[0], nx = b.st[1];
        if (nloc == 0u) { xcd_barrier_complete(bar, b.x, nloc, nx); b.st[0] = nloc; b.st[1] = nx; }
        const unsigned old = xb_add(&bar[XB_XSUB(b.x)], 1u);
        const unsigned gen = old / nloc;
        if (old + 1u == (gen + 1u) * nloc) {
            __builtin_amdgcn_fence(__ATOMIC_RELEASE, "agent");
            asm volatile("s_waitcnt vmcnt(0)" ::: "memory");
            const unsigned og = xb_add(&bar[XB_TOP], 1u);
            const unsigned tg = og / nx;
            if (og + 1u == (tg + 1u) * nx) xb_add(&bar[XB_TOPGEN], 1u);
            else XB_SPIN(xb_ld(&bar[XB_TOPGEN]) == tg, bar);
            __builtin_amdgcn_fence(__ATOMIC_ACQUIRE, "agent");
            xb_add(&bar[XB_XGEN(b.x)], 1u);
            asm volatile("s_waitcnt vmcnt(0)" ::: "memory");
        } else {
            XB_SPIN(xb_ld(&bar[XB_XGEN(b.x)]) == gen, bar);
            __builtin_amdgcn_fence(__ATOMIC_ACQUIRE, "agent");
            asm volatile("s_waitcnt vmcnt(0)" ::: "memory");
        }
    }
    __syncthreads();
}

struct Args { const float* in[31]; float* out; unsigned char* ws; int ph_lo, ph_hi, bli, pad; };

#define LDS_WAIT() asm volatile("s_waitcnt lgkmcnt(0)" ::: "memory")
__device__ __forceinline__ unsigned pk2(float lo, float hi) { return (unsigned)f2bf(lo) | ((unsigned)f2bf(hi) << 16); }
__device__ __forceinline__ void transpose_item(const float* W, int ldn, int col0, int k0, bf16* dst, int pitch, const float* gain, LAS float* scr, int lane) {
#pragma unroll 8
    for (int i = 0; i < 32; ++i) { const int kk = 2 * i + (lane >> 5); float v = W[(size_t)(k0 + kk) * ldn + col0 + (lane & 31)]; if (gain) v *= gain[k0 + kk]; scr[kk * 33 + (lane & 31)] = v; }
    LDS_WAIT(); asm volatile("" ::: "memory");
    const int c = lane & 7;
#pragma unroll
    for (int j = 0; j < 4; ++j) { const int n = (lane >> 3) + 8 * j; const LAS float* s = scr + (8 * c) * 33 + n;
        v4u o; o.x = pk2(s[0 * 33], s[1 * 33]); o.y = pk2(s[2 * 33], s[3 * 33]); o.z = pk2(s[4 * 33], s[5 * 33]); o.w = pk2(s[6 * 33], s[7 * 33]);
        *(GAS v4u*)(dst + (size_t)n * pitch + k0 + 8 * c) = o; }
    LDS_WAIT(); asm volatile("" ::: "memory");
}

__device__ __forceinline__ const float* arg_in(const Args& a, int k) { asm volatile("" : "+s"(k)); return a.in[k]; }
#define INP(k) arg_in(args, k)
#define PHASE_PTRS unsigned char* wsl = args.ws; asm volatile("" : "+s"(wsl)); float* out = args.out; asm volatile("" : "+s"(out)); unsigned* ctl = (unsigned*)(wsl + WS_CTL); const float *x = INP(0), *mem = INP(1), *norm_mix = INP(2), *w_in = INP(3), *w_out = INP(15), *norm_cross = INP(16), *norm_mem = INP(17), *w_cq = INP(18), *w_ckv = INP(19), *w_co = INP(20); const float *norm_moe = INP(21), *w_router = INP(22), *w_gate = INP(24), *b_gate = INP(25), *w_up = INP(26), *b_up = INP(27), *w_down = INP(28), *b_down = INP(29), *norm_final = INP(30); float* ss1 = (float*)(wsl + WS_SSP1); float* ss2 = (float*)(wsl + WS_SSP2); bf16 *Win_t = (bf16*)(wsl + WS_WIN), *Wout_t = (bf16*)(wsl + WS_WOUT), *Wcq_t = (bf16*)(wsl + WS_WCQ), *Wckv_t = (bf16*)(wsl + WS_WCKV), *Wco_t = (bf16*)(wsl + WS_WCO), *Wgu_t = (bf16*)(wsl + WS_WGU), *Wd_t = (bf16*)(wsl + WS_WD); bf16 *XN = (bf16*)(wsl + WS_XN), *MIX = XN, *HB2 = XN, *PROJ = (bf16*)(wsl + WS_PROJ), *HB = (bf16*)(wsl + WS_HB), *Qb = (bf16*)(wsl + WS_Q), *Pb = (bf16*)(wsl + WS_P), *HID = (bf16*)(wsl + WS_HID); bf16 *O2 = (bf16*)(wsl + WS_O2), *Y = (bf16*)(wsl + WS_Y), *MEMN = (bf16*)(wsl + WS_MEMN), *KM = (bf16*)(wsl + WS_KM), *VT = (bf16*)(wsl + WS_VT); const float *dn_conv = INP(4), *dn_a_log = INP(5), *dn_dt_bias = INP(6), *dn_norm = INP(7), *rg_conv = INP(8), *rg_conv_b = INP(9); const float *rg_w_a = INP(10), *rg_b_a = INP(11), *rg_w_x = INP(12), *rg_b_x = INP(13), *rg_lambda = INP(14), *b_router = INP(23); float* QKVN = (float*)(wsl + WS_QKVN); float* ODN = (float*)(wsl + WS_ODN); float* BAf = (float*)(wsl + WS_BA); float* AA = out; float* BX = out + (size_t)M * 512; const int* TOKL = (const int*)(wsl + WS_TOKL); const float* GATEL = (const float*)(wsl + WS_GATEL); const float* RSL = (const float*)(wsl + WS_RSL); (void)ctl;
__device__ __forceinline__ void transpose_item64(const float* W, int ldn, int col0, int k0, bf16* dst, int pitch, const float* gain, LAS float* scr, int lane) {
    f32x4 v[16];
#pragma unroll
    for (int i = 0; i < 16; ++i) { const int kk = (lane >> 4) + 4 * i; v[i] = *(const f32x4*)(W + (size_t)(k0 + kk) * ldn + col0 + 4 * (lane & 15)); }
#pragma unroll
    for (int i = 0; i < 16; ++i) { const int kk = (lane >> 4) + 4 * i; f32x4 w = v[i]; if (gain) w = w * gain[k0 + kk]; LAS float* p = scr + kk * 65 + 4 * (lane & 15); p[0] = w[0]; p[1] = w[1]; p[2] = w[2]; p[3] = w[3]; }
    LDS_WAIT(); asm volatile("" ::: "memory");
    const int c = lane & 7;
#pragma unroll
    for (int j = 0; j < 8; ++j) { const int n = (lane >> 3) + 8 * j; const LAS float* sp = scr + (8 * c) * 65 + n;
        v4u o; o.x = pk2(sp[0 * 65], sp[1 * 65]); o.y = pk2(sp[2 * 65], sp[3 * 65]); o.z = pk2(sp[4 * 65], sp[5 * 65]); o.w = pk2(sp[6 * 65], sp[7 * 65]);
        *(GAS v4u*)(dst + (size_t)n * pitch + k0 + 8 * c) = o; }
    LDS_WAIT(); asm volatile("" ::: "memory");
}
__global__ void __launch_bounds__(NTHR, 2) mk_fwd(Args args) {
    extern __shared__ __attribute__((aligned(16))) unsigned char lds_raw[];
    LAS unsigned char* lds = (LAS unsigned char*)lds_raw;
    volatile LAS unsigned* LW = (volatile LAS unsigned*)(lds + LDSCTL_OFF);
    const int tid = threadIdx.x, lane = tid & 63, wave = __builtin_amdgcn_readfirstlane(tid >> 6), G = gridDim.x, bx = blockIdx.x;
    for (int u = tid; u < LW_NWORDS; u += NTHR) LW[u] = 0u;
    __syncthreads();
    XcdBarrier bar = xcd_barrier_post((unsigned*)(args.ws + WS_CTL) + CW_BAR + args.bli * XCD_BAR_WORDS, LW + LW_BAR);
    const int lo = args.ph_lo, hi = args.ph_hi;
#define STAMP(k) do { if (TS_LO >= 0 && blockIdx.x == 0 && threadIdx.x == 0) { unsigned char* w_ = args.ws; asm volatile("" : "+s"(w_)); __hip_atomic_store((unsigned long long*)(w_ + WS_TS) + (k), __builtin_amdgcn_s_memrealtime(), __ATOMIC_RELAXED, __HIP_MEMORY_SCOPE_AGENT); } } while (0)
    STAMP(0);
#ifndef DOUBLE_PHASE
#define DOUBLE_PHASE -1
#endif
#define REPS(k) ((DOUBLE_PHASE == (k)) ? 2 : 1)
#ifndef SKIPMASK
#define SKIPMASK 0
#endif
#define IN(k) (!((SKIPMASK >> (k)) & 1) && lo <= (k) && (k) < hi)
#define SEAM(k) do { if (IN(k) && IN((k) + 1)) xcd_barrier(bar); } while (0)
    const int gw = bx * NWAVES + wave, NGW = G * NWAVES;

    if (IN(0)) {
        PHASE_PTRS
        LAS float* scr = (LAS float*)(lds + wave * 16640);
        constexpr int I_IN = 16 * 48, I_SQ = 16 * 16, I_KV = 16 * 32;
        constexpr int NIT = I_IN + 3 * I_SQ + I_KV + 16;
        for (int it_ = gw; it_ < NIT * REPS(0); it_ += NGW) { const int it = it_ % NIT;
            int r = it;
            if (r < I_IN) { const int kb = r / 48, nb = r % 48, n0 = nb * 64; transpose_item64(w_in, NIN, n0 < 2048 ? n0 : n0 + 8, kb * 64, Win_t + (size_t)n0 * D, D, nullptr, scr, lane); continue; } r -= I_IN;
            if (r < I_SQ) { const int kb = r / 16, nb = r % 16; transpose_item64(w_out, D, nb * 64, kb * 64, Wout_t + (size_t)nb * 64 * D, D, nullptr, scr, lane); continue; } r -= I_SQ;
            if (r < I_SQ) { const int kb = r / 16, nb = r % 16; transpose_item64(w_cq, D, nb * 64, kb * 64, Wcq_t + (size_t)nb * 64 * D, D, norm_cross, scr, lane); continue; } r -= I_SQ;
            if (r < I_SQ) { const int kb = r / 16, nb = r % 16; transpose_item64(w_co, D, nb * 64, kb * 64, Wco_t + (size_t)nb * 64 * D, D, nullptr, scr, lane); continue; } r -= I_SQ;
            if (r < I_KV) { const int kb = r / 32, nb = r % 32; transpose_item64(w_ckv, 2048, nb * 64, kb * 64, Wckv_t + (size_t)nb * 64 * D, D, nullptr, scr, lane); continue; } r -= I_KV;
            { const int mat = r >> 1, kb = r & 1, gate = mat >> 2, nbk = mat & 3;
              transpose_item64((gate ? rg_w_x : rg_w_a) + (size_t)nbk * 128 * 128, 128, 0, kb * 64, (bf16*)(wsl + WS_RGW) + (size_t)mat * 128 * 128, 128, nullptr, scr, lane);
              transpose_item64((gate ? rg_w_x : rg_w_a) + (size_t)nbk * 128 * 128, 128, 64, kb * 64, (bf16*)(wsl + WS_RGW) + ((size_t)mat * 128 + 64) * 128, 128, nullptr, scr, lane); }
        }
        { bf16* WRh = (bf16*)(wsl + WS_WR); bf16* WRl = WRh + NE * D;
          for (int i = bx * NTHR + tid; i < NE * D; i += G * NTHR) { const int e = i >> 10, k = i & 1023; const float v = w_router[k * NE + e] * norm_moe[k]; const bf16 hv = f2bf(v); WRh[i] = hv; WRl[i] = f2bf(v - bf2f(hv)); } }
        __syncthreads();
        LAS float* w8 = (LAS float*)lds;
        for (int i = tid; i < D * 8; i += NTHR) w8[i] = w_in[(size_t)(i >> 3) * NIN + 2048 + (i & 7)];
        __syncthreads();
        float* BA = (float*)(wsl + WS_BA);
        for (int row_ = gw; row_ < (M + NB * MEML) * REPS(0); row_ += NGW) { const int row = row_ % (M + NB * MEML);
            const bool ismem = row >= M; const float* xr = ismem ? mem + (size_t)(row - M) * D : x + (size_t)row * D; const float* gn = ismem ? norm_mem : norm_mix;
            bf16* orow = ismem ? MEMN + (size_t)(row - M) * D : XN + (size_t)row * D;
            f32x4 v[4]; float s = 0.f;
#pragma unroll
            for (int j = 0; j < 4; ++j) { v[j] = *(const f32x4*)(xr + 4 * lane + 256 * j); s += (v[j][0] * v[j][0] + v[j][1] * v[j][1]) + (v[j][2] * v[j][2] + v[j][3] * v[j][3]); }
            const float rstd = rsqrtf(wave_sum(s) * (1.f / D) + EPS);
            float acc[8];
#pragma unroll
            for (int q = 0; q < 8; ++q) acc[q] = 0.f;
#pragma unroll
            for (int j = 0; j < 4; ++j) { const f32x4 gg = *(const f32x4*)(gn + 4 * lane + 256 * j); const f32x4 u = v[j] * rstd * gg;
                *(unsigned long long*)(orow + 4 * lane + 256 * j) = (unsigned long long)pk2(u[0], u[1]) | ((unsigned long long)pk2(u[2], u[3]) << 32);
                if (!ismem) {
#pragma unroll
                    for (int i = 0; i < 4; ++i) { const int k = 4 * lane + 256 * j + i; const f32x4 wa = *(const LAS f32x4*)(w8 + k * 8), wb = *(const LAS f32x4*)(w8 + k * 8 + 4);
                        acc[0] += u[i] * wa[0]; acc[1] += u[i] * wa[1]; acc[2] += u[i] * wa[2]; acc[3] += u[i] * wa[3]; acc[4] += u[i] * wb[0]; acc[5] += u[i] * wb[1]; acc[6] += u[i] * wb[2]; acc[7] += u[i] * wb[3]; } } }
            if (!ismem) {
#pragma unroll
                for (int q = 0; q < 8; ++q) { const float t = wave_sum(acc[q]); if (lane == q) BA[(size_t)row * 8 + q] = t; } }
        }
        __syncthreads();
    }
    SEAM(0);
    STAMP(1);
    if (IN(1)) {
        PHASE_PTRS
        { pg8::Gemm g{D, D, D}; pg8::StaticOrder S; S.init(XN, Win_t, M, NP, D, D, G, bx); S.rep = REPS(1); pg8::EpiStore E{PROJ, NP};
          pg8::gemm_phase<pg8::EpiStore, pg8::StaticOrder, true, false>(lds, g, S, E); }
    }
    SEAM(1);
    STAMP(2);
    if (IN(2)) {
        PHASE_PTRS
        for (int unit_ = bx; unit_ < NB * 64 * REPS(2); unit_ += G) { const int unit = unit_ & 255;
            const int b = unit >> 6, n = unit & 63; const size_t row0 = (size_t)b * T + n * 64;
            for (int itp = 0; itp < 2; ++itp) {
                const int half = __builtin_amdgcn_readfirstlane(tid >> 8), ht = tid & 255, hw = wave & 3, h = itp * 2 + half;
                LAS unsigned char* HL = lds + half * 53248;
                LAS bf16* QN = (LAS bf16*)HL; LAS bf16* KN = (LAS bf16*)(HL + 17408); LAS float* AL = (LAS float*)(HL + 34816); LAS float* GC = (LAS float*)(HL + 52224); LAS float* BT = GC + 64;
                unsigned char* ub = wsl + WS_DN + (size_t)((b * 4 + h) * 64 + n) * DNU_BYTES;
                if (hw == 0) { int lanev = lane; asm volatile("" : "+v"(lanev)); const size_t row = row0 + lanev; const float beta = sigmoidf_(BAf[row * 8 + h]); float gv = -__expf(dn_a_log[h]) * softplusf_(BAf[row * 8 + 4 + h] + dn_dt_bias[h]);
#pragma unroll
                    for (int o = 1; o < 64; o <<= 1) { const float tv = __shfl_up(gv, o); if (lanev >= o) gv += tv; }
                    GC[lanev] = gv; BT[lanev] = beta; }
                { const int gch = ht & 15;
#pragma unroll
                  for (int tensor = 0; tensor < 2; ++tensor) { const int cb = tensor * 512 + h * 128 + gch * 8; float wv[4][8];
#pragma unroll
                    for (int j = 0; j < 4; ++j) { const f32x4 w0 = *(const f32x4*)(dn_conv + j * 1536 + cb), w1 = *(const f32x4*)(dn_conv + j * 1536 + cb + 4);
                        wv[j][0] = w0[0]; wv[j][1] = w0[1]; wv[j][2] = w0[2]; wv[j][3] = w0[3]; wv[j][4] = w1[0]; wv[j][5] = w1[1]; wv[j][6] = w1[2]; wv[j][7] = w1[3]; }
#pragma unroll
                    for (int ii = 0; ii < 4; ++ii) { const int c = (ht >> 4) + 16 * ii, t = n * 64 + c; float a8[8];
#pragma unroll
                        for (int e = 0; e < 8; ++e) a8[e] = 0.f;
#pragma unroll
                        for (int j = 0; j < 4; ++j) { if (t + j - 3 >= 0) { const v4u pr = *(const v4u*)(PROJ + (row0 + c + j - 3) * NP + cb);
#pragma unroll
                                for (int e = 0; e < 4; ++e) { a8[2 * e] += wv[j][2 * e] * bf2f((bf16)(pr[e] & 0xffff)); a8[2 * e + 1] += wv[j][2 * e + 1] * bf2f((bf16)(pr[e] >> 16)); } } }
                        float ssq = 0.f;
#pragma unroll
                        for (int e = 0; e < 8; ++e) { a8[e] = siluf_(a8[e]); ssq += a8[e] * a8[e]; }
                        ssq += __shfl_xor(ssq, 1); ssq += __shfl_xor(ssq, 2); ssq += __shfl_xor(ssq, 4); ssq += __shfl_xor(ssq, 8);
                        const float rn = rsqrtf(ssq + EPS); v4u o; o.x = pk2(a8[0] * rn, a8[1] * rn); o.y = pk2(a8[2] * rn, a8[3] * rn); o.z = pk2(a8[4] * rn, a8[5] * rn); o.w = pk2(a8[6] * rn, a8[7] * rn);
                        *(LAS v4u*)((tensor ? KN : QN) + c * 136 + gch * 8) = o; } } }
                __syncthreads();
                if (hw < 3) { const int ci = hw == 0 ? 0 : 1, si = hw == 2 ? 1 : 0; int l31 = lane & 31, hh = lane >> 5; asm volatile("" : "+v"(l31), "+v"(hh)); f32x16 kk, qk;
#pragma unroll
                    for (int r = 0; r < 16; ++r) { kk[r] = 0.f; qk[r] = 0.f; }
#pragma unroll
                    for (int ks = 0; ks < 8; ++ks) { const bf16x8 ak = *(const LAS bf16x8*)(KN + (32 * ci + l31) * 136 + 16 * ks + 8 * hh), aq = *(const LAS bf16x8*)(QN + (32 * ci + l31) * 136 + 16 * ks + 8 * hh);
                        const bf16x8 bk = *(const LAS bf16x8*)(KN + (32 * si + l31) * 136 + 16 * ks + 8 * hh);
                        kk = __builtin_amdgcn_mfma_f32_32x32x16_bf16(ak, bk, kk, 0, 0, 0); qk = __builtin_amdgcn_mfma_f32_32x32x16_bf16(aq, bk, qk, 0, 0, 0); }
                    const int sc = 32 * si + l31; const float gs = GC[sc]; bf16* QKg = (bf16*)(ub + DNU_QK);
#pragma unroll
                    for (int r = 0; r < 16; ++r) { const int c = 32 * ci + (r & 3) + 8 * (r >> 2) + 4 * hh; const float dec = c >= sc ? __expf(GC[c] - gs) : 0.f;
                        AL[c * 68 + sc] = c > sc ? BT[c] * kk[r] * dec : 0.f; QKg[c * 64 + kperm(sc)] = f2bf(qk[r] * 0.08838834764831845f * dec); } }
                __syncthreads();
                { float xs[64];
                  if (ht < 128) { const int cv = PC_V + h * 128 + ht; const float w0 = dn_conv[cv], w1 = dn_conv[1536 + cv], w2 = dn_conv[2 * 1536 + cv], w3 = dn_conv[3 * 1536 + cv];
                      float p3 = 0.f, p2 = 0.f, p1 = 0.f; if (n > 0) { p3 = bf2f(PROJ[(row0 - 3) * NP + cv]); p2 = bf2f(PROJ[(row0 - 2) * NP + cv]); p1 = bf2f(PROJ[(row0 - 1) * NP + cv]); }
                      const bf16* pp = PROJ + row0 * NP + cv;
#pragma unroll
                      for (int c = 0; c < 64; ++c) { const float cu = bf2f(*pp); pp += NP; asm volatile("" : "+v"(pp)); xs[c] = siluf_(w0 * p3 + w1 * p2 + w2 * p1 + w3 * cu) * BT[c]; p3 = p2; p2 = p1; p1 = cu; } }
                  else { const int dk = ht - 128;
#pragma unroll
                      for (int c = 0; c < 64; ++c) xs[c] = bf2f(KN[c * 136 + dk]) * BT[c] * __expf(GC[c]); }
#pragma unroll
                  for (int i = 1; i < 64; ++i) { float acc = xs[i];
#pragma unroll
                      for (int j = 0; j < i; ++j) acc -= AL[i * 68 + j] * xs[j];
                      xs[i] = acc; }
                  if (ht < 128) { bf16* UT = (bf16*)(ub + DNU_UT) + ht * 64;
#pragma unroll
                      for (int c8 = 0; c8 < 8; ++c8) { v4u o; o.x = pk2(xs[8 * c8], xs[8 * c8 + 1]); o.y = pk2(xs[8 * c8 + 2], xs[8 * c8 + 3]); o.z = pk2(xs[8 * c8 + 4], xs[8 * c8 + 5]); o.w = pk2(xs[8 * c8 + 6], xs[8 * c8 + 7]); *(v4u*)(UT + 8 * c8) = o; } }
                  else { bf16* Wn = (bf16*)(ub + DNU_WN) + kperm(ht - 128);
#pragma unroll
                      for (int c = 0; c < 64; ++c) { *Wn = f2bf(-xs[c]); Wn += 128; asm volatile("" : "+v"(Wn)); } } }
                { const int c = ht >> 2, d0 = (ht & 3) * 32; const float sc = 0.08838834764831845f * __expf(GC[c]); bf16* Qg = (bf16*)(ub + DNU_QG);
#pragma unroll
                  for (int q = 0; q < 4; ++q) { v4u o;
#pragma unroll
                      for (int e = 0; e < 4; ++e) { const int p0 = d0 + 8 * q + 2 * e; o[e] = pk2(bf2f(QN[c * 136 + kperm(p0)]) * sc, bf2f(QN[c * 136 + kperm(p0 + 1)]) * sc); }
                      *(v4u*)(Qg + c * 128 + d0 + 8 * q) = o; }
                  const int dk = ht >> 1, c0 = (ht & 1) * 32; const float gl = GC[63]; bf16* KdT = (bf16*)(ub + DNU_KDT);
#pragma unroll
                  for (int q = 0; q < 4; ++q) { v4u o;
#pragma unroll
                      for (int e = 0; e < 4; ++e) { const int ca = kperm(c0 + 8 * q + 2 * e), cb2 = kperm(c0 + 8 * q + 2 * e + 1); o[e] = pk2(bf2f(KN[ca * 136 + dk]) * __expf(gl - GC[ca]), bf2f(KN[cb2 * 136 + dk]) * __expf(gl - GC[cb2])); }
                      *(v4u*)(KdT + dk * 64 + c0 + 8 * q) = o; }
                  if (ht == 0) ((float*)(wsl + WS_DEC))[(b * 4 + h) * 64 + n] = __expf(gl); }
                __syncthreads();
            }
            { LAS bf16* XRb = (LAS bf16*)lds; LAS unsigned* RI = (LAS unsigned*)(lds + 17408); const bf16* RGW = (const bf16*)(wsl + WS_RGW);
              for (int nbk = 0; nbk < 4; ++nbk) {
#pragma unroll
                for (int ii = 0; ii < 2; ++ii) { const int gch = tid & 15, c = (tid >> 4) + 32 * ii, t = n * 64 + c, cb = nbk * 128 + gch * 8; float a8[8];
                    { const f32x4 b0 = *(const f32x4*)(rg_conv_b + cb), b1 = *(const f32x4*)(rg_conv_b + cb + 4); a8[0] = b0[0]; a8[1] = b0[1]; a8[2] = b0[2]; a8[3] = b0[3]; a8[4] = b1[0]; a8[5] = b1[1]; a8[6] = b1[2]; a8[7] = b1[3]; }
#pragma unroll
                    for (int j = 0; j < 4; ++j) { if (t + j - 3 >= 0) { const v4u pr = *(const v4u*)(PROJ + (row0 + c + j - 3) * NP + PC_RX + cb); const f32x4 w0 = *(const f32x4*)(rg_conv + j * 512 + cb), w1 = *(const f32x4*)(rg_conv + j * 512 + cb + 4);
                            a8[0] += w0[0] * bf2f((bf16)(pr[0] & 0xffff)); a8[1] += w0[1] * bf2f((bf16)(pr[0] >> 16)); a8[2] += w0[2] * bf2f((bf16)(pr[1] & 0xffff)); a8[3] += w0[3] * bf2f((bf16)(pr[1] >> 16));
                            a8[4] += w1[0] * bf2f((bf16)(pr[2] & 0xffff)); a8[5] += w1[1] * bf2f((bf16)(pr[2] >> 16)); a8[6] += w1[2] * bf2f((bf16)(pr[3] & 0xffff)); a8[7] += w1[3] * bf2f((bf16)(pr[3] >> 16)); } }
                    v4u o; o.x = pk2(a8[0], a8[1]); o.y = pk2(a8[2], a8[3]); o.z = pk2(a8[4], a8[5]); o.w = pk2(a8[6], a8[7]); *(LAS v4u*)(XRb + c * 136 + gch * 8) = o; }
                __syncthreads();
                { const int gate = wave >> 2, ot = wave & 3, l31 = lane & 31, hh = lane >> 5, outc = 32 * ot + l31, ch = nbk * 128 + outc; f32x16 ac[2];
#pragma unroll
                  for (int r = 0; r < 16; ++r) { ac[0][r] = 0.f; ac[1][r] = 0.f; }
                  const bf16* wrow = RGW + ((size_t)(gate * 4 + nbk) * 128 + outc) * 128 + 8 * hh;
#pragma unroll
                  for (int ks = 0; ks < 8; ++ks) { const bf16x8 bw = *(const bf16x8*)(wrow + 16 * ks);
#pragma unroll
                      for (int mt = 0; mt < 2; ++mt) ac[mt] = __builtin_amdgcn_mfma_f32_32x32x16_bf16(*(const LAS bf16x8*)(XRb + (32 * mt + l31) * 136 + 16 * ks + 8 * hh), bw, ac[mt], 0, 0, 0); }
                  const float bias = gate ? rg_b_x[ch] : rg_b_a[ch]; LAS bf16* RIh = (LAS bf16*)RI;
#pragma unroll
                  for (int mt = 0; mt < 2; ++mt)
#pragma unroll
                      for (int r = 0; r < 16; ++r) { const int c = 32 * mt + (r & 3) + 8 * (r >> 2) + 4 * hh; float v = sigmoidf_(ac[mt][r] + bias); if (gate) v *= bf2f(XRb[c * 136 + outc]);
                          RIh[(c * 516 + ch) * 2 + gate] = f2bf(v); } }
                __syncthreads();
              }
              { const int ch = tid; const float lsl = -softplusf_(-rg_lambda[ch]); float hs = 0.f, cp = 1.f; bf16* HL = (bf16*)(wsl + WS_HLOC) + row0 * 512 + ch; bf16* CPg = (bf16*)(wsl + WS_CP) + row0 * 512 + ch;
#pragma unroll 4
                for (int c = 0; c < 64; ++c) { const unsigned w = RI[c * 516 + ch]; const float r = bf2f((bf16)(w & 0xffff)), ix = bf2f((bf16)(w >> 16)), a = __expf(8.f * r * lsl);
                    const float mult = (n == 0 && c == 0) ? 1.f : sqrtf(fmaxf(1.f - a * a, 0.f)); hs = a * hs + mult * ix; cp *= a; *HL = f2bf(hs); *CPg = f2bf(cp); HL += 512; CPg += 512; asm volatile("" : "+v"(HL), "+v"(CPg)); }
                float* SUM = (float*)(wsl + WS_RGSUM); SUM[(size_t)(b * 64 + n) * 512 + ch] = cp; SUM[(size_t)(256 + b * 64 + n) * 512 + ch] = hs; }
              __syncthreads();
            }
        }
    }
    SEAM(2);
    STAMP(3);
    if (IN(3)) {
        PHASE_PTRS
        if (bx < 16) {
            const int b = bx >> 2, h = bx & 3, l31 = lane & 31, hh = lane >> 5, sl = wave;
            const unsigned char* ubase = wsl + WS_DN + (size_t)((b * 4 + h) * 64) * DNU_BYTES; const float* DECp = (const float*)(wsl + WS_DEC) + (b * 4 + h) * 64;
            constexpr int DN_STG = 57344;
            unsigned soff[7];
#pragma unroll
            for (int i = 0; i < 7; ++i) { const int p = wave + 8 * i, q = p * 64 + lane; int src16;
                if (p < 32) { const int r = q >> 4, ch = (q & 15) ^ (r & 15); src16 = r * 16 + ch; } else { const int r = q >> 3, ch = (q & 7) ^ ((r >> 1) & 7); src16 = r * 8 + ch; }
                soff[i] = (unsigned)src16 * 16u; }
#define DN_STAGE(nn, buf) do { const unsigned char* _g = ubase + (size_t)(nn) * DNU_BYTES; _Pragma("unroll") for (int _i = 0; _i < 7; ++_i) \
                __builtin_amdgcn_global_load_lds((const unsigned*)(_g + soff[_i]), (LAS unsigned*)(lds + (buf) * DN_STG + (wave + 8 * _i) * 1024), 16, 0, 0); } while (0)
#define DN_ULOAD(nn) do { const unsigned char* _g = ubase + (size_t)(nn) * DNU_BYTES + DNU_UT + utrow; _Pragma("unroll") for (int _x = 0; _x < 8; ++_x) un[_x] = *(const unsigned long long*)(_g + 16 * _x); } while (0)
            unsigned a256[8], a128[4];
#pragma unroll
            for (int ks = 0; ks < 8; ++ks) a256[ks] = (unsigned)(l31 * 256 + 16 * ((2 * ks + hh) ^ (l31 & 15)));
#pragma unroll
            for (int ks = 0; ks < 4; ++ks) a128[ks] = (unsigned)(l31 * 128 + 16 * ((2 * ks + hh) ^ ((l31 >> 1) & 7)));
            const unsigned utrow = (unsigned)((32 * (sl & 3) + l31) * 128 + 8 * hh); unsigned long long un[8];
            f32x16 S[4];
#pragma unroll
            for (int t = 0; t < 4; ++t)
#pragma unroll
                for (int r = 0; r < 16; ++r) S[t][r] = 0.f;
            DN_STAGE(0, 0); DN_ULOAD(0);
            asm volatile("s_waitcnt vmcnt(0)" ::: "memory"); __syncthreads();
            for (int n_ = 0; n_ < 64 * REPS(3); ++n_) { const int n = n_ & 63;
                const int buf = n & 1;
                if (n == 0 && n_ > 0) { _Pragma("unroll") for (int t = 0; t < 4; ++t) _Pragma("unroll") for (int r = 0; r < 16; ++r) S[t][r] = 0.f; }
                if (n_ + 1 < 64 * REPS(3)) DN_STAGE((n + 1) & 63, buf ^ 1);
                if (wave < 4) {
                    const LAS unsigned char* L = lds + buf * DN_STG; const float dcy = __builtin_bit_cast(float, __hip_atomic_load((const unsigned*)(DECp + n), __ATOMIC_RELAXED, __HIP_MEMORY_SCOPE_AGENT)); const size_t row0 = (size_t)b * T + n * 64;
                    bf16x8 Sb[8];
#pragma unroll
                    for (int t = 0; t < 4; ++t)
#pragma unroll
                        for (int s2 = 0; s2 < 2; ++s2) { v4u w; w.x = cvtpk_s(S[t][8 * s2], S[t][8 * s2 + 1]); w.y = cvtpk_s(S[t][8 * s2 + 2], S[t][8 * s2 + 3]); w.z = cvtpk_s(S[t][8 * s2 + 4], S[t][8 * s2 + 5]); w.w = cvtpk_s(S[t][8 * s2 + 6], S[t][8 * s2 + 7]);
                            Sb[2 * t + s2] = __builtin_bit_cast(bf16x8, w); }
                    f32x16 VN[2];
#pragma unroll
                    for (int mt = 0; mt < 2; ++mt)
#pragma unroll
                        for (int g4 = 0; g4 < 4; ++g4) { const unsigned long long uu = un[4 * mt + g4];
                            VN[mt][4 * g4] = bf2f((bf16)(uu & 0xffff)); VN[mt][4 * g4 + 1] = bf2f((bf16)((uu >> 16) & 0xffff)); VN[mt][4 * g4 + 2] = bf2f((bf16)((uu >> 32) & 0xffff)); VN[mt][4 * g4 + 3] = bf2f((bf16)(uu >> 48)); }
#pragma unroll
                    for (int ks = 0; ks < 8; ++ks)
#pragma unroll
                        for (int mt = 0; mt < 2; ++mt) VN[mt] = __builtin_amdgcn_mfma_f32_32x32x16_bf16(*(const LAS bf16x8*)(L + DNU_WN + mt * 8192 + a256[ks]), Sb[ks], VN[mt], 0, 0, 0);
                    if (n_ + 1 < 64 * REPS(3)) DN_ULOAD((n + 1) & 63);
                    bf16x8 vb[4];
#pragma unroll
                    for (int mt = 0; mt < 2; ++mt)
#pragma unroll
                        for (int s2 = 0; s2 < 2; ++s2) { v4u w; w.x = cvtpk_s(VN[mt][8 * s2], VN[mt][8 * s2 + 1]); w.y = cvtpk_s(VN[mt][8 * s2 + 2], VN[mt][8 * s2 + 3]); w.z = cvtpk_s(VN[mt][8 * s2 + 4], VN[mt][8 * s2 + 5]); w.w = cvtpk_s(VN[mt][8 * s2 + 6], VN[mt][8 * s2 + 7]);
                            vb[2 * mt + s2] = __builtin_bit_cast(bf16x8, w); }
#pragma unroll
                    for (int t = 0; t < 4; ++t) { S[t] = S[t] * dcy;
#pragma unroll
                        for (int kc = 0; kc < 4; ++kc) S[t] = __builtin_amdgcn_mfma_f32_32x32x16_bf16(*(const LAS bf16x8*)(L + DNU_KDT + t * 4096 + a128[kc]), vb[kc], S[t], 0, 0, 0); }
#pragma unroll
                    for (int mt = 0; mt < 2; ++mt) { f32x16 O;
#pragma unroll
                        for (int r = 0; r < 16; ++r) O[r] = 0.f;
#pragma unroll
                        for (int ks = 0; ks < 8; ++ks) O = __builtin_amdgcn_mfma_f32_32x32x16_bf16(*(const LAS bf16x8*)(L + DNU_QG + mt * 8192 + a256[ks]), Sb[ks], O, 0, 0, 0);
#pragma unroll
                        for (int kc = 0; kc < 2 + 2 * mt; ++kc) O = __builtin_amdgcn_mfma_f32_32x32x16_bf16(*(const LAS bf16x8*)(L + DNU_QK + mt * 4096 + a128[kc]), vb[kc], O, 0, 0, 0);
                        float* op = ODN + (row0 + 32 * mt + 4 * hh) * 512 + h * 128 + 32 * sl + l31;
#pragma unroll
                        for (int r = 0; r < 16; ++r) op[(size_t)((r & 3) + 8 * (r >> 2)) * 512] = O[r]; }
                }
                asm volatile("s_waitcnt vmcnt(0)" ::: "memory"); __syncthreads();
            }
#undef DN_STAGE
#undef DN_ULOAD
        } else if (bx < 20) {
            const int b = bx - 16, ch = tid; const float* SUM = (const float*)(wsl + WS_RGSUM); float* CARRY = (float*)(wsl + WS_CARRY); float carry = 0.f;
            for (int n0 = 0; n0 < 64; n0 += 8) { float ap[8], he[8];
#pragma unroll
                for (int j = 0; j < 8; ++j) { ap[j] = SUM[(size_t)(b * 64 + n0 + j) * 512 + ch]; he[j] = SUM[(size_t)(256 + b * 64 + n0 + j) * 512 + ch]; }
#pragma unroll
                for (int j = 0; j < 8; ++j) { CARRY[(size_t)(b * 64 + n0 + j) * 512 + ch] = carry; carry = ap[j] * carry + he[j]; } }
        } else if (bx < 52) {
            if (bx < 36) { pg8::Gemm g{D, D, D}; pg8::StaticOrder S; S.init(MEMN, Wckv_t, NB * MEML, D, D, D, 16, bx - 20); pg8::EpiStore E{KM, D};
                pg8::gemm_phase<pg8::EpiStore, pg8::StaticOrder, true, false>(lds, g, S, E); }
            else { pg8::Gemm g{D, D, D}; pg8::StaticOrder S; S.init(Wckv_t + (size_t)D * D, MEMN, D, NB * MEML, D, D, 16, bx - 36); pg8::EpiStore E{VT, D};
                pg8::gemm_phase<pg8::EpiStore, pg8::StaticOrder, true, false>(lds, g, S, E); }
        } else if (wave < 4) {
            LAS float* scr = (LAS float*)(lds + wave * 16640); const int cw = (bx - 52) * 4 + wave, NCW = (G - 52) * 4;
            constexpr int I_GU = 32 * 2 * 16 * 16, I_D = 32 * 16 * 16;
            for (int it_ = cw; it_ < (I_GU + I_D) * REPS(3); it_ += NCW) { const int it = it_ % (I_GU + I_D);
                if (it < I_GU) { const int nb = it & 15, kb = (it >> 4) & 15, which = (it >> 8) & 1, e = it >> 9, n0 = nb * 64;
                    transpose_item64((which ? w_up : w_gate) + (size_t)e * D * D, D, n0, kb * 64, Wgu_t + ((size_t)e * 2048 + (n0 >> 7) * 256 + (n0 & 127) + which * 128) * D, D, norm_moe, scr, lane); }
                else { const int r = it - I_GU, nb = r & 15, kb = (r >> 4) & 15, e = r >> 8;
                    transpose_item64(w_down + (size_t)e * D * D, D, nb * 64, kb * 64, Wd_t + ((size_t)e * 1024 + nb * 64) * D, D, nullptr, scr, lane); }
            }
        }
    }
    SEAM(3);
    STAMP(4);
    if (IN(4)) {
        PHASE_PTRS
        for (int row_ = gw; row_ < M * REPS(4); row_ += NGW) { const int row = row_ % M, c0 = 8 * lane;
            const f32x4 o0 = *(const f32x4*)(ODN + (size_t)row * 512 + c0), o1 = *(const f32x4*)(ODN + (size_t)row * 512 + c0 + 4); const v4u zz = *(const v4u*)(PROJ + (size_t)row * NP + PC_Z + c0);
            float q = (o0[0] * o0[0] + o0[1] * o0[1]) + (o0[2] * o0[2] + o0[3] * o0[3]) + (o1[0] * o1[0] + o1[1] * o1[1]) + (o1[2] * o1[2] + o1[3] * o1[3]);
            q += __shfl_xor(q, 1); q += __shfl_xor(q, 2); q += __shfl_xor(q, 4); q += __shfl_xor(q, 8);
            const float rs = rsqrtf(q * (1.f / 128) + EPS); const f32x4 g0 = *(const f32x4*)(dn_norm + (c0 & 127)), g1 = *(const f32x4*)(dn_norm + (c0 & 127) + 4); v4u ov;
#pragma unroll
            for (int e = 0; e < 4; ++e) { const float a = (e < 2 ? o0[2 * e] : o1[2 * e - 4]) * rs * (e < 2 ? g0[2 * e] : g1[2 * e - 4]) * siluf_(bf2f((bf16)(zz[e] & 0xffff)));
                const float bq = (e < 2 ? o0[2 * e + 1] : o1[2 * e - 3]) * rs * (e < 2 ? g0[2 * e + 1] : g1[2 * e - 3]) * siluf_(bf2f((bf16)(zz[e] >> 16))); ov[e] = pk2(a, bq); }
            *(v4u*)(MIX + (size_t)row * D + c0) = ov; }
        for (int unit_ = bx; unit_ < NB * 64 * REPS(4); unit_ += G) { const int unit = unit_ & 255, c0 = 8 * lane; const size_t row0 = (size_t)unit * 64;
            const f32x4 ca = *(const f32x4*)((const float*)(wsl + WS_CARRY) + (size_t)unit * 512 + c0), cb = *(const f32x4*)((const float*)(wsl + WS_CARRY) + (size_t)unit * 512 + c0 + 4);
#pragma unroll 2
            for (int c = wave; c < 64; c += NWAVES) { const size_t row = row0 + c; const v4u hl = *(const v4u*)((const bf16*)(wsl + WS_HLOC) + row * 512 + c0), cpv = *(const v4u*)((const bf16*)(wsl + WS_CP) + row * 512 + c0), yy = *(const v4u*)(PROJ + row * NP + PC_RY + c0); v4u ov;
#pragma unroll
                for (int e = 0; e < 4; ++e) { const float c_lo = e < 2 ? ca[2 * e] : cb[2 * e - 4], c_hi = e < 2 ? ca[2 * e + 1] : cb[2 * e - 3];
                    const float h0 = bf2f((bf16)(hl[e] & 0xffff)) + bf2f((bf16)(cpv[e] & 0xffff)) * c_lo, h1 = bf2f((bf16)(hl[e] >> 16)) + bf2f((bf16)(cpv[e] >> 16)) * c_hi;
                    ov[e] = pk2(h0 * gelu_tanh(bf2f((bf16)(yy[e] & 0xffff))), h1 * gelu_tanh(bf2f((bf16)(yy[e] >> 16)))); }
                *(v4u*)(MIX + row * D + 512 + c0) = ov; } }
    }
    SEAM(4);
    STAMP(5);
    if (IN(5)) {
        PHASE_PTRS
        pg8::Gemm g{D, D, D}; pg8::StaticOrder S; S.init(MIX, Wout_t, M, D, D, D, G, bx); S.rep = REPS(5); pg8::EpiResid E{x, out, HB, ss1};
        pg8::gemm_phase<pg8::EpiResid, pg8::StaticOrder, true, false>(lds, g, S, E);
    }
    SEAM(5);
    STAMP(6);
    if (IN(6)) {
        PHASE_PTRS
        for (int rp6 = 0; rp6 < REPS(6); ++rp6) { const int ut = bx; if (ut < (M / 256) * 4) {
            const int pm = ut >> 2, h = ut & 3, b = pm / (T / 256);
            { pg8::Gemm g{D, D, D}; pg8::OneUnit S; S.u0 = pg8::Unit{pm, h, (const char*)(HB + (size_t)pm * 256 * D), (const char*)(Wcq_t + (size_t)h * 256 * D), 0, 0};
              pg8::EpiRowScale E{Qb, ss1, 0.0625f}; pg8::gemm_phase<pg8::EpiRowScale, pg8::OneUnit, false, false>(lds, g, S, E); }
            asm volatile("s_waitcnt vmcnt(0)" ::: "memory"); __syncthreads();
            { pg8::Gemm g{D, D, 256}; pg8::OneUnit S; S.u0 = pg8::Unit{pm, h, (const char*)(Qb + (size_t)pm * 256 * D + h * 256), (const char*)(KM + (size_t)b * 256 * D + h * 256), 0, 0};
              pg8::EpiSoftmax E{Pb}; pg8::gemm_phase<pg8::EpiSoftmax, pg8::OneUnit, false, false>(lds, g, S, E); }
            asm volatile("s_waitcnt vmcnt(0)" ::: "memory"); __syncthreads();
            { pg8::Gemm g{D, D, 256}; pg8::OneUnit S; S.u0 = pg8::Unit{pm, h, (const char*)(Pb + (size_t)pm * 256 * D + h * 256), (const char*)(VT + (size_t)h * 256 * D + b * 256), 0, 0};
              pg8::EpiStore E{O2, D}; pg8::gemm_phase<pg8::EpiStore, pg8::OneUnit, false, false>(lds, g, S, E); }
            asm volatile("s_waitcnt vmcnt(0)" ::: "memory"); __syncthreads();
        } }
    }
    SEAM(6);
    STAMP(7);
    if (IN(7)) {
        PHASE_PTRS
        pg8::Gemm g{D, D, D}; pg8::StaticOrder S; S.init(O2, Wco_t, M, D, D, D, G, bx); pg8::EpiResid E{out, out, HB2, ss2};
        pg8::gemm_phase<pg8::EpiResid, pg8::StaticOrder, true, false>(lds, g, S, E);
    }
    SEAM(7);
    STAMP(8);
    if (IN(8)) {
        PHASE_PTRS
        unsigned* cntg = ctl + CW_CNT; int* TOKLw = (int*)(wsl + WS_TOKL); float* GATELw = (float*)(wsl + WS_GATEL); float* RSLw = (float*)(wsl + WS_RSL);
        const bf16* WRh = (const bf16*)(wsl + WS_WR); const bf16* WRl = WRh + NE * D; LAS float* part = (LAS float*)lds;
        for (int rb = bx; rb < M / 64; rb += G) {
            const int rgp = wave & 1, kq = wave >> 1, l31 = lane & 31, hh = lane >> 5; f32x16 acc;
#pragma unroll
            for (int r = 0; r < 16; ++r) acc[r] = 0.f;
            const float* arow = out + (size_t)(rb * 64 + rgp * 32 + l31) * D + kq * 256 + 8 * hh; const bf16* bh = WRh + (size_t)l31 * D + kq * 256 + 8 * hh; const bf16* bl = WRl + (size_t)l31 * D + kq * 256 + 8 * hh;
#pragma unroll 4
            for (int ks = 0; ks < 16; ++ks) { const f32x4 a0 = *(const f32x4*)(arow + 16 * ks), a1 = *(const f32x4*)(arow + 16 * ks + 4); const bf16x8 bhv = *(const bf16x8*)(bh + 16 * ks), blv = *(const bf16x8*)(bl + 16 * ks);
                v4u ah, al;
#pragma unroll
                for (int e = 0; e < 4; ++e) { const float x0 = e < 2 ? a0[2 * e] : a1[2 * e - 4], x1 = e < 2 ? a0[2 * e + 1] : a1[2 * e - 3]; const bf16 h0 = f2bf(x0), h1 = f2bf(x1);
                    ah[e] = (unsigned)h0 | ((unsigned)h1 << 16); al[e] = pk2(x0 - bf2f(h0), x1 - bf2f(h1)); }
                const bf16x8 ahv = __builtin_bit_cast(bf16x8, ah), alv = __builtin_bit_cast(bf16x8, al);
                acc = __builtin_amdgcn_mfma_f32_32x32x16_bf16(ahv, bhv, acc, 0, 0, 0); acc = __builtin_amdgcn_mfma_f32_32x32x16_bf16(alv, bhv, acc, 0, 0, 0); acc = __builtin_amdgcn_mfma_f32_32x32x16_bf16(ahv, blv, acc, 0, 0, 0); }
#pragma unroll
            for (int r = 0; r < 16; ++r) part[(kq * 64 + rgp * 32 + (r & 3) + 8 * (r >> 2) + 4 * hh) * 33 + l31] = acc[r];
            __syncthreads();
            if (tid < 64) { const int row = rb * 64 + tid; const float rs = rsqrtf(pg8::row_ss(ss2, row) * (1.f / D) + EPS); float lg[32];
#pragma unroll
                for (int e = 0; e < 32; ++e) lg[e] = ((part[tid * 33 + e] + part[(64 + tid) * 33 + e]) + (part[(128 + tid) * 33 + e] + part[(192 + tid) * 33 + e])) * rs + b_router[e];
                float tl[4]; int te[4];
#pragma unroll
                for (int q = 0; q < 4; ++q) { float m = lg[0]; int mi = 0;
#pragma unroll
                    for (int e = 1; e < 32; ++e) if (lg[e] > m) { m = lg[e]; mi = e; }
                    tl[q] = m; te[q] = mi;
#pragma unroll
                    for (int e = 0; e < 32; ++e) if (e == mi) lg[e] = -3.0e38f; }
                const float e1 = __expf(tl[1] - tl[0]), e2 = __expf(tl[2] - tl[0]), e3 = __expf(tl[3] - tl[0]), inv = 1.f / (1.f + e1 + e2 + e3);
                LAS unsigned* lcnt = (LAS unsigned*)(lds + 40960); LAS unsigned* lbase = lcnt + 32;
                if (tid < 32) lcnt[tid] = 0u;
                LDS_WAIT(); __builtin_amdgcn_wave_barrier();
                unsigned lp[4];
#pragma unroll
                for (int q = 0; q < 4; ++q) lp[q] = __hip_atomic_fetch_add(&lcnt[te[q]], 1u, __ATOMIC_RELAXED, __HIP_MEMORY_SCOPE_WORKGROUP);
                LDS_WAIT(); __builtin_amdgcn_wave_barrier();
                if (tid < 32) lbase[tid] = atomicAdd(&cntg[tid * CNT_STRIDE], lcnt[tid]);
                LDS_WAIT(); __builtin_amdgcn_wave_barrier();
#pragma unroll
                for (int q = 0; q < 4; ++q) { const float gv = (q == 0 ? 1.f : q == 1 ? e1 : q == 2 ? e2 : e3) * inv; const unsigned pos = lbase[te[q]] + lp[q];
                    TOKLw[te[q] * M + pos] = row * 4 + q; GATELw[te[q] * M + pos] = gv; RSLw[te[q] * M + pos] = rs; } }
            __syncthreads();
        }
    }
    SEAM(8);
    STAMP(9);
    if (IN(9) || IN(10)) {
        PHASE_PTRS
        const unsigned* cntg = ctl + CW_CNT;
        if (tid < 32) LW[LW_CNT + tid] = cntg[tid * CNT_STRIDE];
        __syncthreads();
        if (tid == 0) { int s = 0; for (int e = 0; e < 32; ++e) { LW[LW_TSTART + e] = (unsigned)s; s += ((int)LW[LW_CNT + e] + 255) >> 8; } LW[LW_TSTART + 32] = (unsigned)s; }
        __syncthreads();
    }
    const LAS int* tstart = (const LAS int*)(lds + LDSCTL_OFF) + LW_TSTART; const LAS int* cntl = (const LAS int*)(lds + LDSCTL_OFF) + LW_CNT;
    if (IN(9)) {
        PHASE_PTRS
        pg8::Gemm g{D, D, D}; pg8::MoeOrder<8, true> S{G, bx, tstart, cntl, (const char*)HB2, (const char*)Wgu_t, TOKL, REPS(9)};
        pg8::EpiFFN1 E{HID, RSL, b_gate, b_up, cntl};
        pg8::gemm_phase<pg8::EpiFFN1, pg8::MoeOrder<8, true>, true, true>(lds, g, S, E);
    }
    SEAM(9);
    STAMP(10);
    if (IN(10)) {
        PHASE_PTRS
        pg8::Gemm g{D, D, D}; pg8::MoeOrder<4, false> S{G, bx, tstart, cntl, (const char*)HID, (const char*)Wd_t, TOKL, REPS(10)};
        pg8::EpiFFN2 E{Y, TOKL, GATEL, b_down, cntl};
        pg8::gemm_phase<pg8::EpiFFN2, pg8::MoeOrder<4, false>, true, false>(lds, g, S, E);
    }
    SEAM(10);
    STAMP(11);
    if (IN(11)) {
        PHASE_PTRS
        for (int row = gw; row < M; row += NGW) {
            f32x4 v[4]; float s = 0.f;
#pragma unroll
            for (int j = 0; j < 4; ++j) { const int c = 4 * lane + 256 * j; f32x4 h = *(const f32x4*)(out + (size_t)row * D + c);
#pragma unroll
                for (int k = 0; k < 4; ++k) { const unsigned long long yy = *(const unsigned long long*)(Y + ((size_t)row * 4 + k) * D + c);
                    h[0] += bf2f((bf16)(yy & 0xffff)); h[1] += bf2f((bf16)((yy >> 16) & 0xffff)); h[2] += bf2f((bf16)((yy >> 32) & 0xffff)); h[3] += bf2f((bf16)(yy >> 48)); }
                v[j] = h; s += (h[0] * h[0] + h[1] * h[1]) + (h[2] * h[2] + h[3] * h[3]); }
            const float rs = rsqrtf(wave_sum(s) * (1.f / D) + EPS);
#pragma unroll
            for (int j = 0; j < 4; ++j) { const int c = 4 * lane + 256 * j; const f32x4 gg = *(const f32x4*)(norm_final + c); *(f32x4*)(out + (size_t)row * D + c) = v[j] * rs * gg; }
        }
    }
    STAMP(12);
    if (TS_LO >= 0 && blockIdx.x == 0 && threadIdx.x == 0) {
        unsigned long long* tsp = (unsigned long long*)(args.ws + WS_TS);
        const unsigned long long t0 = __hip_atomic_load(tsp + TS_LO, __ATOMIC_RELAXED, __HIP_MEMORY_SCOPE_AGENT), t1 = __hip_atomic_load(tsp + TS_HI, __ATOMIC_RELAXED, __HIP_MEMORY_SCOPE_AGENT);
        const unsigned long long until = __builtin_amdgcn_s_memrealtime() + TS_MULT * (t1 - t0);
        while (__builtin_amdgcn_s_memrealtime() < until) __builtin_amdgcn_s_sleep(8);
    }
#undef IN
#undef SEAM
}

static void launch_mk(Args a, int lo, int hi, int bli, int grid, hipStream_t stream) {
    a.ph_lo = lo; a.ph_hi = hi; a.bli = bli; a.pad = 0;
    hipLaunchKernelGGL(mk_fwd, dim3(grid), dim3(NTHR), LDS_BYTES, stream, a);
}
extern "C" void kernel_launch(void* const* d_in, const int* in_sizes, int n_in, void* d_out, int out_size, void* d_ws, size_t ws_size, hipStream_t stream) {
    if (n_in != 31 || out_size != M * D || ws_size < WS_END) { fprintf(stderr, "kernel_launch: unexpected shapes n_in %d out %d ws %zu\n", n_in, out_size, ws_size); return; }
    static int grid = 0;
    if (grid == 0) {
        int dev = 0, cus = 0;
        if (hipGetDevice(&dev) != hipSuccess || hipDeviceGetAttribute(&cus, hipDeviceAttributeMultiprocessorCount, dev) != hipSuccess) { grid = -1; return; }
        if (hipFuncSetAttribute((const void*)mk_fwd, hipFuncAttributeMaxDynamicSharedMemorySize, LDS_BYTES) != hipSuccess) { fprintf(stderr, "kernel_launch: hipFuncSetAttribute failed\n"); grid = -1; return; }
        int per_cu = 0; (void)hipOccupancyMaxActiveBlocksPerMultiprocessor(&per_cu, (const void*)mk_fwd, NTHR, LDS_BYTES); (void)hipGetLastError();
        if (per_cu < 1) fprintf(stderr, "kernel_launch: occupancy query reports %d blocks per CU\n", per_cu);
        if (cus < 256) { fprintf(stderr, "kernel_launch: needs 256 CUs, device has %d\n", cus); grid = -1; return; }
        grid = 256;
    }
    if (grid < 0) return;
    const float* const* in = (const float* const*)d_in;
    const float *dn_conv = in[4], *dn_a_log = in[5], *dn_dt_bias = in[6], *dn_norm = in[7];
    const float *rg_conv = in[8], *rg_conv_b = in[9], *rg_w_a = in[10], *rg_b_a = in[11], *rg_w_x = in[12], *rg_b_x = in[13], *rg_lambda = in[14];
    const float *norm_moe = in[21], *w_router = in[22], *b_router = in[23];
    char* ws = (char*)d_ws; float* out = (float*)d_out;
    unsigned* ctl = (unsigned*)(ws + WS_CTL); unsigned* cnt = ctl + CW_CNT; float* ss2 = (float*)(ws + CTL_SS2);
    float* BA = (float*)(ws + WS_BA); float* RSTD2 = (float*)(ws + WS_RSTD2);
    int* TOKL = (int*)(ws + WS_TOKL); float* GATEL = (float*)(ws + WS_GATEL); float* RSL = (float*)(ws + WS_RSL);
    bf16 *MIX = (bf16*)(ws + WS_XN), *PROJ = (bf16*)(ws + WS_PROJ);
    float* ODN = (float*)(ws + WS_ODN); float* QKVN = (float*)(ws + WS_QKVN);
    Args a{};
    for (int i = 0; i < 31; ++i) a.in[i] = (const float*)d_in[i];
    a.out = out; a.ws = (unsigned char*)d_ws;

    (void)hipMemsetAsync(ws + WS_CTL, 0, CTL_BYTES, stream);
    launch_mk(a, 0, 12, 0, grid, stream);
}
```

```cpp
#include <hip/hip_runtime.h>
#include <cstdio>
#include <cstdint>

typedef unsigned short bf16;
#ifndef TS_LO
#define TS_LO -1
#define TS_HI -1
#endif
#define TS_MULT 4
__device__ __forceinline__ float bf2f(bf16 v) { return __builtin_bit_cast(float, (unsigned)v << 16); }
__device__ __forceinline__ bf16 f2bf(float f) { unsigned u = __builtin_bit_cast(unsigned, f); return (bf16)((u + 0x7fffu + ((u >> 16) & 1u)) >> 16); }

constexpr int NB = 4, T = 4096, D = 1024, M = NB * T, NIN = 3080, NP = 3072, MEML = 256;
constexpr int NE = 32, TOPK = 4;
constexpr float EPS = 1e-6f;
constexpr int PC_Q = 0, PC_K = 512, PC_V = 1024, PC_Z = 1536, PC_RX = 2048, PC_RY = 2560;

constexpr size_t MiB = 1u << 20;
constexpr size_t WS_CTL = 0, CTL_BYTES = 1 * MiB;
constexpr int CW_CNT = 16384, CNT_STRIDE = 64;
constexpr size_t CTL_SS1 = 128 * 1024, CTL_SS2 = 192 * 1024;
constexpr size_t WS_BA = 1 * MiB, WS_RSTD2 = 1 * MiB + 512 * 1024, WS_DEC = 1 * MiB + 768 * 1024;
constexpr size_t WS_RGW = 2 * MiB, WS_WR = 2 * MiB + 512 * 1024, WS_MEMN = 3 * MiB, WS_KM = 5 * MiB, WS_VT = 7 * MiB;
constexpr size_t WS_RGSUM = 9 * MiB, WS_TOKL = 10 * MiB, WS_GATEL = 12 * MiB, WS_RSL = 14 * MiB;
constexpr size_t WS_WIN = 16 * MiB, WS_WOUT = 22 * MiB, WS_WCQ = 24 * MiB, WS_WCKV = 26 * MiB, WS_WCO = 30 * MiB;
constexpr size_t WS_WGU = 32 * MiB, WS_WD = 160 * MiB;
constexpr size_t WS_XN = 224 * MiB;
constexpr size_t WS_PROJ = 256 * MiB;
constexpr size_t WS_HB = 256 * MiB, WS_Q = 288 * MiB, WS_P = 320 * MiB, WS_HID = 256 * MiB;
constexpr size_t WS_DN = 352 * MiB;
constexpr size_t WS_O2 = 352 * MiB, WS_SC = 384 * MiB  ;
constexpr size_t WS_ODN = 442 * MiB, WS_HLOC = 474 * MiB, WS_CP = 490 * MiB, WS_SSP1 = 506 * MiB, WS_SSP2 = 507 * MiB, WS_CARRY = 508 * MiB, WS_TS = 508 * MiB + 768 * 1024, WS_END = 509 * MiB;
constexpr size_t WS_Y = 32 * MiB;
constexpr int DNU_BYTES = 73728, DNU_WN = 0, DNU_QG = 16384, DNU_KDT = 32768, DNU_QK = 49152, DNU_UT = 57344;
constexpr size_t WS_QKVN = 32 * MiB;

__host__ __device__ __forceinline__ int kperm(int k) { const int g = (k >> 2) & 3; return (g == 1 || g == 2) ? (k ^ 12) : k; }
__device__ __forceinline__ float wave_sum(float v) {
#pragma unroll
    for (int o = 1; o < 64; o <<= 1) v += __shfl_xor(v, o);
    return v;
}
__device__ __forceinline__ float sigmoidf_(float x) { return 1.f / (1.f + __expf(-x)); }
__device__ __forceinline__ float siluf_(float x) { return x * sigmoidf_(x); }
__device__ __forceinline__ float softplusf_(float x) { return fmaxf(x, 0.f) + log1pf(__expf(-fabsf(x))); }
__device__ __forceinline__ float gelu_tanh(float x) { const float u = 0.7978845608028654f * (x + 0.044715f * x * x * x); return 0.5f * x * (1.f + tanhf(u)); }
__device__ __forceinline__ float ffn_act(float gt, float up) { gt = fminf(gt, 7.f); up = fminf(fmaxf(up, -7.f), 7.f); return (up + 1.f) * (gt * sigmoidf_(1.702f * gt)); }

namespace pg8 {
#define PG8_LAS __attribute__((address_space(3)))
typedef unsigned short bf16_t;
typedef short bf16x8 __attribute__((ext_vector_type(8)));
typedef float f32x4 __attribute__((ext_vector_type(4)));
typedef unsigned u32x4 __attribute__((ext_vector_type(4)));
constexpr int BM = 256, BK = 64, HALF = 128, HTB = HALF * BK * 2, STAGE_BYTES = 8 * HTB, NXCD = 8, WGM = 8;

__host__ __device__ __forceinline__ int lds_byte(int r, int c) { const int st = (r >> 4) * 2 + (c >> 5), rr = r & 15, cc = c & 31, ob = rr * 64 + cc * 2; return st * 1024 + (ob ^ (((ob >> 9) & 1) << 5)); }
__host__ __device__ __forceinline__ void stage_rc(int b, int& R, int& C) { const int st = b / 1024, sb = b % 1024, swz = sb ^ (((sb >> 9) & 1) << 5); R = (st >> 1) * 16 + swz / 64; C = (st & 1) * 32 + (swz % 64) / 2; }
__host__ __device__ __forceinline__ int perm32(int rho) { const int n = rho >> 4, i = rho & 15; return 8 * (i >> 2) + 4 * n + (i & 3); }

struct Unit { int pm, pn; const char* a; const char* b; int e, j; };
struct Gemm { int lda, ldb, K; };

struct StaticOrder {
    int nM, nN, nwg, G, c, rep = 1; const char* A; const char* Bt; size_t astep, bstep;
    __device__ void init(const void* A_, const void* Bt_, int M, int N, int lda, int ldb, int G_, int c_) { nM = M / BM; nN = N / BM; nwg = nM * nN; G = G_; c = c_; A = (const char*)A_; Bt = (const char*)Bt_; astep = (size_t)BM * lda * 2; bstep = (size_t)BM * ldb * 2; }
    __device__ bool next(int i, Unit& u) const {
        long L = (long)i * G + c; if (L >= (long)nwg * rep) return false; L %= nwg;
        int wgid = (int)L; { const int q = nwg / NXCD, r = nwg % NXCD, xcd = wgid % NXCD, off = wgid / NXCD; wgid = (xcd < r ? xcd * (q + 1) : r * (q + 1) + (xcd - r) * q) + off; }
        const int nig = WGM * nN, gid = wgid / nig, fm = gid * WGM, gsz = (nM - fm) < WGM ? (nM - fm) : WGM;
        u.pm = fm + ((wgid % nig) % gsz); u.pn = (wgid % nig) / gsz; u.a = A + (size_t)u.pm * astep; u.b = Bt + (size_t)u.pn * bstep; u.e = 0; u.j = 0; return true;
    }
    __device__ __forceinline__ int arow(const Unit&, int) const { return 0; }
};
struct OneUnit {
    Unit u0;
    __device__ bool next(int i, Unit& u) const { if (i != 0) return false; u = u0; return true; }
    __device__ __forceinline__ int arow(const Unit&, int) const { return 0; }
};

__device__ __forceinline__ unsigned cvt_pk_bf16(float lo, float hi) { unsigned r; asm volatile("v_cvt_pk_bf16_f32 %0, %1, %2" : "=v"(r) : "v"(lo), "v"(hi)); return r; }

typedef f32x4 Acc[2][2][4][2];

template <class Epi, class Sched, bool ALIGN_EPI, bool GATHER>
__device__ __forceinline__ void gemm_phase(PG8_LAS unsigned char* lds, const Gemm g, const Sched& S, const Epi& E) {
    const int tid = threadIdx.x, wid = __builtin_amdgcn_readfirstlane(tid >> 6), lane = tid & 63, wr = wid >> 2, wc = wid & 3, fr = lane & 15, fq = lane >> 4;
    const int nt = g.K / BK;
    unsigned voffA[2], voffB[2]; int RA[2], CA[2];
#pragma unroll
    for (int i = 0; i < 2; ++i) { int R, C; stage_rc(tid * 16 + i * 8192, R, C); const int Rb = (R & ~31) + perm32(R & 31);
        voffA[i] = (unsigned)(R * g.lda + C) * 2u; voffB[i] = (unsigned)(Rb * g.ldb + C) * 2u; RA[i] = R; CA[i] = C; }
    const size_t kstep = (size_t)(BK * 2);
    const size_t hstepA = (size_t)HALF * g.lda * 2, hstepB = (size_t)HALF * g.ldb * 2;
    const unsigned ldsw = (unsigned)wid * 1024u;
    const int aoff = lds_byte(wr * 64 + fr, fq * 8), boff = lds_byte(wc * 32 + fr, fq * 8);
    unsigned aoC[2][2], aoN[2][2];
#define PG8_SA(b, h) (((b) * 2 + (h)) * HTB)
#define PG8_SB(b, h) ((4 + (b) * 2 + (h)) * HTB)
#define PG8_STAGE(bufoff, gbase, voff) do { _Pragma("unroll") for (int _i = 0; _i < 2; ++_i) \
        __builtin_amdgcn_global_load_lds((const unsigned*)((const char*)(gbase) + (voff)[_i]), (PG8_LAS unsigned*)(lds + (bufoff) + ldsw + _i * 8192), 16, 0, 0); } while (0)
#define PG8_STAGE_A(bufoff, gbase, h, nx) do { if constexpr (GATHER) { unsigned _v[2]; _v[0] = (nx) ? aoN[h][0] : aoC[h][0]; _v[1] = (nx) ? aoN[h][1] : aoC[h][1]; PG8_STAGE(bufoff, gbase, _v); } \
        else { PG8_STAGE(bufoff, (gbase) + (h) * hstepA, voffA); } } while (0)
#define PG8_GOFF(dst, un) do { _Pragma("unroll") for (int _h = 0; _h < 2; ++_h) _Pragma("unroll") for (int _i = 0; _i < 2; ++_i) \
        dst[_h][_i] = (unsigned)(S.arow(un, _h * HALF + RA[_i]) * g.lda + CA[_i]) * 2u; } while (0)
#define PG8_LDA(dst, b, h) do { _Pragma("unroll") for (int m = 0; m < 4; ++m) _Pragma("unroll") for (int k = 0; k < 2; ++k) dst[m][k] = *(const PG8_LAS bf16x8*)(lds + PG8_SA(b, h) + aoff + m * 2048 + k * 1024); } while (0)
#define PG8_LDB(dst, b, h) do { _Pragma("unroll") for (int n = 0; n < 2; ++n) _Pragma("unroll") for (int k = 0; k < 2; ++k) dst[n][k] = *(const PG8_LAS bf16x8*)(lds + PG8_SB(b, h) + boff + n * 2048 + k * 1024); } while (0)
#define PG8_MMA(ai, bj, At, Bt) do { __builtin_amdgcn_s_setprio(1); _Pragma("unroll") for (int m = 0; m < 4; ++m) _Pragma("unroll") for (int n = 0; n < 2; ++n) _Pragma("unroll") for (int k = 0; k < 2; ++k) \
        acc[ai][bj][m][n] = __builtin_amdgcn_mfma_f32_16x16x32_bf16(Bt[n][k], At[m][k], acc[ai][bj][m][n], 0, 0, 0); __builtin_amdgcn_s_setprio(0); } while (0)
#define PG8_WAIT_V(n) asm volatile("s_waitcnt vmcnt(" #n ")" ::: "memory")
#define PG8_WAIT_L(n) asm volatile("s_waitcnt lgkmcnt(" #n ")" ::: "memory")
#define PG8_BAR __builtin_amdgcn_s_barrier()
#define PG8_SCHED __builtin_amdgcn_sched_barrier(0)
    Unit cur, nxt; int ui = 0;
    if (!S.next(0, cur)) return;
    if constexpr (GATHER) { PG8_GOFF(aoC, cur); }
    Acc acc;
#pragma unroll
    for (int a = 0; a < 2; ++a)
#pragma unroll
        for (int b = 0; b < 2; ++b)
#pragma unroll
            for (int m = 0; m < 4; ++m)
#pragma unroll
                for (int n = 0; n < 2; ++n) acc[a][b][m][n] = (f32x4){0.f, 0.f, 0.f, 0.f};
    bf16x8 At[4][2], B0[2][2], B1[2][2];
    const char* cA = cur.a; const char* cB = cur.b;
    PG8_STAGE(PG8_SB(0, 0), cB, voffB); PG8_STAGE(PG8_SB(0, 1), cB + hstepB, voffB); PG8_STAGE_A(PG8_SA(0, 0), cA, 0, false); PG8_STAGE_A(PG8_SA(0, 1), cA, 1, false);
    if (wr == 1) PG8_BAR;
    PG8_WAIT_V(2); PG8_BAR;
    PG8_STAGE(PG8_SB(1, 0), cB + kstep, voffB); PG8_STAGE_A(PG8_SA(1, 0), cA + kstep, 0, false); PG8_STAGE(PG8_SB(1, 1), cB + hstepB + kstep, voffB);
    PG8_WAIT_V(6); PG8_BAR;
    for (;;) {
        const bool has_next = S.next(ui + 1, nxt);
        if constexpr (GATHER) { if (has_next) { PG8_GOFF(aoN, nxt); } else {
#pragma unroll
            for (int _h = 0; _h < 2; ++_h) { aoN[_h][0] = aoC[_h][0]; aoN[_h][1] = aoC[_h][1]; } } }
        const char* nA = has_next ? nxt.a : cA; const char* nB = has_next ? nxt.b : cB;
#pragma nounroll
        for (int t = 0; t < nt; t += 2) {
            const bool last = (t == nt - 2);
            const char* a1 = cA + (size_t)(t + 1) * kstep;
            const char* a2 = last ? nA : cA + (size_t)(t + 2) * kstep; const char* b2 = last ? nB : cB + (size_t)(t + 2) * kstep;
            const char* a3 = a2 + kstep; const char* b3 = b2 + kstep;
            PG8_LDB(B0, 0, 0); PG8_LDB(B1, 0, 1); PG8_SCHED; PG8_LDA(At, 0, 0); PG8_STAGE_A(PG8_SA(1, 1), a1, 1, false);
            PG8_WAIT_V(8); PG8_WAIT_L(0); PG8_BAR; PG8_MMA(0, 0, At, B0); PG8_MMA(0, 1, At, B1); PG8_BAR; PG8_SCHED;
            PG8_LDA(At, 0, 1); PG8_STAGE(PG8_SB(0, 0), b2, voffB); PG8_STAGE(PG8_SB(0, 1), b2 + hstepB, voffB); PG8_STAGE_A(PG8_SA(0, 0), a2, 0, last);
            PG8_WAIT_V(8); PG8_WAIT_L(0); PG8_BAR; PG8_MMA(1, 0, At, B0); PG8_MMA(1, 1, At, B1); PG8_BAR; PG8_SCHED;
            PG8_LDB(B0, 1, 0); PG8_LDB(B1, 1, 1); PG8_SCHED; PG8_LDA(At, 1, 0); PG8_STAGE_A(PG8_SA(0, 1), a2, 1, last);
            PG8_WAIT_V(8); PG8_WAIT_L(0); PG8_BAR; PG8_MMA(0, 0, At, B0); PG8_MMA(0, 1, At, B1); PG8_BAR; PG8_SCHED;
            PG8_LDA(At, 1, 1); PG8_STAGE(PG8_SB(1, 0), b3, voffB); PG8_STAGE(PG8_SB(1, 1), b3 + hstepB, voffB); PG8_STAGE_A(PG8_SA(1, 0), a3, 0, last);
            PG8_WAIT_V(8); PG8_WAIT_L(0); PG8_BAR; PG8_MMA(1, 0, At, B0); PG8_MMA(1, 1, At, B1); PG8_BAR; PG8_SCHED;
        }
        if constexpr (ALIGN_EPI) { if (wr == 0) PG8_BAR; }
        if constexpr (!Epi::AFTER_DRAIN) { E(acc, cur, wr, wc, fr, fq); }
        if (!has_next) break;
#pragma unroll
        for (int a = 0; a < 2; ++a)
#pragma unroll
            for (int b = 0; b < 2; ++b)
#pragma unroll
                for (int m = 0; m < 4; ++m)
#pragma unroll
                    for (int n = 0; n < 2; ++n) acc[a][b][m][n] = (f32x4){0.f, 0.f, 0.f, 0.f};
        cur = nxt; cA = nA; cB = nB; ++ui;
        if constexpr (GATHER) {
#pragma unroll
            for (int _h = 0; _h < 2; ++_h) { aoC[_h][0] = aoN[_h][0]; aoC[_h][1] = aoN[_h][1]; } }
        if constexpr (ALIGN_EPI) { if (wr == 1) PG8_BAR; }
    }
    PG8_WAIT_V(0);
    if constexpr (!ALIGN_EPI) { if (wr == 0) PG8_BAR; }
    PG8_BAR;
    if constexpr (Epi::AFTER_DRAIN) { E.fused(acc, cur, wr, wc, fr, fq, lds); }
#undef PG8_SA
#undef PG8_SB
#undef PG8_STAGE
#undef PG8_STAGE_A
#undef PG8_GOFF
#undef PG8_LDA
#undef PG8_LDB
#undef PG8_MMA
#undef PG8_WAIT_V
#undef PG8_WAIT_L
#undef PG8_BAR
#undef PG8_SCHED
}

struct EpiStore {
    static constexpr bool AFTER_DRAIN = false; bf16_t* O; int ldc;
    __device__ __forceinline__ void operator()(const Acc& acc, const Unit& u, int wr, int wc, int fr, int fq) const {
        const int row0 = u.pm * BM + wr * 64 + fr, col0 = u.pn * BM + wc * 32 + 8 * fq;
#pragma unroll
        for (int ai = 0; ai < 2; ++ai)
#pragma unroll
            for (int m = 0; m < 4; ++m) { bf16_t* rowp = O + (size_t)(row0 + ai * HALF + m * 16) * ldc + col0;
#pragma unroll
                for (int bj = 0; bj < 2; ++bj) { const f32x4 v0 = acc[ai][bj][m][0], v1 = acc[ai][bj][m][1];
                    u32x4 w; w.x = cvt_pk_bf16(v0[0], v0[1]); w.y = cvt_pk_bf16(v0[2], v0[3]); w.z = cvt_pk_bf16(v1[0], v1[1]); w.w = cvt_pk_bf16(v1[2], v1[3]);
                    *(u32x4*)(rowp + bj * HALF) = w; } }
    }
};
__device__ __forceinline__ float row_ss(const float* SS, int row) { const f32x4 a = *(const f32x4*)(SS + row * 16), b = *(const f32x4*)(SS + row * 16 + 4), c = *(const f32x4*)(SS + row * 16 + 8), d = *(const f32x4*)(SS + row * 16 + 12);
    return (((a[0] + a[1]) + (a[2] + a[3])) + ((b[0] + b[1]) + (b[2] + b[3]))) + (((c[0] + c[1]) + (c[2] + c[3])) + ((d[0] + d[1]) + (d[2] + d[3]))); }
struct EpiResid {
    static constexpr bool AFTER_DRAIN = false; const float* R; float* H; bf16_t* HB; float* SS;
    __device__ __forceinline__ void operator()(const Acc& acc, const Unit& u, int wr, int wc, int fr, int fq) const {
        const int row0 = u.pm * BM + wr * 64 + fr, col0 = u.pn * BM + wc * 32 + 8 * fq;
#pragma unroll
        for (int ai = 0; ai < 2; ++ai)
#pragma unroll
            for (int m = 0; m < 4; ++m) { const int row = row0 + ai * HALF + m * 16; const size_t off = (size_t)row * D + col0; float sq = 0.f;
#pragma unroll
                for (int bj = 0; bj < 2; ++bj) { const f32x4 r0 = *(const f32x4*)(R + off + bj * HALF), r1 = *(const f32x4*)(R + off + bj * HALF + 4);
                    const f32x4 v0 = acc[ai][bj][m][0] + r0, v1 = acc[ai][bj][m][1] + r1;
                    *(f32x4*)(H + off + bj * HALF) = v0; *(f32x4*)(H + off + bj * HALF + 4) = v1;
                    u32x4 w; w.x = cvt_pk_bf16(v0[0], v0[1]); w.y = cvt_pk_bf16(v0[2], v0[3]); w.z = cvt_pk_bf16(v1[0], v1[1]); w.w = cvt_pk_bf16(v1[2], v1[3]);
                    *(u32x4*)(HB + off + bj * HALF) = w;
                    sq += (v0[0] * v0[0] + v0[1] * v0[1]) + (v0[2] * v0[2] + v0[3] * v0[3]) + (v1[0] * v1[0] + v1[1] * v1[1]) + (v1[2] * v1[2] + v1[3] * v1[3]); }
                sq += __shfl_xor(sq, 16); sq += __shfl_xor(sq, 32);
                if (fq == 0) SS[row * 16 + u.pn * 4 + wc] = sq; }
    }
};
struct EpiRowScale {
    static constexpr bool AFTER_DRAIN = false; bf16_t* O; const float* SS; float s;
    __device__ __forceinline__ void operator()(const Acc& acc, const Unit& u, int wr, int wc, int fr, int fq) const {
        const int row0 = u.pm * BM + wr * 64 + fr, col0 = u.pn * BM + wc * 32 + 8 * fq;
#pragma unroll
        for (int ai = 0; ai < 2; ++ai)
#pragma unroll
            for (int m = 0; m < 4; ++m) { const int row = row0 + ai * HALF + m * 16; const float rs = rsqrtf(row_ss(SS, row) * (1.f / D) + EPS) * s; bf16_t* rowp = O + (size_t)row * D + col0;
#pragma unroll
                for (int bj = 0; bj < 2; ++bj) { const f32x4 v0 = acc[ai][bj][m][0] * rs, v1 = acc[ai][bj][m][1] * rs;
                    u32x4 w; w.x = cvt_pk_bf16(v0[0], v0[1]); w.y = cvt_pk_bf16(v0[2], v0[3]); w.z = cvt_pk_bf16(v1[0], v1[1]); w.w = cvt_pk_bf16(v1[2], v1[3]);
                    *(u32x4*)(rowp + bj * HALF) = w; } }
    }
};
struct EpiSoftmax {
    static constexpr bool AFTER_DRAIN = true; bf16_t* P;
    __device__ __forceinline__ void operator()(const Acc&, const Unit&, int, int, int, int) const {}
    __device__ __forceinline__ void fused(Acc& acc, const Unit& u, int wr, int wc, int fr, int fq, PG8_LAS unsigned char* lds) const {
        PG8_LAS float* xm = (PG8_LAS float*)lds; PG8_LAS float* xs = xm + 1024;
#pragma unroll
        for (int ai = 0; ai < 2; ++ai)
#pragma unroll
            for (int m = 0; m < 4; ++m) { float mx = -3.0e38f;
#pragma unroll
                for (int bj = 0; bj < 2; ++bj)
#pragma unroll
                    for (int n = 0; n < 2; ++n) { const f32x4 v = acc[ai][bj][m][n]; mx = fmaxf(mx, fmaxf(fmaxf(v[0], v[1]), fmaxf(v[2], v[3]))); }
                mx = fmaxf(mx, __shfl_xor(mx, 16)); mx = fmaxf(mx, __shfl_xor(mx, 32));
                if (fq == 0) xm[(ai * HALF + wr * 64 + m * 16 + fr) * 4 + wc] = mx; }
        __syncthreads();
#pragma unroll
        for (int ai = 0; ai < 2; ++ai)
#pragma unroll
            for (int m = 0; m < 4; ++m) { const int r = ai * HALF + wr * 64 + m * 16 + fr; const f32x4 q = *(const PG8_LAS f32x4*)(xm + r * 4);
                const float mx = fmaxf(fmaxf(q[0], q[1]), fmaxf(q[2], q[3])); float sm = 0.f;
#pragma unroll
                for (int bj = 0; bj < 2; ++bj)
#pragma unroll
                    for (int n = 0; n < 2; ++n) { f32x4 v = acc[ai][bj][m][n]; v[0] = __expf(v[0] - mx); v[1] = __expf(v[1] - mx); v[2] = __expf(v[2] - mx); v[3] = __expf(v[3] - mx);
                        acc[ai][bj][m][n] = v; sm += (v[0] + v[1]) + (v[2] + v[3]); }
                sm += __shfl_xor(sm, 16); sm += __shfl_xor(sm, 32);
                if (fq == 0) xs[r * 4 + wc] = sm; }
        __syncthreads();
        const int row0 = u.pm * BM, col0 = u.pn * BM + wc * 32 + 8 * fq;
#pragma unroll
        for (int ai = 0; ai < 2; ++ai)
#pragma unroll
            for (int m = 0; m < 4; ++m) { const int r = ai * HALF + wr * 64 + m * 16 + fr; const f32x4 q = *(const PG8_LAS f32x4*)(xs + r * 4);
                const float inv = 1.f / ((q[0] + q[1]) + (q[2] + q[3])); bf16_t* rowp = P + (size_t)(row0 + r) * D + col0;
#pragma unroll
                for (int bj = 0; bj < 2; ++bj) { const f32x4 v0 = acc[ai][bj][m][0] * inv, v1 = acc[ai][bj][m][1] * inv;
                    u32x4 w; w.x = cvt_pk_bf16(v0[0], v0[1]); w.y = cvt_pk_bf16(v0[2], v0[3]); w.z = cvt_pk_bf16(v1[0], v1[1]); w.w = cvt_pk_bf16(v1[2], v1[3]);
                    *(u32x4*)(rowp + bj * HALF) = w; } }
        __syncthreads();
    }
};
struct EpiFFN1 {
    static constexpr bool AFTER_DRAIN = false; bf16_t* HID; const float* RSL; const float* bg; const float* bu; const PG8_LAS int* cntl;
    __device__ __forceinline__ void operator()(const Acc& acc, const Unit& u, int wr, int wc, int fr, int fq) const {
        const int cnt = cntl[u.e], c0 = u.pn * HALF + wc * 32 + 8 * fq;
        const f32x4 g0 = *(const f32x4*)(bg + u.e * 1024 + c0), g1 = *(const f32x4*)(bg + u.e * 1024 + c0 + 4), u0 = *(const f32x4*)(bu + u.e * 1024 + c0), u1 = *(const f32x4*)(bu + u.e * 1024 + c0 + 4);
#pragma unroll
        for (int ai = 0; ai < 2; ++ai)
#pragma unroll
            for (int m = 0; m < 4; ++m) { const int r = ai * HALF + wr * 64 + m * 16 + fr, pos = u.j * BM + r; const float rs = pos < cnt ? RSL[u.e * M + pos] : 0.f;
                const f32x4 a0 = acc[ai][0][m][0] * rs + g0, a1 = acc[ai][0][m][1] * rs + g1, b0 = acc[ai][1][m][0] * rs + u0, b1 = acc[ai][1][m][1] * rs + u1;
                u32x4 w; w.x = cvt_pk_bf16(ffn_act(a0[0], b0[0]), ffn_act(a0[1], b0[1])); w.y = cvt_pk_bf16(ffn_act(a0[2], b0[2]), ffn_act(a0[3], b0[3]));
                w.z = cvt_pk_bf16(ffn_act(a1[0], b1[0]), ffn_act(a1[1], b1[1])); w.w = cvt_pk_bf16(ffn_act(a1[2], b1[2]), ffn_act(a1[3], b1[3]));
                *(u32x4*)(HID + (size_t)(u.pm * BM + r) * 1024 + c0) = w; }
    }
};
struct EpiFFN2 {
    static constexpr bool AFTER_DRAIN = false; bf16_t* Y; const int* TOKL; const float* GATEL; const float* bd; const PG8_LAS int* cntl;
    __device__ __forceinline__ void operator()(const Acc& acc, const Unit& u, int wr, int wc, int fr, int fq) const {
        const int cnt = cntl[u.e], c0 = u.pn * BM + wc * 32 + 8 * fq;
        f32x4 bv[2][2];
#pragma unroll
        for (int bj = 0; bj < 2; ++bj) { bv[bj][0] = *(const f32x4*)(bd + u.e * 1024 + c0 + bj * HALF); bv[bj][1] = *(const f32x4*)(bd + u.e * 1024 + c0 + bj * HALF + 4); }
#pragma unroll
        for (int ai = 0; ai < 2; ++ai)
#pragma unroll
            for (int m = 0; m < 4; ++m) { const int r = ai * HALF + wr * 64 + m * 16 + fr, pos = u.j * BM + r;
                if (pos < cnt) { const int dst = TOKL[u.e * M + pos]; const float gt = GATEL[u.e * M + pos]; bf16_t* rowp = Y + (size_t)dst * 1024 + c0;
#pragma unroll
                    for (int bj = 0; bj < 2; ++bj) { const f32x4 v0 = (acc[ai][bj][m][0] + bv[bj][0]) * gt, v1 = (acc[ai][bj][m][1] + bv[bj][1]) * gt;
                        u32x4 w; w.x = cvt_pk_bf16(v0[0], v0[1]); w.y = cvt_pk_bf16(v0[2], v0[3]); w.z = cvt_pk_bf16(v1[0], v1[1]); w.w = cvt_pk_bf16(v1[2], v1[3]);
                        *(u32x4*)(rowp + bj * HALF) = w; } } }
    }
};
template <int NPN, bool IS_FFN1> struct MoeOrder {
    int G, c; const PG8_LAS int* tstart; const PG8_LAS int* cntl; const char* A; const char* W; const int* TOKL; int rep;
    __device__ bool next(int i, Unit& u) const {
        int L = i * G + c; const int nrt = tstart[32]; if (L >= nrt * NPN * rep) return false; L %= nrt * NPN;
        const int rt = L / NPN, pn = L % NPN; int e = 0;
        for (int q = 1; q < 32; ++q) e += (tstart[q] <= rt) ? 1 : 0;
        u.pm = rt; u.pn = pn; u.e = e; u.j = rt - tstart[e];
        if (IS_FFN1) { u.a = A; u.b = W + ((size_t)e * 2048 + (size_t)pn * 256) * 2048; }
        else { u.a = A + (size_t)rt * 256 * 2048; u.b = W + ((size_t)e * 1024 + (size_t)pn * 256) * 2048; }
        return true;
    }
    __device__ __forceinline__ int arow(const Unit& u, int r) const { const int pos = u.j * BM + r; return pos < cntl[u.e] ? (TOKL[u.e * M + pos] >> 2) : 0; }
};
}

#define GAS __attribute__((address_space(1)))
#define LAS __attribute__((address_space(3)))
typedef unsigned v4u __attribute__((ext_vector_type(4)));
typedef float f32x4 __attribute__((ext_vector_type(4)));
typedef GAS unsigned gu32;
typedef __bf16 bf16x2_t __attribute__((ext_vector_type(2)));
typedef float f32x2_t __attribute__((ext_vector_type(2)));
__device__ __forceinline__ unsigned cvtpk_s(float lo, float hi) { f32x2_t v = {lo, hi}; bf16x2_t b = __builtin_convertvector(v, bf16x2_t); return __builtin_bit_cast(unsigned, b); }
typedef short bf16x8 __attribute__((ext_vector_type(8)));
typedef float f32x16 __attribute__((ext_vector_type(16)));
#ifndef NVGPR_CAP
#define NVGPR_CAP 256
#endif
constexpr int NWAVES = 8, NTHR = 512;
constexpr int RING_BYTES = 131072, LDS_BYTES = 163840, LDSCTL_OFF = LDS_BYTES - 512;
constexpr int LW_BAR = 0, LW_TSTART = 16, LW_CNT = 64, LW_NWORDS = 128;
constexpr int CW_BAR = 1024;

#define XB_TMO      128
#define XB_XCNT(j)  (256  + 64 * (j))
#define XB_XSUB(j)  (1280 + 64 * (j))
#define XB_XGEN(j)  (2304 + 64 * (j))
#define XB_TOP      3328
#define XB_TOPGEN   3392
#define XCD_BAR_WORDS 3456
#define XB_SPIN_CAP (1u << 18)
__device__ __forceinline__ unsigned xb_ld(unsigned* p)              { return __hip_atomic_load(p, __ATOMIC_RELAXED, __HIP_MEMORY_SCOPE_AGENT); }
__device__ __forceinline__ unsigned xb_add(unsigned* p, unsigned v) { return __hip_atomic_fetch_add(p, v, __ATOMIC_RELAXED, __HIP_MEMORY_SCOPE_AGENT); }
__device__ __forceinline__ unsigned xb_xcc_id() { return (unsigned)__builtin_amdgcn_s_getreg((3 << 11) | 20) & 0xFu; }
#define XB_SPIN(cond, bar) do { unsigned _sp = 0; while (cond) { __builtin_amdgcn_s_sleep(1); \
    if ((++_sp & 255u) == 0u) { if (xb_ld(&(bar)[XB_TMO])) break; if (_sp > XB_SPIN_CAP) { atomicAdd(&(bar)[XB_TMO], 1u); break; } } } } while (0)
struct XcdBarrier { unsigned* bar; unsigned x; volatile LAS unsigned* st; };
__device__ __forceinline__ XcdBarrier xcd_barrier_post(unsigned* bar, volatile LAS unsigned* st) {
    XcdBarrier b; b.bar = bar; b.x = xb_xcc_id(); b.st = st;
    if (threadIdx.x == 0) (void)xb_add(&bar[XB_XCNT(b.x)], 1u);
    return b;
}
__device__ __forceinline__ void xcd_barrier_complete(unsigned* bar, unsigned x, unsigned& nloc, unsigned& nx) {
    const unsigned G = gridDim.x * gridDim.y * gridDim.z;
    unsigned sum, cnt, mine, sp = 0u;
    for (;;) {
        sum = 0u; cnt = 0u; mine = 0u;
#pragma unroll
        for (unsigned j = 0; j < 16; ++j) { const unsigned c = xb_ld(&bar[XB_XCNT(j)]); sum += c; cnt += (c > 0u) ? 1u : 0u; mine = (j == x) ? c : mine; }
        if (sum == G) break;
        __builtin_amdgcn_s_sleep(1);
        if ((++sp & 255u) == 0u) { if (xb_ld(&bar[XB_TMO])) break; if (sp > XB_SPIN_CAP) { atomicAdd(&bar[XB_TMO], 1u); break; } }
    }
    nloc = mine > 0u ? mine : 1u; nx = cnt > 0u ? cnt : 1u;
}
__device__ __forceinline__ void xcd_barrier(const XcdBarrier& b) {
    asm volatile("s_waitcnt vmcnt(0)" ::: "memory");
    __syncthreads();
    if (threadIdx.x == 0) {
        unsigned* bar = b.bar;
        __builtin_amdgcn_s_waitcnt(0);
        unsigned nloc = b.st[0], nx = b.st[1];
        if (nloc == 0u) { xcd_barrier_complete(bar, b.x, nloc, nx); b.st[0] = nloc; b.st[1] = nx; }
        const unsigned old = xb_add(&bar[XB_XSUB(b.x)], 1u);
        const unsigned gen = old / nloc;
        if (old + 1u == (gen + 1u) * nloc) {
            __builtin_amdgcn_fence(__ATOMIC_RELEASE, "agent");
            asm volatile("s_waitcnt vmcnt(0)" ::: "memory");
            const unsigned og = xb_add(&bar[XB_TOP], 1u);
            const unsigned tg = og / nx;
            if (og + 1u == (tg + 1u) * nx) xb_add(&bar[XB_TOPGEN], 1u);
            else XB_SPIN(xb_ld(&bar[XB_TOPGEN]) == tg, bar);
            __builtin_amdgcn_fence(__ATOMIC_ACQUIRE, "agent");
            xb_add(&bar[XB_XGEN(b.x)], 1u);
            asm volatile("s_waitcnt vmcnt(0)" ::: "memory");
        } else {
            XB_SPIN(xb_ld(&bar[XB_XGEN(b.x)]) == gen, bar);
            __builtin_amdgcn_fence(__ATOMIC_ACQUIRE, "agent");
            asm volatile("s_waitcnt vmcnt(0)" ::: "memory");
        }
    }
    __syncthreads();
}

struct Args { const float* in[31]; float* out; unsigned char* ws; int ph_lo, ph_hi, bli, pad; };

#define LDS_WAIT() asm volatile("s_waitcnt lgkmcnt(0)" ::: "memory")
__device__ __forceinline__ unsigned pk2(float lo, float hi) { return (unsigned)f2bf(lo) | ((unsigned)f2bf(hi) << 16); }
__device__ __forceinline__ void transpose_item(const float* W, int ldn, int col0, int k0, bf16* dst, int pitch, const float* gain, LAS float* scr, int lane) {
#pragma unroll 8
    for (int i = 0; i < 32; ++i) { const int kk = 2 * i + (lane >> 5); float v = W[(size_t)(k0 + kk) * ldn + col0 + (lane & 31)]; if (gain) v *= gain[k0 + kk]; scr[kk * 33 + (lane & 31)] = v; }
    LDS_WAIT(); asm volatile("" ::: "memory");
    const int c = lane & 7;
#pragma unroll
    for (int j = 0; j < 4; ++j) { const int n = (lane >> 3) + 8 * j; const LAS float* s = scr + (8 * c) * 33 + n;
        v4u o; o.x = pk2(s[0 * 33], s[1 * 33]); o.y = pk2(s[2 * 33], s[3 * 33]); o.z = pk2(s[4 * 33], s[5 * 33]); o.w = pk2(s[6 * 33], s[7 * 33]);
        *(GAS v4u*)(dst + (size_t)n * pitch + k0 + 8 * c) = o; }
    LDS_WAIT(); asm volatile("" ::: "memory");
}

__device__ __forceinline__ const float* arg_in(const Args& a, int k) { asm volatile("" : "+s"(k)); return a.in[k]; }
#define INP(k) arg_in(args, k)
#define PHASE_PTRS unsigned char* wsl = args.ws; asm volatile("" : "+s"(wsl)); float* out = args.out; asm volatile("" : "+s"(out)); unsigned* ctl = (unsigned*)(wsl + WS_CTL); const float *x = INP(0), *mem = INP(1), *norm_mix = INP(2), *w_in = INP(3), *w_out = INP(15), *norm_cross = INP(16), *norm_mem = INP(17), *w_cq = INP(18), *w_ckv = INP(19), *w_co = INP(20); const float *norm_moe = INP(21), *w_router = INP(22), *w_gate = INP(24), *b_gate = INP(25), *w_up = INP(26), *b_up = INP(27), *w_down = INP(28), *b_down = INP(29), *norm_final = INP(30); float* ss1 = (float*)(wsl + WS_SSP1); float* ss2 = (float*)(wsl + WS_SSP2); bf16 *Win_t = (bf16*)(wsl + WS_WIN), *Wout_t = (bf16*)(wsl + WS_WOUT), *Wcq_t = (bf16*)(wsl + WS_WCQ), *Wckv_t = (bf16*)(wsl + WS_WCKV), *Wco_t = (bf16*)(wsl + WS_WCO), *Wgu_t = (bf16*)(wsl + WS_WGU), *Wd_t = (bf16*)(wsl + WS_WD); bf16 *XN = (bf16*)(wsl + WS_XN), *MIX = XN, *HB2 = XN, *PROJ = (bf16*)(wsl + WS_PROJ), *HB = (bf16*)(wsl + WS_HB), *Qb = (bf16*)(wsl + WS_Q), *Pb = (bf16*)(wsl + WS_P), *HID = (bf16*)(wsl + WS_HID); bf16 *O2 = (bf16*)(wsl + WS_O2), *Y = (bf16*)(wsl + WS_Y), *MEMN = (bf16*)(wsl + WS_MEMN), *KM = (bf16*)(wsl + WS_KM), *VT = (bf16*)(wsl + WS_VT); const float *dn_conv = INP(4), *dn_a_log = INP(5), *dn_dt_bias = INP(6), *dn_norm = INP(7), *rg_conv = INP(8), *rg_conv_b = INP(9); const float *rg_w_a = INP(10), *rg_b_a = INP(11), *rg_w_x = INP(12), *rg_b_x = INP(13), *rg_lambda = INP(14), *b_router = INP(23); float* QKVN = (float*)(wsl + WS_QKVN); float* ODN = (float*)(wsl + WS_ODN); float* BAf = (float*)(wsl + WS_BA); float* AA = out; float* BX = out + (size_t)M * 512; const int* TOKL = (const int*)(wsl + WS_TOKL); const float* GATEL = (const float*)(wsl + WS_GATEL); const float* RSL = (const float*)(wsl + WS_RSL); (void)ctl;
template <bool NT = false> __device__ __forceinline__ void transpose_item64(const float* W, int ldn, int col0, int k0, bf16* dst, int pitch, const float* gain, LAS float* scr, int lane) {
    f32x4 v[16];
#pragma unroll
    for (int i = 0; i < 16; ++i) { const int kk = (lane >> 4) + 4 * i; const f32x4* p = (const f32x4*)(W + (size_t)(k0 + kk) * ldn + col0 + 4 * (lane & 15)); v[i] = NT ? __builtin_nontemporal_load(p) : *p; }
#pragma unroll
    for (int i = 0; i < 16; ++i) { const int kk = (lane >> 4) + 4 * i; f32x4 w = v[i]; if (gain) w = w * gain[k0 + kk]; LAS float* p = scr + kk * 65 + 4 * (lane & 15); p[0] = w[0]; p[1] = w[1]; p[2] = w[2]; p[3] = w[3]; }
    LDS_WAIT(); asm volatile("" ::: "memory");
    const int c = lane & 7;
#pragma unroll
    for (int j = 0; j < 8; ++j) { const int n = (lane >> 3) + 8 * j; const LAS float* sp = scr + (8 * c) * 65 + n;
        v4u o; o.x = pk2(sp[0 * 65], sp[1 * 65]); o.y = pk2(sp[2 * 65], sp[3 * 65]); o.z = pk2(sp[4 * 65], sp[5 * 65]); o.w = pk2(sp[6 * 65], sp[7 * 65]);
        GAS v4u* q = (GAS v4u*)(dst + (size_t)n * pitch + k0 + 8 * c); if (NT) __builtin_nontemporal_store(o, q); else *q = o; }
    LDS_WAIT(); asm volatile("" ::: "memory");
}
__global__ void __launch_bounds__(NTHR, 2) mk_fwd(Args args) {
    extern __shared__ __attribute__((aligned(16))) unsigned char lds_raw[];
    LAS unsigned char* lds = (LAS unsigned char*)lds_raw;
    volatile LAS unsigned* LW = (volatile LAS unsigned*)(lds + LDSCTL_OFF);
    const int tid = threadIdx.x, lane = tid & 63, wave = __builtin_amdgcn_readfirstlane(tid >> 6), G = gridDim.x, bx = blockIdx.x;
    for (int u = tid; u < LW_NWORDS; u += NTHR) LW[u] = 0u;
    __syncthreads();
    XcdBarrier bar = xcd_barrier_post((unsigned*)(args.ws + WS_CTL) + CW_BAR + args.bli * XCD_BAR_WORDS, LW + LW_BAR);
    const int lo = args.ph_lo, hi = args.ph_hi;
#define STAMP(k) do { if (TS_LO >= 0 && blockIdx.x == 0 && threadIdx.x == 0) { unsigned char* w_ = args.ws; asm volatile("" : "+s"(w_)); __hip_atomic_store((unsigned long long*)(w_ + WS_TS) + (k), __builtin_amdgcn_s_memrealtime(), __ATOMIC_RELAXED, __HIP_MEMORY_SCOPE_AGENT); } } while (0)
    STAMP(0);
#ifndef DOUBLE_PHASE
#define DOUBLE_PHASE -1
#endif
#define REPS(k) ((DOUBLE_PHASE == (k)) ? 2 : 1)
#ifndef SKIPMASK
#define SKIPMASK 0
#endif
#define IN(k) (!((SKIPMASK >> (k)) & 1) && lo <= (k) && (k) < hi)
#define SEAM(k) do { if (IN(k) && IN((k) + 1)) xcd_barrier(bar); } while (0)
    const int gw = bx * NWAVES + wave, NGW = G * NWAVES;

    if (IN(0)) {
        PHASE_PTRS
        LAS float* scr = (LAS float*)(lds + wave * 16640);
        constexpr int I_IN = 16 * 48, I_SQ = 16 * 16, I_KV = 16 * 32;
        constexpr int NIT = I_IN + 3 * I_SQ + I_KV + 16;
        for (int it_ = gw; it_ < NIT * REPS(0); it_ += NGW) { const int it = it_ % NIT;
            int r = it;
            if (r < I_IN) { const int kb = r / 48, nb = r % 48, n0 = nb * 64; transpose_item64(w_in, NIN, n0 < 2048 ? n0 : n0 + 8, kb * 64, Win_t + (size_t)n0 * D, D, nullptr, scr, lane); continue; } r -= I_IN;
            if (r < I_SQ) { const int kb = r / 16, nb = r % 16; transpose_item64(w_out, D, nb * 64, kb * 64, Wout_t + (size_t)nb * 64 * D, D, nullptr, scr, lane); continue; } r -= I_SQ;
            if (r < I_SQ) { const int kb = r / 16, nb = r % 16; transpose_item64(w_cq, D, nb * 64, kb * 64, Wcq_t + (size_t)nb * 64 * D, D, norm_cross, scr, lane); continue; } r -= I_SQ;
            if (r < I_SQ) { const int kb = r / 16, nb = r % 16; transpose_item64(w_co, D, nb * 64, kb * 64, Wco_t + (size_t)nb * 64 * D, D, nullptr, scr, lane); continue; } r -= I_SQ;
            if (r < I_KV) { const int kb = r / 32, nb = r % 32; transpose_item64(w_ckv, 2048, nb * 64, kb * 64, Wckv_t + (size_t)nb * 64 * D, D, nullptr, scr, lane); continue; } r -= I_KV;
            { const int mat = r >> 1, kb = r & 1, gate = mat >> 2, nbk = mat & 3;
              transpose_item64((gate ? rg_w_x : rg_w_a) + (size_t)nbk * 128 * 128, 128, 0, kb * 64, (bf16*)(wsl + WS_RGW) + (size_t)mat * 128 * 128, 128, nullptr, scr, lane);
              transpose_item64((gate ? rg_w_x : rg_w_a) + (size_t)nbk * 128 * 128, 128, 64, kb * 64, (bf16*)(wsl + WS_RGW) + ((size_t)mat * 128 + 64) * 128, 128, nullptr, scr, lane); }
        }
        { bf16* WRh = (bf16*)(wsl + WS_WR); bf16* WRl = WRh + NE * D;
          for (int i = bx * NTHR + tid; i < NE * D; i += G * NTHR) { const int e = i >> 10, k = i & 1023; const float v = w_router[k * NE + e] * norm_moe[k]; const bf16 hv = f2bf(v); WRh[i] = hv; WRl[i] = f2bf(v - bf2f(hv)); } }
        __syncthreads();
        LAS float* w8 = (LAS float*)lds;
        for (int i = tid; i < D * 8; i += NTHR) w8[i] = w_in[(size_t)(i >> 3) * NIN + 2048 + (i & 7)];
        __syncthreads();
        float* BA = (float*)(wsl + WS_BA);
        for (int row_ = gw; row_ < (M + NB * MEML) * REPS(0); row_ += NGW) { const int row = row_ % (M + NB * MEML);
            const bool ismem = row >= M; const float* xr = ismem ? mem + (size_t)(row - M) * D : x + (size_t)row * D; const float* gn = ismem ? norm_mem : norm_mix;
            bf16* orow = ismem ? MEMN + (size_t)(row - M) * D : XN + (size_t)row * D;
            f32x4 v[4]; float s = 0.f;
#pragma unroll
            for (int j = 0; j < 4; ++j) { v[j] = *(const f32x4*)(xr + 4 * lane + 256 * j); s += (v[j][0] * v[j][0] + v[j][1] * v[j][1]) + (v[j][2] * v[j][2] + v[j][3] * v[j][3]); }
            const float rstd = rsqrtf(wave_sum(s) * (1.f / D) + EPS);
            float acc[8];
#pragma unroll
            for (int q = 0; q < 8; ++q) acc[q] = 0.f;
#pragma unroll
            for (int j = 0; j < 4; ++j) { const f32x4 gg = *(const f32x4*)(gn + 4 * lane + 256 * j); const f32x4 u = v[j] * rstd * gg;
                *(unsigned long long*)(orow + 4 * lane + 256 * j) = (unsigned long long)pk2(u[0], u[1]) | ((unsigned long long)pk2(u[2], u[3]) << 32);
                if (!ismem) {
#pragma unroll
                    for (int i = 0; i < 4; ++i) { const int k = 4 * lane + 256 * j + i; const f32x4 wa = *(const LAS f32x4*)(w8 + k * 8), wb = *(const LAS f32x4*)(w8 + k * 8 + 4);
                        acc[0] += u[i] * wa[0]; acc[1] += u[i] * wa[1]; acc[2] += u[i] * wa[2]; acc[3] += u[i] * wa[3]; acc[4] += u[i] * wb[0]; acc[5] += u[i] * wb[1]; acc[6] += u[i] * wb[2]; acc[7] += u[i] * wb[3]; } } }
            if (!ismem) {
#pragma unroll
                for (int q = 0; q < 8; ++q) { const float t = wave_sum(acc[q]); if (lane == q) BA[(size_t)row * 8 + q] = t; } }
        }
        __syncthreads();
    }
    SEAM(0);
    STAMP(1);
    if (IN(1)) {
        PHASE_PTRS
        { pg8::Gemm g{D, D, D}; pg8::StaticOrder S; S.init(XN, Win_t, M, NP, D, D, G, bx); S.rep = REPS(1); pg8::EpiStore E{PROJ, NP};
          pg8::gemm_phase<pg8::EpiStore, pg8::StaticOrder, true, false>(lds, g, S, E); }
    }
    SEAM(1);
    STAMP(2);
    if (IN(2)) {
        PHASE_PTRS
        for (int unit_ = bx; unit_ < NB * 64 * REPS(2); unit_ += G) { const int unit = unit_ & 255;
            const int b = unit >> 6, n = unit & 63; const size_t row0 = (size_t)b * T + n * 64;
            for (int itp = 0; itp < 2; ++itp) {
                const int half = __builtin_amdgcn_readfirstlane(tid >> 8), ht = tid & 255, hw = wave & 3, h = itp * 2 + half;
                LAS unsigned char* HL = lds + half * 53248;
                LAS bf16* QN = (LAS bf16*)HL; LAS bf16* KN = (LAS bf16*)(HL + 17408); LAS float* AL = (LAS float*)(HL + 34816); LAS float* GC = (LAS float*)(HL + 52224); LAS float* BT = GC + 64;
                unsigned char* ub = wsl + WS_DN + (size_t)((b * 4 + h) * 64 + n) * DNU_BYTES;
                if (hw == 0) { int lanev = lane; asm volatile("" : "+v"(lanev)); const size_t row = row0 + lanev; const float beta = sigmoidf_(BAf[row * 8 + h]); float gv = -__expf(dn_a_log[h]) * softplusf_(BAf[row * 8 + 4 + h] + dn_dt_bias[h]);
#pragma unroll
                    for (int o = 1; o < 64; o <<= 1) { const float tv = __shfl_up(gv, o); if (lanev >= o) gv += tv; }
                    GC[lanev] = gv; BT[lanev] = beta; }
                { const int gch = ht & 15;
#pragma unroll
                  for (int tensor = 0; tensor < 2; ++tensor) { const int cb = tensor * 512 + h * 128 + gch * 8; float wv[4][8];
#pragma unroll
                    for (int j = 0; j < 4; ++j) { const f32x4 w0 = *(const f32x4*)(dn_conv + j * 1536 + cb), w1 = *(const f32x4*)(dn_conv + j * 1536 + cb + 4);
                        wv[j][0] = w0[0]; wv[j][1] = w0[1]; wv[j][2] = w0[2]; wv[j][3] = w0[3]; wv[j][4] = w1[0]; wv[j][5] = w1[1]; wv[j][6] = w1[2]; wv[j][7] = w1[3]; }
#pragma unroll
                    for (int ii = 0; ii < 4; ++ii) { const int c = (ht >> 4) + 16 * ii, t = n * 64 + c; float a8[8];
#pragma unroll
                        for (int e = 0; e < 8; ++e) a8[e] = 0.f;
#pragma unroll
                        for (int j = 0; j < 4; ++j) { if (t + j - 3 >= 0) { const v4u pr = *(const v4u*)(PROJ + (row0 + c + j - 3) * NP + cb);
#pragma unroll
                                for (int e = 0; e < 4; ++e) { a8[2 * e] += wv[j][2 * e] * bf2f((bf16)(pr[e] & 0xffff)); a8[2 * e + 1] += wv[j][2 * e + 1] * bf2f((bf16)(pr[e] >> 16)); } } }
                        float ssq = 0.f;
#pragma unroll
                        for (int e = 0; e < 8; ++e) { a8[e] = siluf_(a8[e]); ssq += a8[e] * a8[e]; }
                        ssq += __shfl_xor(ssq, 1); ssq += __shfl_xor(ssq, 2); ssq += __shfl_xor(ssq, 4); ssq += __shfl_xor(ssq, 8);
                        const float rn = rsqrtf(ssq + EPS); v4u o; o.x = pk2(a8[0] * rn, a8[1] * rn); o.y = pk2(a8[2] * rn, a8[3] * rn); o.z = pk2(a8[4] * rn, a8[5] * rn); o.w = pk2(a8[6] * rn, a8[7] * rn);
                        *(LAS v4u*)((tensor ? KN : QN) + c * 136 + gch * 8) = o; } } }
                __syncthreads();
                if (hw < 3) { const int ci = hw == 0 ? 0 : 1, si = hw == 2 ? 1 : 0; int l31 = lane & 31, hh = lane >> 5; asm volatile("" : "+v"(l31), "+v"(hh)); f32x16 kk, qk;
#pragma unroll
                    for (int r = 0; r < 16; ++r) { kk[r] = 0.f; qk[r] = 0.f; }
#pragma unroll
                    for (int ks = 0; ks < 8; ++ks) { const bf16x8 ak = *(const LAS bf16x8*)(KN + (32 * ci + l31) * 136 + 16 * ks + 8 * hh), aq = *(const LAS bf16x8*)(QN + (32 * ci + l31) * 136 + 16 * ks + 8 * hh);
                        const bf16x8 bk = *(const LAS bf16x8*)(KN + (32 * si + l31) * 136 + 16 * ks + 8 * hh);
                        kk = __builtin_amdgcn_mfma_f32_32x32x16_bf16(ak, bk, kk, 0, 0, 0); qk = __builtin_amdgcn_mfma_f32_32x32x16_bf16(aq, bk, qk, 0, 0, 0); }
                    const int sc = 32 * si + l31; const float gs = GC[sc]; bf16* QKg = (bf16*)(ub + DNU_QK);
#pragma unroll
                    for (int r = 0; r < 16; ++r) { const int c = 32 * ci + (r & 3) + 8 * (r >> 2) + 4 * hh; const float dec = c >= sc ? __expf(GC[c] - gs) : 0.f;
                        AL[c * 68 + sc] = c > sc ? BT[c] * kk[r] * dec : 0.f; QKg[c * 64 + kperm(sc)] = f2bf(qk[r] * 0.08838834764831845f * dec); } }
                __syncthreads();
                { float xs[64];
                  if (ht < 128) { const int cv = PC_V + h * 128 + ht; const float w0 = dn_conv[cv], w1 = dn_conv[1536 + cv], w2 = dn_conv[2 * 1536 + cv], w3 = dn_conv[3 * 1536 + cv];
                      float p3 = 0.f, p2 = 0.f, p1 = 0.f; if (n > 0) { p3 = bf2f(PROJ[(row0 - 3) * NP + cv]); p2 = bf2f(PROJ[(row0 - 2) * NP + cv]); p1 = bf2f(PROJ[(row0 - 1) * NP + cv]); }
                      const bf16* pp = PROJ + row0 * NP + cv;
#pragma unroll
                      for (int c = 0; c < 64; ++c) { const float cu = bf2f(*pp); pp += NP; asm volatile("" : "+v"(pp)); xs[c] = siluf_(w0 * p3 + w1 * p2 + w2 * p1 + w3 * cu) * BT[c]; p3 = p2; p2 = p1; p1 = cu; } }
                  else { const int dk = ht - 128;
#pragma unroll
                      for (int c = 0; c < 64; ++c) xs[c] = bf2f(KN[c * 136 + dk]) * BT[c] * __expf(GC[c]); }
#pragma unroll
                  for (int i = 1; i < 64; ++i) { float acc = xs[i];
#pragma unroll
                      for (int j = 0; j < i; ++j) acc -= AL[i * 68 + j] * xs[j];
                      xs[i] = acc; }
                  if (ht < 128) { bf16* UT = (bf16*)(ub + DNU_UT) + ht * 64;
#pragma unroll
                      for (int c8 = 0; c8 < 8; ++c8) { v4u o; o.x = pk2(xs[8 * c8], xs[8 * c8 + 1]); o.y = pk2(xs[8 * c8 + 2], xs[8 * c8 + 3]); o.z = pk2(xs[8 * c8 + 4], xs[8 * c8 + 5]); o.w = pk2(xs[8 * c8 + 6], xs[8 * c8 + 7]); *(v4u*)(UT + 8 * c8) = o; } }
                  else { bf16* Wn = (bf16*)(ub + DNU_WN) + kperm(ht - 128);
#pragma unroll
                      for (int c = 0; c < 64; ++c) { *Wn = f2bf(-xs[c]); Wn += 128; asm volatile("" : "+v"(Wn)); } } }
                { const int c = ht >> 2, d0 = (ht & 3) * 32; const float sc = 0.08838834764831845f * __expf(GC[c]); bf16* Qg = (bf16*)(ub + DNU_QG);
#pragma unroll
                  for (int q = 0; q < 4; ++q) { v4u o;
#pragma unroll
                      for (int e = 0; e < 4; ++e) { const int p0 = d0 + 8 * q + 2 * e; o[e] = pk2(bf2f(QN[c * 136 + kperm(p0)]) * sc, bf2f(QN[c * 136 + kperm(p0 + 1)]) * sc); }
                      *(v4u*)(Qg + c * 128 + d0 + 8 * q) = o; }
                  const int dk = ht >> 1, c0 = (ht & 1) * 32; const float gl = GC[63]; bf16* KdT = (bf16*)(ub + DNU_KDT);
#pragma unroll
                  for (int q = 0; q < 4; ++q) { v4u o;
#pragma unroll
                      for (int e = 0; e < 4; ++e) { const int ca = kperm(c0 + 8 * q + 2 * e), cb2 = kperm(c0 + 8 * q + 2 * e + 1); o[e] = pk2(bf2f(KN[ca * 136 + dk]) * __expf(gl - GC[ca]), bf2f(KN[cb2 * 136 + dk]) * __expf(gl - GC[cb2])); }
                      *(v4u*)(KdT + dk * 64 + c0 + 8 * q) = o; }
                  if (ht == 0) ((float*)(wsl + WS_DEC))[(b * 4 + h) * 64 + n] = __expf(gl); }
                __syncthreads();
            }
            { LAS bf16* XRb = (LAS bf16*)lds; LAS unsigned* RI = (LAS unsigned*)(lds + 17408); const bf16* RGW = (const bf16*)(wsl + WS_RGW);
              for (int nbk = 0; nbk < 4; ++nbk) {
#pragma unroll
                for (int ii = 0; ii < 2; ++ii) { const int gch = tid & 15, c = (tid >> 4) + 32 * ii, t = n * 64 + c, cb = nbk * 128 + gch * 8; float a8[8];
                    { const f32x4 b0 = *(const f32x4*)(rg_conv_b + cb), b1 = *(const f32x4*)(rg_conv_b + cb + 4); a8[0] = b0[0]; a8[1] = b0[1]; a8[2] = b0[2]; a8[3] = b0[3]; a8[4] = b1[0]; a8[5] = b1[1]; a8[6] = b1[2]; a8[7] = b1[3]; }
#pragma unroll
                    for (int j = 0; j < 4; ++j) { if (t + j - 3 >= 0) { const v4u pr = *(const v4u*)(PROJ + (row0 + c + j - 3) * NP + PC_RX + cb); const f32x4 w0 = *(const f32x4*)(rg_conv + j * 512 + cb), w1 = *(const f32x4*)(rg_conv + j * 512 + cb + 4);
                            a8[0] += w0[0] * bf2f((bf16)(pr[0] & 0xffff)); a8[1] += w0[1] * bf2f((bf16)(pr[0] >> 16)); a8[2] += w0[2] * bf2f((bf16)(pr[1] & 0xffff)); a8[3] += w0[3] * bf2f((bf16)(pr[1] >> 16));
                            a8[4] += w1[0] * bf2f((bf16)(pr[2] & 0xffff)); a8[5] += w1[1] * bf2f((bf16)(pr[2] >> 16)); a8[6] += w1[2] * bf2f((bf16)(pr[3] & 0xffff)); a8[7] += w1[3] * bf2f((bf16)(pr[3] >> 16)); } }
                    v4u o; o.x = pk2(a8[0], a8[1]); o.y = pk2(a8[2], a8[3]); o.z = pk2(a8[4], a8[5]); o.w = pk2(a8[6], a8[7]); *(LAS v4u*)(XRb + c * 136 + gch * 8) = o; }
                __syncthreads();
                { const int gate = wave >> 2, ot = wave & 3, l31 = lane & 31, hh = lane >> 5, outc = 32 * ot + l31, ch = nbk * 128 + outc; f32x16 ac[2];
#pragma unroll
                  for (int r = 0; r < 16; ++r) { ac[0][r] = 0.f; ac[1][r] = 0.f; }
                  const bf16* wrow = RGW + ((size_t)(gate * 4 + nbk) * 128 + outc) * 128 + 8 * hh;
#pragma unroll
                  for (int ks = 0; ks < 8; ++ks) { const bf16x8 bw = *(const bf16x8*)(wrow + 16 * ks);
#pragma unroll
                      for (int mt = 0; mt < 2; ++mt) ac[mt] = __builtin_amdgcn_mfma_f32_32x32x16_bf16(*(const LAS bf16x8*)(XRb + (32 * mt + l31) * 136 + 16 * ks + 8 * hh), bw, ac[mt], 0, 0, 0); }
                  const float bias = gate ? rg_b_x[ch] : rg_b_a[ch]; LAS bf16* RIh = (LAS bf16*)RI;
#pragma unroll
                  for (int mt = 0; mt < 2; ++mt)
#pragma unroll
                      for (int r = 0; r < 16; ++r) { const int c = 32 * mt + (r & 3) + 8 * (r >> 2) + 4 * hh; float v = sigmoidf_(ac[mt][r] + bias); if (gate) v *= bf2f(XRb[c * 136 + outc]);
                          RIh[(c * 516 + ch) * 2 + gate] = f2bf(v); } }
                __syncthreads();
              }
              { const int ch = tid; const float lsl = -softplusf_(-rg_lambda[ch]); float hs = 0.f, cp = 1.f; bf16* HL = (bf16*)(wsl + WS_HLOC) + row0 * 512 + ch; bf16* CPg = (bf16*)(wsl + WS_CP) + row0 * 512 + ch;
#pragma unroll 4
                for (int c = 0; c < 64; ++c) { const unsigned w = RI[c * 516 + ch]; const float r = bf2f((bf16)(w & 0xffff)), ix = bf2f((bf16)(w >> 16)), a = __expf(8.f * r * lsl);
                    const float mult = (n == 0 && c == 0) ? 1.f : sqrtf(fmaxf(1.f - a * a, 0.f)); hs = a * hs + mult * ix; cp *= a; *HL = f2bf(hs); *CPg = f2bf(cp); HL += 512; CPg += 512; asm volatile("" : "+v"(HL), "+v"(CPg)); }
                float* SUM = (float*)(wsl + WS_RGSUM); SUM[(size_t)(b * 64 + n) * 512 + ch] = cp; SUM[(size_t)(256 + b * 64 + n) * 512 + ch] = hs; }
              __syncthreads();
            }
        }
    }
    SEAM(2);
    STAMP(3);
    if (IN(3)) {
        PHASE_PTRS
        if (bx < 16) {
            const int b = bx >> 2, h = bx & 3, l31 = lane & 31, hh = lane >> 5, sl = wave;
            const unsigned char* ubase = wsl + WS_DN + (size_t)((b * 4 + h) * 64) * DNU_BYTES; const float* DECp = (const float*)(wsl + WS_DEC) + (b * 4 + h) * 64;
            unsigned a256[8], a128[4];
#pragma unroll
            for (int ks = 0; ks < 8; ++ks) a256[ks] = (unsigned)(l31 * 256 + 16 * ((2 * ks + hh) ^ (l31 & 15)));
#pragma unroll
            for (int ks = 0; ks < 4; ++ks) a128[ks] = (unsigned)(l31 * 128 + 16 * ((2 * ks + hh) ^ ((l31 >> 1) & 7)));
            const unsigned t7 = (unsigned)((l31 >> 1) & 7), utrow = (unsigned)((32 * (sl & 3) + l31) * 128 + 8 * hh);
            const int lw = wave & 3;
            v4u R0[18], R1[18];
#define DN_LD(R, nn) do { const unsigned char* _g = ubase + (size_t)(nn) * DNU_BYTES + lw * 1024 + lane * 16; _Pragma("unroll") for (int _i = 0; _i < 18; ++_i) { \
                asm volatile("global_load_dwordx4 %0, %1, off" : "=v"(R[_i]) : "v"(_g) : "memory"); _g += 4096; asm volatile("" : "+v"(_g)); } } while (0)
#define DN_LWAIT(R, cnt) asm volatile("s_waitcnt vmcnt(" #cnt ")" : "+v"(R[0]), "+v"(R[1]), "+v"(R[2]), "+v"(R[3]), "+v"(R[4]), "+v"(R[5]), "+v"(R[6]), "+v"(R[7]), "+v"(R[8]), "+v"(R[9]), \
                "+v"(R[10]), "+v"(R[11]), "+v"(R[12]), "+v"(R[13]), "+v"(R[14]), "+v"(R[15]), "+v"(R[16]), "+v"(R[17]) :: "memory")
#define DN_WR(R, buf) do { int _lv = lane; asm volatile("" : "+v"(_lv)); _Pragma("unroll") for (int _i = 0; _i < 18; ++_i) { const int _p = lw + 4 * _i, _q = _p * 64 + _lv; int _slot; \
                if (_i < 8) { const int _r = _q >> 4; _slot = _r * 16 + ((_q & 15) ^ (_r & 15)); } else { const int _r = _q >> 3; _slot = _r * 8 + ((_q & 7) ^ ((_r >> 1) & 7)); } \
                *(LAS v4u*)(lds + (buf) * DNU_BYTES + _slot * 16) = R[_i]; } } while (0)
            f32x16 S[4];
#pragma unroll
            for (int t = 0; t < 4; ++t)
#pragma unroll
                for (int r = 0; r < 16; ++r) S[t][r] = 0.f;
            const float decv = DECp[lane];
#define DN_FADDR(i) ((i) < 16 ? (L + DNU_WN + ((i) & 1) * 8192 + a256[(i) >> 1]) : (i) < 32 ? (L + DNU_QG + (((i) - 16) & 1) * 8192 + a256[((i) - 16) >> 1]) : \
                     (i) < 48 ? (L + DNU_KDT + (((i) - 32) >> 2) * 4096 + a128[((i) - 32) & 3]) : ((i) < 50 ? (L + DNU_QK + a128[(i) - 48]) : (L + DNU_QK + 4096 + a128[(i) - 50])))
#define DN_COMPUTE(n) do { constexpr int FD = 6; \
                    const LAS unsigned char* L = lds + ((n) & 1) * DNU_BYTES; const float dcy = __builtin_bit_cast(float, __builtin_amdgcn_readlane(__builtin_bit_cast(int, decv), (n))); const size_t row0 = (size_t)b * T + (n) * 64; \
                    bf16x8 fr[8]; \
                    _Pragma("unroll") for (int i = 0; i < FD; ++i) fr[i] = *(const LAS bf16x8*)DN_FADDR(i); \
                    bf16x8 Sb[8]; \
                    _Pragma("unroll") for (int t = 0; t < 4; ++t) _Pragma("unroll") for (int s2 = 0; s2 < 2; ++s2) { v4u w; w.x = cvtpk_s(S[t][8 * s2], S[t][8 * s2 + 1]); w.y = cvtpk_s(S[t][8 * s2 + 2], S[t][8 * s2 + 3]); \
                            w.z = cvtpk_s(S[t][8 * s2 + 4], S[t][8 * s2 + 5]); w.w = cvtpk_s(S[t][8 * s2 + 6], S[t][8 * s2 + 7]); Sb[2 * t + s2] = __builtin_bit_cast(bf16x8, w); } \
                    f32x16 VN[2], O[2]; \
                    _Pragma("unroll") for (int mt = 0; mt < 2; ++mt) _Pragma("unroll") for (int g4 = 0; g4 < 4; ++g4) { const unsigned long long uu = *(const LAS unsigned long long*)(L + DNU_UT + utrow + 16 * ((unsigned)(4 * mt + g4) ^ t7)); \
                            VN[mt][4 * g4] = bf2f((bf16)(uu & 0xffff)); VN[mt][4 * g4 + 1] = bf2f((bf16)((uu >> 16) & 0xffff)); VN[mt][4 * g4 + 2] = bf2f((bf16)((uu >> 32) & 0xffff)); VN[mt][4 * g4 + 3] = bf2f((bf16)(uu >> 48)); } \
                    _Pragma("unroll") for (int r = 0; r < 16; ++r) { O[0][r] = 0.f; O[1][r] = 0.f; } \
                    bf16x8 vb[4]; \
                    __builtin_amdgcn_sched_group_barrier(0x100, FD, 0); \
                    _Pragma("clang loop unroll(full)") for (int i = 0; i < 54; ++i) { \
                        const bf16x8 fa = fr[i & 7]; \
                        if (i + FD < 54) fr[(i + FD) & 7] = *(const LAS bf16x8*)DN_FADDR(i + FD); \
                        if (i < 16) VN[i & 1] = __builtin_amdgcn_mfma_f32_32x32x16_bf16(fa, Sb[i >> 1], VN[i & 1], 0, 0, 0); \
                        else if (i < 32) O[(i - 16) & 1] = __builtin_amdgcn_mfma_f32_32x32x16_bf16(fa, Sb[(i - 16) >> 1], O[(i - 16) & 1], 0, 0, 0); \
                        else if (i < 48) S[(i - 32) >> 2] = __builtin_amdgcn_mfma_f32_32x32x16_bf16(fa, vb[(i - 32) & 3], S[(i - 32) >> 2], 0, 0, 0); \
                        else if (i < 50) O[0] = __builtin_amdgcn_mfma_f32_32x32x16_bf16(fa, vb[i - 48], O[0], 0, 0, 0); \
                        else O[1] = __builtin_amdgcn_mfma_f32_32x32x16_bf16(fa, vb[i - 50], O[1], 0, 0, 0); \
                        __builtin_amdgcn_sched_group_barrier(0x008, 1, 0); if (i + FD < 54) __builtin_amdgcn_sched_group_barrier(0x100, 1, 0); \
                        if (i == 23) { \
                            _Pragma("unroll") for (int mt = 0; mt < 2; ++mt) _Pragma("unroll") for (int s2 = 0; s2 < 2; ++s2) { v4u w; w.x = cvtpk_s(VN[mt][8 * s2], VN[mt][8 * s2 + 1]); w.y = cvtpk_s(VN[mt][8 * s2 + 2], VN[mt][8 * s2 + 3]); \
                                    w.z = cvtpk_s(VN[mt][8 * s2 + 4], VN[mt][8 * s2 + 5]); w.w = cvtpk_s(VN[mt][8 * s2 + 6], VN[mt][8 * s2 + 7]); vb[2 * mt + s2] = __builtin_bit_cast(bf16x8, w); } \
                            _Pragma("unroll") for (int t = 0; t < 4; ++t) S[t] = S[t] * dcy; } } \
                    _Pragma("unroll") for (int mt = 0; mt < 2; ++mt) { GAS float* op = (GAS float*)ODN + (row0 + 32 * mt + 4 * hh) * 512 + h * 128 + 32 * sl + l31; \
                        _Pragma("unroll") for (int r = 0; r < 16; ++r) op[(size_t)((r & 3) + 8 * (r >> 2)) * 512] = O[mt][r]; } \
                } while (0)
#define DN_BAR() do { asm volatile("s_waitcnt lgkmcnt(0)" ::: "memory"); __builtin_amdgcn_s_barrier(); asm volatile("" ::: "memory"); } while (0)
            if (wave >= 4) {
#define DN_LSTEP(n, RL, RW) do { if ((n) + 2 < 64) DN_LD(RL, (n) + 2); \
                    if ((n) + 1 < 64) { if ((n) + 2 < 64) DN_LWAIT(RW, 18); else DN_LWAIT(RW, 0); DN_WR(RW, ((n) + 1) & 1); } \
                    DN_BAR(); } while (0)
                DN_LD(R0, 0); DN_LD(R1, 1); DN_LWAIT(R0, 18); DN_WR(R0, 0);
                DN_BAR();
#pragma clang loop unroll(full)
                for (int n2 = 0; n2 < 64; n2 += 2) { DN_LSTEP(n2, R0, R1); DN_LSTEP(n2 + 1, R1, R0); }
#undef DN_LSTEP
            } else {
                DN_BAR();
                for (int n = 0; n < 64; ++n) { DN_COMPUTE(n); DN_BAR(); }
            }
            asm volatile("s_waitcnt vmcnt(0)" ::: "memory");
#undef DN_BAR
#undef DN_LD
#undef DN_LWAIT
#undef DN_WR
#undef DN_FADDR
#undef DN_COMPUTE
        } else if (bx < 20) {
            const int b = bx - 16, ch = tid; const float* SUM = (const float*)(wsl + WS_RGSUM); float* CARRY = (float*)(wsl + WS_CARRY); float carry = 0.f;
            for (int n0 = 0; n0 < 64; n0 += 8) { float ap[8], he[8];
#pragma unroll
                for (int j = 0; j < 8; ++j) { ap[j] = SUM[(size_t)(b * 64 + n0 + j) * 512 + ch]; he[j] = SUM[(size_t)(256 + b * 64 + n0 + j) * 512 + ch]; }
#pragma unroll
                for (int j = 0; j < 8; ++j) { CARRY[(size_t)(b * 64 + n0 + j) * 512 + ch] = carry; carry = ap[j] * carry + he[j]; } }
        } else if (bx < 52) {
            if (bx < 36) { pg8::Gemm g{D, D, D}; pg8::StaticOrder S; S.init(MEMN, Wckv_t, NB * MEML, D, D, D, 16, bx - 20); pg8::EpiStore E{KM, D};
                pg8::gemm_phase<pg8::EpiStore, pg8::StaticOrder, true, false>(lds, g, S, E); }
            else { pg8::Gemm g{D, D, D}; pg8::StaticOrder S; S.init(Wckv_t + (size_t)D * D, MEMN, D, NB * MEML, D, D, 16, bx - 36); pg8::EpiStore E{VT, D};
                pg8::gemm_phase<pg8::EpiStore, pg8::StaticOrder, true, false>(lds, g, S, E); }
        } else if (wave < 4) {
            LAS float* scr = (LAS float*)(lds + wave * 16640); const int cw = (bx - 52) * 4 + wave, NCW = (G - 52) * 4;
            constexpr int I_GU = 32 * 2 * 16 * 16, I_D = 32 * 16 * 16;
            for (int it_ = cw; it_ < (I_GU + I_D) * REPS(3); it_ += NCW) { const int it = it_ % (I_GU + I_D);
                if (it < I_GU) { const int nb = it & 15, kb = (it >> 4) & 15, which = (it >> 8) & 1, e = it >> 9, n0 = nb * 64;
                    transpose_item64<true>((which ? w_up : w_gate) + (size_t)e * D * D, D, n0, kb * 64, Wgu_t + ((size_t)e * 2048 + (n0 >> 7) * 256 + (n0 & 127) + which * 128) * D, D, norm_moe, scr, lane); }
                else { const int r = it - I_GU, nb = r & 15, kb = (r >> 4) & 15, e = r >> 8;
                    transpose_item64<true>(w_down + (size_t)e * D * D, D, nb * 64, kb * 64, Wd_t + ((size_t)e * 1024 + nb * 64) * D, D, nullptr, scr, lane); }
            }
        }
    }
    SEAM(3);
    STAMP(4);
    if (IN(4)) {
        PHASE_PTRS
        for (int row_ = gw; row_ < M * REPS(4); row_ += NGW) { const int row = row_ % M, c0 = 8 * lane;
            const f32x4 o0 = *(const f32x4*)(ODN + (size_t)row * 512 + c0), o1 = *(const f32x4*)(ODN + (size_t)row * 512 + c0 + 4); const v4u zz = *(const v4u*)(PROJ + (size_t)row * NP + PC_Z + c0);
            float q = (o0[0] * o0[0] + o0[1] * o0[1]) + (o0[2] * o0[2] + o0[3] * o0[3]) + (o1[0] * o1[0] + o1[1] * o1[1]) + (o1[2] * o1[2] + o1[3] * o1[3]);
            q += __shfl_xor(q, 1); q += __shfl_xor(q, 2); q += __shfl_xor(q, 4); q += __shfl_xor(q, 8);
            const float rs = rsqrtf(q * (1.f / 128) + EPS); const f32x4 g0 = *(const f32x4*)(dn_norm + (c0 & 127)), g1 = *(const f32x4*)(dn_norm + (c0 & 127) + 4); v4u ov;
#pragma unroll
            for (int e = 0; e < 4; ++e) { const float a = (e < 2 ? o0[2 * e] : o1[2 * e - 4]) * rs * (e < 2 ? g0[2 * e] : g1[2 * e - 4]) * siluf_(bf2f((bf16)(zz[e] & 0xffff)));
                const float bq = (e < 2 ? o0[2 * e + 1] : o1[2 * e - 3]) * rs * (e < 2 ? g0[2 * e + 1] : g1[2 * e - 3]) * siluf_(bf2f((bf16)(zz[e] >> 16))); ov[e] = pk2(a, bq); }
            *(v4u*)(MIX + (size_t)row * D + c0) = ov; }
        for (int unit_ = bx; unit_ < NB * 64 * REPS(4); unit_ += G) { const int unit = unit_ & 255, c0 = 8 * lane; const size_t row0 = (size_t)unit * 64;
            const f32x4 ca = *(const f32x4*)((const float*)(wsl + WS_CARRY) + (size_t)unit * 512 + c0), cb = *(const f32x4*)((const float*)(wsl + WS_CARRY) + (size_t)unit * 512 + c0 + 4);
#pragma unroll 2
            for (int c = wave; c < 64; c += NWAVES) { const size_t row = row0 + c; const v4u hl = *(const v4u*)((const bf16*)(wsl + WS_HLOC) + row * 512 + c0), cpv = *(const v4u*)((const bf16*)(wsl + WS_CP) + row * 512 + c0), yy = *(const v4u*)(PROJ + row * NP + PC_RY + c0); v4u ov;
#pragma unroll
                for (int e = 0; e < 4; ++e) { const float c_lo = e < 2 ? ca[2 * e] : cb[2 * e - 4], c_hi = e < 2 ? ca[2 * e + 1] : cb[2 * e - 3];
                    const float h0 = bf2f((bf16)(hl[e] & 0xffff)) + bf2f((bf16)(cpv[e] & 0xffff)) * c_lo, h1 = bf2f((bf16)(hl[e] >> 16)) + bf2f((bf16)(cpv[e] >> 16)) * c_hi;
                    ov[e] = pk2(h0 * gelu_tanh(bf2f((bf16)(yy[e] & 0xffff))), h1 * gelu_tanh(bf2f((bf16)(yy[e] >> 16)))); }
                *(v4u*)(MIX + row * D + 512 + c0) = ov; } }
    }
    SEAM(4);
    STAMP(5);
    if (IN(5)) {
        PHASE_PTRS
        pg8::Gemm g{D, D, D}; pg8::StaticOrder S; S.init(MIX, Wout_t, M, D, D, D, G, bx); S.rep = REPS(5); pg8::EpiResid E{x, out, HB, ss1};
        pg8::gemm_phase<pg8::EpiResid, pg8::StaticOrder, true, false>(lds, g, S, E);
    }
    SEAM(5);
    STAMP(6);
    if (IN(6)) {
        PHASE_PTRS
        for (int rp6 = 0; rp6 < REPS(6); ++rp6) { const int ut = bx; if (ut < (M / 256) * 4) {
            const int pm = ut >> 2, h = ut & 3, b = pm / (T / 256);
            { pg8::Gemm g{D, D, D}; pg8::OneUnit S; S.u0 = pg8::Unit{pm, h, (const char*)(HB + (size_t)pm * 256 * D), (const char*)(Wcq_t + (size_t)h * 256 * D), 0, 0};
              pg8::EpiRowScale E{Qb, ss1, 0.0625f}; pg8::gemm_phase<pg8::EpiRowScale, pg8::OneUnit, false, false>(lds, g, S, E); }
            asm volatile("s_waitcnt vmcnt(0)" ::: "memory"); __syncthreads();
            { pg8::Gemm g{D, D, 256}; pg8::OneUnit S; S.u0 = pg8::Unit{pm, h, (const char*)(Qb + (size_t)pm * 256 * D + h * 256), (const char*)(KM + (size_t)b * 256 * D + h * 256), 0, 0};
              pg8::EpiSoftmax E{Pb}; pg8::gemm_phase<pg8::EpiSoftmax, pg8::OneUnit, false, false>(lds, g, S, E); }
            asm volatile("s_waitcnt vmcnt(0)" ::: "memory"); __syncthreads();
            { pg8::Gemm g{D, D, 256}; pg8::OneUnit S; S.u0 = pg8::Unit{pm, h, (const char*)(Pb + (size_t)pm * 256 * D + h * 256), (const char*)(VT + (size_t)h * 256 * D + b * 256), 0, 0};
              pg8::EpiStore E{O2, D}; pg8::gemm_phase<pg8::EpiStore, pg8::OneUnit, false, false>(lds, g, S, E); }
            asm volatile("s_waitcnt vmcnt(0)" ::: "memory"); __syncthreads();
        } }
    }
    SEAM(6);
    STAMP(7);
    if (IN(7)) {
        PHASE_PTRS
        pg8::Gemm g{D, D, D}; pg8::StaticOrder S; S.init(O2, Wco_t, M, D, D, D, G, bx); pg8::EpiResid E{out, out, HB2, ss2};
        pg8::gemm_phase<pg8::EpiResid, pg8::StaticOrder, true, false>(lds, g, S, E);
    }
    SEAM(7);
    STAMP(8);
    if (IN(8)) {
        PHASE_PTRS
        unsigned* cntg = ctl + CW_CNT; int* TOKLw = (int*)(wsl + WS_TOKL); float* GATELw = (float*)(wsl + WS_GATEL); float* RSLw = (float*)(wsl + WS_RSL);
        const bf16* WRh = (const bf16*)(wsl + WS_WR); const bf16* WRl = WRh + NE * D; LAS float* part = (LAS float*)lds;
        for (int rb = bx; rb < M / 64; rb += G) {
            const int rgp = wave & 1, kq = wave >> 1, l31 = lane & 31, hh = lane >> 5; f32x16 acc;
#pragma unroll
            for (int r = 0; r < 16; ++r) acc[r] = 0.f;
            const float* arow = out + (size_t)(rb * 64 + rgp * 32 + l31) * D + kq * 256 + 8 * hh; const bf16* bh = WRh + (size_t)l31 * D + kq * 256 + 8 * hh; const bf16* bl = WRl + (size_t)l31 * D + kq * 256 + 8 * hh;
#pragma unroll 4
            for (int ks = 0; ks < 16; ++ks) { const f32x4 a0 = *(const f32x4*)(arow + 16 * ks), a1 = *(const f32x4*)(arow + 16 * ks + 4); const bf16x8 bhv = *(const bf16x8*)(bh + 16 * ks), blv = *(const bf16x8*)(bl + 16 * ks);
                v4u ah, al;
#pragma unroll
                for (int e = 0; e < 4; ++e) { const float x0 = e < 2 ? a0[2 * e] : a1[2 * e - 4], x1 = e < 2 ? a0[2 * e + 1] : a1[2 * e - 3]; const bf16 h0 = f2bf(x0), h1 = f2bf(x1);
                    ah[e] = (unsigned)h0 | ((unsigned)h1 << 16); al[e] = pk2(x0 - bf2f(h0), x1 - bf2f(h1)); }
                const bf16x8 ahv = __builtin_bit_cast(bf16x8, ah), alv = __builtin_bit_cast(bf16x8, al);
                acc = __builtin_amdgcn_mfma_f32_32x32x16_bf16(ahv, bhv, acc, 0, 0, 0); acc = __builtin_amdgcn_mfma_f32_32x32x16_bf16(alv, bhv, acc, 0, 0, 0); acc = __builtin_amdgcn_mfma_f32_32x32x16_bf16(ahv, blv, acc, 0, 0, 0); }
#pragma unroll
            for (int r = 0; r < 16; ++r) part[(kq * 64 + rgp * 32 + (r & 3) + 8 * (r >> 2) + 4 * hh) * 33 + l31] = acc[r];
            __syncthreads();
            if (tid < 64) { const int row = rb * 64 + tid; const float rs = rsqrtf(pg8::row_ss(ss2, row) * (1.f / D) + EPS); float lg[32];
#pragma unroll
                for (int e = 0; e < 32; ++e) lg[e] = ((part[tid * 33 + e] + part[(64 + tid) * 33 + e]) + (part[(128 + tid) * 33 + e] + part[(192 + tid) * 33 + e])) * rs + b_router[e];
                float tl[4]; int te[4];
#pragma unroll
                for (int q = 0; q < 4; ++q) { float m = lg[0]; int mi = 0;
#pragma unroll
                    for (int e = 1; e < 32; ++e) if (lg[e] > m) { m = lg[e]; mi = e; }
                    tl[q] = m; te[q] = mi;
#pragma unroll
                    for (int e = 0; e < 32; ++e) if (e == mi) lg[e] = -3.0e38f; }
                const float e1 = __expf(tl[1] - tl[0]), e2 = __expf(tl[2] - tl[0]), e3 = __expf(tl[3] - tl[0]), inv = 1.f / (1.f + e1 + e2 + e3);
                LAS unsigned* lcnt = (LAS unsigned*)(lds + 40960); LAS unsigned* lbase = lcnt + 32;
                if (tid < 32) lcnt[tid] = 0u;
                LDS_WAIT(); __builtin_amdgcn_wave_barrier();
                unsigned lp[4];
#pragma unroll
                for (int q = 0; q < 4; ++q) lp[q] = __hip_atomic_fetch_add(&lcnt[te[q]], 1u, __ATOMIC_RELAXED, __HIP_MEMORY_SCOPE_WORKGROUP);
                LDS_WAIT(); __builtin_amdgcn_wave_barrier();
                if (tid < 32) lbase[tid] = atomicAdd(&cntg[tid * CNT_STRIDE], lcnt[tid]);
                LDS_WAIT(); __builtin_amdgcn_wave_barrier();
#pragma unroll
                for (int q = 0; q < 4; ++q) { const float gv = (q == 0 ? 1.f : q == 1 ? e1 : q == 2 ? e2 : e3) * inv; const unsigned pos = lbase[te[q]] + lp[q];
                    TOKLw[te[q] * M + pos] = row * 4 + q; GATELw[te[q] * M + pos] = gv; RSLw[te[q] * M + pos] = rs; } }
            __syncthreads();
        }
    }
    SEAM(8);
    STAMP(9);
    if (IN(9) || IN(10)) {
        PHASE_PTRS
        const unsigned* cntg = ctl + CW_CNT;
        if (tid < 32) LW[LW_CNT + tid] = cntg[tid * CNT_STRIDE];
        __syncthreads();
        if (tid == 0) { int s = 0; for (int e = 0; e < 32; ++e) { LW[LW_TSTART + e] = (unsigned)s; s += ((int)LW[LW_CNT + e] + 255) >> 8; } LW[LW_TSTART + 32] = (unsigned)s; }
        __syncthreads();
    }
    const LAS int* tstart = (const LAS int*)(lds + LDSCTL_OFF) + LW_TSTART; const LAS int* cntl = (const LAS int*)(lds + LDSCTL_OFF) + LW_CNT;
    if (IN(9)) {
        PHASE_PTRS
        pg8::Gemm g{D, D, D}; pg8::MoeOrder<8, true> S{G, bx, tstart, cntl, (const char*)HB2, (const char*)Wgu_t, TOKL, REPS(9)};
        pg8::EpiFFN1 E{HID, RSL, b_gate, b_up, cntl};
        pg8::gemm_phase<pg8::EpiFFN1, pg8::MoeOrder<8, true>, true, true>(lds, g, S, E);
    }
    SEAM(9);
    STAMP(10);
    if (IN(10)) {
        PHASE_PTRS
        pg8::Gemm g{D, D, D}; pg8::MoeOrder<4, false> S{G, bx, tstart, cntl, (const char*)HID, (const char*)Wd_t, TOKL, REPS(10)};
        pg8::EpiFFN2 E{Y, TOKL, GATEL, b_down, cntl};
        pg8::gemm_phase<pg8::EpiFFN2, pg8::MoeOrder<4, false>, true, false>(lds, g, S, E);
    }
    SEAM(10);
    STAMP(11);
    if (IN(11)) {
        PHASE_PTRS
        for (int row = gw; row < M; row += NGW) {
            f32x4 v[4]; float s = 0.f;
#pragma unroll
            for (int j = 0; j < 4; ++j) { const int c = 4 * lane + 256 * j; f32x4 h = *(const f32x4*)(out + (size_t)row * D + c);
#pragma unroll
                for (int k = 0; k < 4; ++k) { const unsigned long long yy = *(const unsigned long long*)(Y + ((size_t)row * 4 + k) * D + c);
                    h[0] += bf2f((bf16)(yy & 0xffff)); h[1] += bf2f((bf16)((yy >> 16) & 0xffff)); h[2] += bf2f((bf16)((yy >> 32) & 0xffff)); h[3] += bf2f((bf16)(yy >> 48)); }
                v[j] = h; s += (h[0] * h[0] + h[1] * h[1]) + (h[2] * h[2] + h[3] * h[3]); }
            const float rs = rsqrtf(wave_sum(s) * (1.f / D) + EPS);
#pragma unroll
            for (int j = 0; j < 4; ++j) { const int c = 4 * lane + 256 * j; const f32x4 gg = *(const f32x4*)(norm_final + c); *(f32x4*)(out + (size_t)row * D + c) = v[j] * rs * gg; }
        }
    }
    STAMP(12);
    if (TS_LO >= 0 && blockIdx.x == 0 && threadIdx.x == 0) {
        unsigned long long* tsp = (unsigned long long*)(args.ws + WS_TS);
        const unsigned long long t0 = __hip_atomic_load(tsp + TS_LO, __ATOMIC_RELAXED, __HIP_MEMORY_SCOPE_AGENT), t1 = __hip_atomic_load(tsp + TS_HI, __ATOMIC_RELAXED, __HIP_MEMORY_SCOPE_AGENT);
        const unsigned long long until = __builtin_amdgcn_s_memrealtime() + TS_MULT * (t1 - t0);
        while (__builtin_amdgcn_s_memrealtime() < until) __builtin_amdgcn_s_sleep(8);
    }
#undef IN
#undef SEAM
}

static void launch_mk(Args a, int lo, int hi, int bli, int grid, hipStream_t stream) {
    a.ph_lo = lo; a.ph_hi = hi; a.bli = bli; a.pad = 0;
    hipLaunchKernelGGL(mk_fwd, dim3(grid), dim3(NTHR), LDS_BYTES, stream, a);
}
extern "C" void kernel_launch(void* const* d_in, const int* in_sizes, int n_in, void* d_out, int out_size, void* d_ws, size_t ws_size, hipStream_t stream) {
    if (n_in != 31 || out_size != M * D || ws_size < WS_END) { fprintf(stderr, "kernel_launch: unexpected shapes n_in %d out %d ws %zu\n", n_in, out_size, ws_size); return; }
    static int grid = 0;
    if (grid == 0) {
        int dev = 0, cus = 0;
        if (hipGetDevice(&dev) != hipSuccess || hipDeviceGetAttribute(&cus, hipDeviceAttributeMultiprocessorCount, dev) != hipSuccess) { grid = -1; return; }
        if (hipFuncSetAttribute((const void*)mk_fwd, hipFuncAttributeMaxDynamicSharedMemorySize, LDS_BYTES) != hipSuccess) { fprintf(stderr, "kernel_launch: hipFuncSetAttribute failed\n"); grid = -1; return; }
        int per_cu = 0; (void)hipOccupancyMaxActiveBlocksPerMultiprocessor(&per_cu, (const void*)mk_fwd, NTHR, LDS_BYTES); (void)hipGetLastError();
        if (per_cu < 1) fprintf(stderr, "kernel_launch: occupancy query reports %d blocks per CU\n", per_cu);
        if (cus < 256) { fprintf(stderr, "kernel_launch: needs 256 CUs, device has %d\n", cus); grid = -1; return; }
        grid = 256;
    }
    if (grid < 0) return;
    const float* const* in = (const float* const*)d_in;
    const float *dn_conv = in[4], *dn_a_log = in[5], *dn_dt_bias = in[6], *dn_norm = in[7];
    const float *rg_conv = in[8], *rg_conv_b = in[9], *rg_w_a = in[10], *rg_b_a = in[11], *rg_w_x = in[12], *rg_b_x = in[13], *rg_lambda = in[14];
    const float *norm_moe = in[21], *w_router = in[22], *b_router = in[23];
    char* ws = (char*)d_ws; float* out = (float*)d_out;
    unsigned* ctl = (unsigned*)(ws + WS_CTL); unsigned* cnt = ctl + CW_CNT; float* ss2 = (float*)(ws + CTL_SS2);
    float* BA = (float*)(ws + WS_BA); float* RSTD2 = (float*)(ws + WS_RSTD2);
    int* TOKL = (int*)(ws + WS_TOKL); float* GATEL = (float*)(ws + WS_GATEL); float* RSL = (float*)(ws + WS_RSL);
    bf16 *MIX = (bf16*)(ws + WS_XN), *PROJ = (bf16*)(ws + WS_PROJ);
    float* ODN = (float*)(ws + WS_ODN); float* QKVN = (float*)(ws + WS_QKVN);
    Args a{};
    for (int i = 0; i < 31; ++i) a.in[i] = (const float*)d_in[i];
    a.out = out; a.ws = (unsigned char*)d_ws;

    (void)hipMemsetAsync(ws + WS_CTL, 0, CTL_BYTES, stream);
    launch_mk(a, 0, 12, 0, grid, stream);
}
```

```cpp
#include <hip/hip_runtime.h>
#include <cstdio>
#include <cstdint>

typedef unsigned short bf16;
#ifndef TS_LO
#define TS_LO -1
#define TS_HI -1
#endif
#define TS_MULT 4
__device__ __forceinline__ float bf2f(bf16 v) { return __builtin_bit_cast(float, (unsigned)v << 16); }
__device__ __forceinline__ bf16 f2bf(float f) { unsigned u = __builtin_bit_cast(unsigned, f); return (bf16)((u + 0x7fffu + ((u >> 16) & 1u)) >> 16); }

constexpr int NB = 4, T = 4096, D = 1024, M = NB * T, NIN = 3080, NP = 3072, MEML = 256;
constexpr int NE = 32, TOPK = 4;
constexpr float EPS = 1e-6f;
constexpr int PC_Q = 0, PC_K = 512, PC_V = 1024, PC_Z = 1536, PC_RX = 2048, PC_RY = 2560;

constexpr size_t MiB = 1u << 20;
constexpr size_t WS_CTL = 0, CTL_BYTES = 1 * MiB;
constexpr int CW_CNT = 16384, CNT_STRIDE = 64;
constexpr size_t CTL_SS1 = 128 * 1024, CTL_SS2 = 192 * 1024;
constexpr size_t WS_BA = 1 * MiB, WS_RSTD2 = 1 * MiB + 512 * 1024, WS_DEC = 1 * MiB + 768 * 1024;
constexpr size_t WS_RGW = 2 * MiB, WS_WR = 2 * MiB + 512 * 1024, WS_MEMN = 3 * MiB, WS_KM = 5 * MiB, WS_VT = 7 * MiB;
constexpr size_t WS_RGSUM = 9 * MiB, WS_TOKL = 10 * MiB, WS_GATEL = 12 * MiB, WS_RSL = 14 * MiB;
constexpr size_t WS_WIN = 16 * MiB, WS_WOUT = 22 * MiB, WS_WCQ = 24 * MiB, WS_WCKV = 26 * MiB, WS_WCO = 30 * MiB;
constexpr size_t WS_WGU = 32 * MiB, WS_WD = 160 * MiB;
constexpr size_t WS_XN = 224 * MiB;
constexpr size_t WS_PROJ = 256 * MiB;
constexpr size_t WS_HB = 256 * MiB, WS_Q = 288 * MiB, WS_P = 320 * MiB, WS_HID = 256 * MiB;
constexpr size_t WS_DN = 352 * MiB;
constexpr size_t WS_O2 = 352 * MiB, WS_SC = 384 * MiB  ;
constexpr size_t WS_ODN = 442 * MiB, WS_HLOC = 474 * MiB, WS_CP = 490 * MiB, WS_SSP1 = 506 * MiB, WS_SSP2 = 507 * MiB, WS_CARRY = 508 * MiB, WS_TS = 508 * MiB + 768 * 1024, WS_END = 509 * MiB;
constexpr size_t WS_Y = 32 * MiB;
constexpr int DNU_BYTES = 73728, DNU_WN = 0, DNU_QG = 16384, DNU_KDT = 32768, DNU_QK = 49152, DNU_UT = 57344;
constexpr size_t WS_QKVN = 32 * MiB;

__host__ __device__ __forceinline__ int kperm(int k) { const int g = (k >> 2) & 3; return (g == 1 || g == 2) ? (k ^ 12) : k; }
#define DPP_ADD(v, ctrl) ((v) + __builtin_bit_cast(float, __builtin_amdgcn_update_dpp(0, __builtin_bit_cast(int, (v)), (ctrl), 0xF, 0xF, true)))
__device__ __forceinline__ float wave_sum(float v) {
    v = DPP_ADD(v, 0xB1); v = DPP_ADD(v, 0x4E); v = DPP_ADD(v, 0x141); v = DPP_ADD(v, 0x140);
    const float r0 = __builtin_bit_cast(float, __builtin_amdgcn_readlane(__builtin_bit_cast(int, v), 0)), r1 = __builtin_bit_cast(float, __builtin_amdgcn_readlane(__builtin_bit_cast(int, v), 16));
    const float r2 = __builtin_bit_cast(float, __builtin_amdgcn_readlane(__builtin_bit_cast(int, v), 32)), r3 = __builtin_bit_cast(float, __builtin_amdgcn_readlane(__builtin_bit_cast(int, v), 48));
    return (r0 + r1) + (r2 + r3);
}
__device__ __forceinline__ float sigmoidf_(float x) { return 1.f / (1.f + __expf(-x)); }
__device__ __forceinline__ float siluf_(float x) { return x * sigmoidf_(x); }
__device__ __forceinline__ float softplusf_(float x) { return fmaxf(x, 0.f) + log1pf(__expf(-fabsf(x))); }
__device__ __forceinline__ float gelu_tanh(float x) { const float u = 0.7978845608028654f * (x + 0.044715f * x * x * x); return 0.5f * x * (1.f + tanhf(u)); }
__device__ __forceinline__ float ffn_act(float gt, float up) { gt = fminf(gt, 7.f); up = fminf(fmaxf(up, -7.f), 7.f); return (up + 1.f) * (gt * sigmoidf_(1.702f * gt)); }

namespace pg8 {
#define PG8_LAS __attribute__((address_space(3)))
typedef unsigned short bf16_t;
typedef short bf16x8 __attribute__((ext_vector_type(8)));
typedef float f32x4 __attribute__((ext_vector_type(4)));
typedef unsigned u32x4 __attribute__((ext_vector_type(4)));
constexpr int BM = 256, BK = 64, HALF = 128, HTB = HALF * BK * 2, STAGE_BYTES = 8 * HTB, NXCD = 8, WGM = 8;

__host__ __device__ __forceinline__ int lds_byte(int r, int c) { const int st = (r >> 4) * 2 + (c >> 5), rr = r & 15, cc = c & 31, ob = rr * 64 + cc * 2; return st * 1024 + (ob ^ (((ob >> 9) & 1) << 5)); }
__host__ __device__ __forceinline__ void stage_rc(int b, int& R, int& C) { const int st = b / 1024, sb = b % 1024, swz = sb ^ (((sb >> 9) & 1) << 5); R = (st >> 1) * 16 + swz / 64; C = (st & 1) * 32 + (swz % 64) / 2; }
__host__ __device__ __forceinline__ int perm32(int rho) { const int n = rho >> 4, i = rho & 15; return 8 * (i >> 2) + 4 * n + (i & 3); }

struct Unit { int pm, pn; const char* a; const char* b; int e, j; };
struct Gemm { int lda, ldb, K; };

struct StaticOrder {
    int nM, nN, nwg, G, c, rep = 1; const char* A; const char* Bt; size_t astep, bstep;
    __device__ void init(const void* A_, const void* Bt_, int M, int N, int lda, int ldb, int G_, int c_) { nM = M / BM; nN = N / BM; nwg = nM * nN; G = G_; c = c_; A = (const char*)A_; Bt = (const char*)Bt_; astep = (size_t)BM * lda * 2; bstep = (size_t)BM * ldb * 2; }
    __device__ bool next(int i, Unit& u) const {
        long L = (long)i * G + c; if (L >= (long)nwg * rep) return false; L %= nwg;
        int wgid = (int)L; { const int q = nwg / NXCD, r = nwg % NXCD, xcd = wgid % NXCD, off = wgid / NXCD; wgid = (xcd < r ? xcd * (q + 1) : r * (q + 1) + (xcd - r) * q) + off; }
        const int nig = WGM * nN, gid = wgid / nig, fm = gid * WGM, gsz = (nM - fm) < WGM ? (nM - fm) : WGM;
        u.pm = fm + ((wgid % nig) % gsz); u.pn = (wgid % nig) / gsz; u.a = A + (size_t)u.pm * astep; u.b = Bt + (size_t)u.pn * bstep; u.e = 0; u.j = 0; return true;
    }
    __device__ __forceinline__ int arow(const Unit&, int) const { return 0; }
};
struct OneUnit {
    Unit u0;
    __device__ bool next(int i, Unit& u) const { if (i != 0) return false; u = u0; return true; }
    __device__ __forceinline__ int arow(const Unit&, int) const { return 0; }
};

__device__ __forceinline__ unsigned cvt_pk_bf16(float lo, float hi) { unsigned r; asm volatile("v_cvt_pk_bf16_f32 %0, %1, %2" : "=v"(r) : "v"(lo), "v"(hi)); return r; }

typedef f32x4 Acc[2][2][4][2];

template <class Epi, class Sched, bool ALIGN_EPI, bool GATHER>
__device__ __forceinline__ void gemm_phase(PG8_LAS unsigned char* lds, const Gemm g, const Sched& S, const Epi& E) {
    const int tid = threadIdx.x, wid = __builtin_amdgcn_readfirstlane(tid >> 6), lane = tid & 63, wr = wid >> 2, wc = wid & 3, fr = lane & 15, fq = lane >> 4;
    const int nt = g.K / BK;
    unsigned voffA[2], voffB[2]; int RA[2], CA[2];
#pragma unroll
    for (int i = 0; i < 2; ++i) { int R, C; stage_rc(tid * 16 + i * 8192, R, C); const int Rb = (R & ~31) + perm32(R & 31);
        voffA[i] = (unsigned)(R * g.lda + C) * 2u; voffB[i] = (unsigned)(Rb * g.ldb + C) * 2u; RA[i] = R; CA[i] = C; }
    const size_t kstep = (size_t)(BK * 2);
    const size_t hstepA = (size_t)HALF * g.lda * 2, hstepB = (size_t)HALF * g.ldb * 2;
    const unsigned ldsw = (unsigned)wid * 1024u;
    const int aoff = lds_byte(wr * 64 + fr, fq * 8), boff = lds_byte(wc * 32 + fr, fq * 8);
    unsigned aoC[2][2], aoN[2][2];
#define PG8_SA(b, h) (((b) * 2 + (h)) * HTB)
#define PG8_SB(b, h) ((4 + (b) * 2 + (h)) * HTB)
#define PG8_STAGE(bufoff, gbase, voff) do { _Pragma("unroll") for (int _i = 0; _i < 2; ++_i) \
        __builtin_amdgcn_global_load_lds((const unsigned*)((const char*)(gbase) + (voff)[_i]), (PG8_LAS unsigned*)(lds + (bufoff) + ldsw + _i * 8192), 16, 0, 0); } while (0)
#define PG8_STAGE_A(bufoff, gbase, h, nx) do { if constexpr (GATHER) { unsigned _v[2]; _v[0] = (nx) ? aoN[h][0] : aoC[h][0]; _v[1] = (nx) ? aoN[h][1] : aoC[h][1]; PG8_STAGE(bufoff, gbase, _v); } \
        else { PG8_STAGE(bufoff, (gbase) + (h) * hstepA, voffA); } } while (0)
#define PG8_GOFF(dst, un) do { _Pragma("unroll") for (int _h = 0; _h < 2; ++_h) _Pragma("unroll") for (int _i = 0; _i < 2; ++_i) \
        dst[_h][_i] = (unsigned)(S.arow(un, _h * HALF + RA[_i]) * g.lda + CA[_i]) * 2u; } while (0)
#define PG8_LDA(dst, b, h) do { _Pragma("unroll") for (int m = 0; m < 4; ++m) _Pragma("unroll") for (int k = 0; k < 2; ++k) dst[m][k] = *(const PG8_LAS bf16x8*)(lds + PG8_SA(b, h) + aoff + m * 2048 + k * 1024); } while (0)
#define PG8_LDB(dst, b, h) do { _Pragma("unroll") for (int n = 0; n < 2; ++n) _Pragma("unroll") for (int k = 0; k < 2; ++k) dst[n][k] = *(const PG8_LAS bf16x8*)(lds + PG8_SB(b, h) + boff + n * 2048 + k * 1024); } while (0)
#define PG8_MMA(ai, bj, At, Bt) do { __builtin_amdgcn_s_setprio(1); _Pragma("unroll") for (int m = 0; m < 4; ++m) _Pragma("unroll") for (int n = 0; n < 2; ++n) _Pragma("unroll") for (int k = 0; k < 2; ++k) \
        acc[ai][bj][m][n] = __builtin_amdgcn_mfma_f32_16x16x32_bf16(Bt[n][k], At[m][k], acc[ai][bj][m][n], 0, 0, 0); __builtin_amdgcn_s_setprio(0); } while (0)
#define PG8_WAIT_V(n) asm volatile("s_waitcnt vmcnt(" #n ")" ::: "memory")
#define PG8_WAIT_L(n) asm volatile("s_waitcnt lgkmcnt(" #n ")" ::: "memory")
#define PG8_BAR __builtin_amdgcn_s_barrier()
#define PG8_SCHED __builtin_amdgcn_sched_barrier(0)
    Unit cur, nxt; int ui = 0;
    if (!S.next(0, cur)) return;
    if constexpr (GATHER) { PG8_GOFF(aoC, cur); }
    Acc acc;
#pragma unroll
    for (int a = 0; a < 2; ++a)
#pragma unroll
        for (int b = 0; b < 2; ++b)
#pragma unroll
            for (int m = 0; m < 4; ++m)
#pragma unroll
                for (int n = 0; n < 2; ++n) acc[a][b][m][n] = (f32x4){0.f, 0.f, 0.f, 0.f};
    bf16x8 At[4][2], B0[2][2], B1[2][2];
    const char* cA = cur.a; const char* cB = cur.b;
    PG8_STAGE(PG8_SB(0, 0), cB, voffB); PG8_STAGE(PG8_SB(0, 1), cB + hstepB, voffB); PG8_STAGE_A(PG8_SA(0, 0), cA, 0, false); PG8_STAGE_A(PG8_SA(0, 1), cA, 1, false);
    if (wr == 1) PG8_BAR;
    PG8_WAIT_V(2); PG8_BAR;
    PG8_STAGE(PG8_SB(1, 0), cB + kstep, voffB); PG8_STAGE_A(PG8_SA(1, 0), cA + kstep, 0, false); PG8_STAGE(PG8_SB(1, 1), cB + hstepB + kstep, voffB);
    PG8_WAIT_V(6); PG8_BAR;
    for (;;) {
        const bool has_next = S.next(ui + 1, nxt);
        if constexpr (GATHER) { if (has_next) { PG8_GOFF(aoN, nxt); } else {
#pragma unroll
            for (int _h = 0; _h < 2; ++_h) { aoN[_h][0] = aoC[_h][0]; aoN[_h][1] = aoC[_h][1]; } } }
        const char* nA = has_next ? nxt.a : cA; const char* nB = has_next ? nxt.b : cB;
#pragma nounroll
        for (int t = 0; t < nt; t += 2) {
            const bool last = (t == nt - 2);
            const char* a1 = cA + (size_t)(t + 1) * kstep;
            const char* a2 = last ? nA : cA + (size_t)(t + 2) * kstep; const char* b2 = last ? nB : cB + (size_t)(t + 2) * kstep;
            const char* a3 = a2 + kstep; const char* b3 = b2 + kstep;
            PG8_LDB(B0, 0, 0); PG8_LDB(B1, 0, 1); PG8_SCHED; PG8_LDA(At, 0, 0); PG8_STAGE_A(PG8_SA(1, 1), a1, 1, false);
            PG8_WAIT_V(8); PG8_WAIT_L(0); PG8_BAR; PG8_MMA(0, 0, At, B0); PG8_MMA(0, 1, At, B1); PG8_BAR; PG8_SCHED;
            PG8_LDA(At, 0, 1); PG8_STAGE(PG8_SB(0, 0), b2, voffB); PG8_STAGE(PG8_SB(0, 1), b2 + hstepB, voffB); PG8_STAGE_A(PG8_SA(0, 0), a2, 0, last);
            PG8_WAIT_V(8); PG8_WAIT_L(0); PG8_BAR; PG8_MMA(1, 0, At, B0); PG8_MMA(1, 1, At, B1); PG8_BAR; PG8_SCHED;
            PG8_LDB(B0, 1, 0); PG8_LDB(B1, 1, 1); PG8_SCHED; PG8_LDA(At, 1, 0); PG8_STAGE_A(PG8_SA(0, 1), a2, 1, last);
            PG8_WAIT_V(8); PG8_WAIT_L(0); PG8_BAR; PG8_MMA(0, 0, At, B0); PG8_MMA(0, 1, At, B1); PG8_BAR; PG8_SCHED;
            PG8_LDA(At, 1, 1); PG8_STAGE(PG8_SB(1, 0), b3, voffB); PG8_STAGE(PG8_SB(1, 1), b3 + hstepB, voffB); PG8_STAGE_A(PG8_SA(1, 0), a3, 0, last);
            PG8_WAIT_V(8); PG8_WAIT_L(0); PG8_BAR; PG8_MMA(1, 0, At, B0); PG8_MMA(1, 1, At, B1); PG8_BAR; PG8_SCHED;
        }
        if constexpr (ALIGN_EPI) { if (wr == 0) PG8_BAR; }
        if constexpr (!Epi::AFTER_DRAIN) { E(acc, cur, wr, wc, fr, fq); }
        if (!has_next) break;
#pragma unroll
        for (int a = 0; a < 2; ++a)
#pragma unroll
            for (int b = 0; b < 2; ++b)
#pragma unroll
                for (int m = 0; m < 4; ++m)
#pragma unroll
                    for (int n = 0; n < 2; ++n) acc[a][b][m][n] = (f32x4){0.f, 0.f, 0.f, 0.f};
        cur = nxt; cA = nA; cB = nB; ++ui;
        if constexpr (GATHER) {
#pragma unroll
            for (int _h = 0; _h < 2; ++_h) { aoC[_h][0] = aoN[_h][0]; aoC[_h][1] = aoN[_h][1]; } }
        if constexpr (ALIGN_EPI) { if (wr == 1) PG8_BAR; }
    }
    PG8_WAIT_V(0);
    if constexpr (!ALIGN_EPI) { if (wr == 0) PG8_BAR; }
    PG8_BAR;
    if constexpr (Epi::AFTER_DRAIN) { E.fused(acc, cur, wr, wc, fr, fq, lds); }
#undef PG8_SA
#undef PG8_SB
#undef PG8_STAGE
#undef PG8_STAGE_A
#undef PG8_GOFF
#undef PG8_LDA
#undef PG8_LDB
#undef PG8_MMA
#undef PG8_WAIT_V
#undef PG8_WAIT_L
#undef PG8_BAR
#undef PG8_SCHED
}

struct EpiStore {
    static constexpr bool AFTER_DRAIN = false; bf16_t* O; int ldc;
    __device__ __forceinline__ void operator()(const Acc& acc, const Unit& u, int wr, int wc, int fr, int fq) const {
        const int row0 = u.pm * BM + wr * 64 + fr, col0 = u.pn * BM + wc * 32 + 8 * fq;
#pragma unroll
        for (int ai = 0; ai < 2; ++ai)
#pragma unroll
            for (int m = 0; m < 4; ++m) { bf16_t* rowp = O + (size_t)(row0 + ai * HALF + m * 16) * ldc + col0;
#pragma unroll
                for (int bj = 0; bj < 2; ++bj) { const f32x4 v0 = acc[ai][bj][m][0], v1 = acc[ai][bj][m][1];
                    u32x4 w; w.x = cvt_pk_bf16(v0[0], v0[1]); w.y = cvt_pk_bf16(v0[2], v0[3]); w.z = cvt_pk_bf16(v1[0], v1[1]); w.w = cvt_pk_bf16(v1[2], v1[3]);
                    *(u32x4*)(rowp + bj * HALF) = w; } }
    }
};
__device__ __forceinline__ float row_ss(const float* SS, int row) { const f32x4 a = *(const f32x4*)(SS + row * 16), b = *(const f32x4*)(SS + row * 16 + 4), c = *(const f32x4*)(SS + row * 16 + 8), d = *(const f32x4*)(SS + row * 16 + 12);
    return (((a[0] + a[1]) + (a[2] + a[3])) + ((b[0] + b[1]) + (b[2] + b[3]))) + (((c[0] + c[1]) + (c[2] + c[3])) + ((d[0] + d[1]) + (d[2] + d[3]))); }
template <bool RBF16, bool WF32> struct EpiResid {
    static constexpr bool AFTER_DRAIN = false; const void* R; float* H; bf16_t* HB; float* SS;
    __device__ __forceinline__ void operator()(const Acc& acc, const Unit& u, int wr, int wc, int fr, int fq) const {
        const int row0 = u.pm * BM + wr * 64 + fr, col0 = u.pn * BM + wc * 32 + 8 * fq;
#pragma unroll
        for (int ai = 0; ai < 2; ++ai)
#pragma unroll
            for (int m = 0; m < 4; ++m) { const int row = row0 + ai * HALF + m * 16; const size_t off = (size_t)row * D + col0; float sq = 0.f;
#pragma unroll
                for (int bj = 0; bj < 2; ++bj) { f32x4 r0, r1;
                    if (RBF16) { const u32x4 rb = *(const u32x4*)((const bf16_t*)R + off + bj * HALF);
                        r0 = (f32x4){__builtin_bit_cast(float, rb.x << 16), __builtin_bit_cast(float, rb.x & 0xffff0000u), __builtin_bit_cast(float, rb.y << 16), __builtin_bit_cast(float, rb.y & 0xffff0000u)};
                        r1 = (f32x4){__builtin_bit_cast(float, rb.z << 16), __builtin_bit_cast(float, rb.z & 0xffff0000u), __builtin_bit_cast(float, rb.w << 16), __builtin_bit_cast(float, rb.w & 0xffff0000u)}; }
                    else { r0 = *(const f32x4*)((const float*)R + off + bj * HALF); r1 = *(const f32x4*)((const float*)R + off + bj * HALF + 4); }
                    const f32x4 v0 = acc[ai][bj][m][0] + r0, v1 = acc[ai][bj][m][1] + r1;
                    if (WF32) { *(f32x4*)(H + off + bj * HALF) = v0; *(f32x4*)(H + off + bj * HALF + 4) = v1; }
                    u32x4 w; w.x = cvt_pk_bf16(v0[0], v0[1]); w.y = cvt_pk_bf16(v0[2], v0[3]); w.z = cvt_pk_bf16(v1[0], v1[1]); w.w = cvt_pk_bf16(v1[2], v1[3]);
                    *(u32x4*)(HB + off + bj * HALF) = w;
                    sq += (v0[0] * v0[0] + v0[1] * v0[1]) + (v0[2] * v0[2] + v0[3] * v0[3]) + (v1[0] * v1[0] + v1[1] * v1[1]) + (v1[2] * v1[2] + v1[3] * v1[3]); }
                sq += __shfl_xor(sq, 16); sq += __shfl_xor(sq, 32);
                if (fq == 0) SS[row * 16 + u.pn * 4 + wc] = sq; }
    }
};
struct EpiRowScale {
    static constexpr bool AFTER_DRAIN = false; bf16_t* O; const float* SS; float s;
    __device__ __forceinline__ void operator()(const Acc& acc, const Unit& u, int wr, int wc, int fr, int fq) const {
        const int row0 = u.pm * BM + wr * 64 + fr, col0 = u.pn * BM + wc * 32 + 8 * fq;
#pragma unroll
        for (int ai = 0; ai < 2; ++ai)
#pragma unroll
            for (int m = 0; m < 4; ++m) { const int row = row0 + ai * HALF + m * 16; const float rs = rsqrtf(row_ss(SS, row) * (1.f / D) + EPS) * s; bf16_t* rowp = O + (size_t)row * D + col0;
#pragma unroll
                for (int bj = 0; bj < 2; ++bj) { const f32x4 v0 = acc[ai][bj][m][0] * rs, v1 = acc[ai][bj][m][1] * rs;
                    u32x4 w; w.x = cvt_pk_bf16(v0[0], v0[1]); w.y = cvt_pk_bf16(v0[2], v0[3]); w.z = cvt_pk_bf16(v1[0], v1[1]); w.w = cvt_pk_bf16(v1[2], v1[3]);
                    *(u32x4*)(rowp + bj * HALF) = w; } }
    }
};
struct EpiSoftmax {
    static constexpr bool AFTER_DRAIN = true; bf16_t* P;
    __device__ __forceinline__ void operator()(const Acc&, const Unit&, int, int, int, int) const {}
    __device__ __forceinline__ void fused(Acc& acc, const Unit& u, int wr, int wc, int fr, int fq, PG8_LAS unsigned char* lds) const {
        PG8_LAS float* xm = (PG8_LAS float*)lds; PG8_LAS float* xs = xm + 1024;
#pragma unroll
        for (int ai = 0; ai < 2; ++ai)
#pragma unroll
            for (int m = 0; m < 4; ++m) { float mx = -3.0e38f;
#pragma unroll
                for (int bj = 0; bj < 2; ++bj)
#pragma unroll
                    for (int n = 0; n < 2; ++n) { const f32x4 v = acc[ai][bj][m][n]; mx = fmaxf(mx, fmaxf(fmaxf(v[0], v[1]), fmaxf(v[2], v[3]))); }
                mx = fmaxf(mx, __shfl_xor(mx, 16)); mx = fmaxf(mx, __shfl_xor(mx, 32));
                if (fq == 0) xm[(ai * HALF + wr * 64 + m * 16 + fr) * 4 + wc] = mx; }
        __syncthreads();
#pragma unroll
        for (int ai = 0; ai < 2; ++ai)
#pragma unroll
            for (int m = 0; m < 4; ++m) { const int r = ai * HALF + wr * 64 + m * 16 + fr; const f32x4 q = *(const PG8_LAS f32x4*)(xm + r * 4);
                const float mx = fmaxf(fmaxf(q[0], q[1]), fmaxf(q[2], q[3])); float sm = 0.f;
#pragma unroll
                for (int bj = 0; bj < 2; ++bj)
#pragma unroll
                    for (int n = 0; n < 2; ++n) { f32x4 v = acc[ai][bj][m][n]; v[0] = __expf(v[0] - mx); v[1] = __expf(v[1] - mx); v[2] = __expf(v[2] - mx); v[3] = __expf(v[3] - mx);
                        acc[ai][bj][m][n] = v; sm += (v[0] + v[1]) + (v[2] + v[3]); }
                sm += __shfl_xor(sm, 16); sm += __shfl_xor(sm, 32);
                if (fq == 0) xs[r * 4 + wc] = sm; }
        __syncthreads();
        const int row0 = u.pm * BM, col0 = u.pn * BM + wc * 32 + 8 * fq;
#pragma unroll
        for (int ai = 0; ai < 2; ++ai)
#pragma unroll
            for (int m = 0; m < 4; ++m) { const int r = ai * HALF + wr * 64 + m * 16 + fr; const f32x4 q = *(const PG8_LAS f32x4*)(xs + r * 4);
                const float inv = 1.f / ((q[0] + q[1]) + (q[2] + q[3])); bf16_t* rowp = P + (size_t)(row0 + r) * D + col0;
#pragma unroll
                for (int bj = 0; bj < 2; ++bj) { const f32x4 v0 = acc[ai][bj][m][0] * inv, v1 = acc[ai][bj][m][1] * inv;
                    u32x4 w; w.x = cvt_pk_bf16(v0[0], v0[1]); w.y = cvt_pk_bf16(v0[2], v0[3]); w.z = cvt_pk_bf16(v1[0], v1[1]); w.w = cvt_pk_bf16(v1[2], v1[3]);
                    *(u32x4*)(rowp + bj * HALF) = w; } }
        __syncthreads();
    }
};
struct EpiFFN1 {
    static constexpr bool AFTER_DRAIN = false; bf16_t* HID; const float* RSL; const float* bg; const float* bu; const PG8_LAS int* cntl;
    __device__ __forceinline__ void operator()(const Acc& acc, const Unit& u, int wr, int wc, int fr, int fq) const {
        const int cnt = cntl[u.e], c0 = u.pn * HALF + wc * 32 + 8 * fq;
        const f32x4 g0 = *(const f32x4*)(bg + u.e * 1024 + c0), g1 = *(const f32x4*)(bg + u.e * 1024 + c0 + 4), u0 = *(const f32x4*)(bu + u.e * 1024 + c0), u1 = *(const f32x4*)(bu + u.e * 1024 + c0 + 4);
#pragma unroll
        for (int ai = 0; ai < 2; ++ai)
#pragma unroll
            for (int m = 0; m < 4; ++m) { const int r = ai * HALF + wr * 64 + m * 16 + fr, pos = u.j * BM + r; const float rs = pos < cnt ? RSL[u.e * M + pos] : 0.f;
                const f32x4 a0 = acc[ai][0][m][0] * rs + g0, a1 = acc[ai][0][m][1] * rs + g1, b0 = acc[ai][1][m][0] * rs + u0, b1 = acc[ai][1][m][1] * rs + u1;
                u32x4 w; w.x = cvt_pk_bf16(ffn_act(a0[0], b0[0]), ffn_act(a0[1], b0[1])); w.y = cvt_pk_bf16(ffn_act(a0[2], b0[2]), ffn_act(a0[3], b0[3]));
                w.z = cvt_pk_bf16(ffn_act(a1[0], b1[0]), ffn_act(a1[1], b1[1])); w.w = cvt_pk_bf16(ffn_act(a1[2], b1[2]), ffn_act(a1[3], b1[3]));
                *(u32x4*)(HID + (size_t)(u.pm * BM + r) * 1024 + c0) = w; }
    }
};
struct EpiFFN2 {
    static constexpr bool AFTER_DRAIN = false; bf16_t* Y; const int* TOKL; const float* GATEL; const float* bd; const PG8_LAS int* cntl;
    __device__ __forceinline__ void operator()(const Acc& acc, const Unit& u, int wr, int wc, int fr, int fq) const {
        const int cnt = cntl[u.e], c0 = u.pn * BM + wc * 32 + 8 * fq;
        f32x4 bv[2][2];
#pragma unroll
        for (int bj = 0; bj < 2; ++bj) { bv[bj][0] = *(const f32x4*)(bd + u.e * 1024 + c0 + bj * HALF); bv[bj][1] = *(const f32x4*)(bd + u.e * 1024 + c0 + bj * HALF + 4); }
#pragma unroll
        for (int ai = 0; ai < 2; ++ai)
#pragma unroll
            for (int m = 0; m < 4; ++m) { const int r = ai * HALF + wr * 64 + m * 16 + fr, pos = u.j * BM + r;
                if (pos < cnt) { const int dst = TOKL[u.e * M + pos]; const float gt = GATEL[u.e * M + pos]; bf16_t* rowp = Y + (size_t)dst * 1024 + c0;
#pragma unroll
                    for (int bj = 0; bj < 2; ++bj) { const f32x4 v0 = (acc[ai][bj][m][0] + bv[bj][0]) * gt, v1 = (acc[ai][bj][m][1] + bv[bj][1]) * gt;
                        u32x4 w; w.x = cvt_pk_bf16(v0[0], v0[1]); w.y = cvt_pk_bf16(v0[2], v0[3]); w.z = cvt_pk_bf16(v1[0], v1[1]); w.w = cvt_pk_bf16(v1[2], v1[3]);
                        *(u32x4*)(rowp + bj * HALF) = w; } } }
    }
};
template <int NPN, bool IS_FFN1> struct MoeOrder {
    int G, c; const PG8_LAS int* tstart; const PG8_LAS int* cntl; const char* A; const char* W; const int* TOKL; int rep;
    __device__ bool next(int i, Unit& u) const {
        int L = i * G + c; const int nrt = tstart[32]; if (L >= nrt * NPN * rep) return false; L %= nrt * NPN;
        const int rt = L / NPN, pn = L % NPN; int e = 0;
        for (int q = 1; q < 32; ++q) e += (tstart[q] <= rt) ? 1 : 0;
        u.pm = rt; u.pn = pn; u.e = e; u.j = rt - tstart[e];
        if (IS_FFN1) { u.a = A; u.b = W + ((size_t)e * 2048 + (size_t)pn * 256) * 2048; }
        else { u.a = A + (size_t)rt * 256 * 2048; u.b = W + ((size_t)e * 1024 + (size_t)pn * 256) * 2048; }
        return true;
    }
    __device__ __forceinline__ int arow(const Unit& u, int r) const { const int pos = u.j * BM + r; return pos < cntl[u.e] ? (TOKL[u.e * M + pos] >> 2) : 0; }
};
}

#define GAS __attribute__((address_space(1)))
#define LAS __attribute__((address_space(3)))
typedef unsigned v4u __attribute__((ext_vector_type(4)));
typedef float f32x4 __attribute__((ext_vector_type(4)));
typedef GAS unsigned gu32;
typedef __bf16 bf16x2_t __attribute__((ext_vector_type(2)));
typedef float f32x2_t __attribute__((ext_vector_type(2)));
__device__ __forceinline__ unsigned cvtpk_s(float lo, float hi) { f32x2_t v = {lo, hi}; bf16x2_t b = __builtin_convertvector(v, bf16x2_t); return __builtin_bit_cast(unsigned, b); }
typedef short bf16x8 __attribute__((ext_vector_type(8)));
typedef float f32x16 __attribute__((ext_vector_type(16)));
#ifndef NVGPR_CAP
#define NVGPR_CAP 256
#endif
constexpr int NWAVES = 8, NTHR = 512;
constexpr int RING_BYTES = 131072, LDS_BYTES = 163840, LDSCTL_OFF = LDS_BYTES - 512;
constexpr int LW_BAR = 0, LW_TSTART = 16, LW_CNT = 64, LW_NWORDS = 128;
constexpr int CW_BAR = 1024;

#define XB_TMO      128
#define XB_XCNT(j)  (256  + 64 * (j))
#define XB_XSUB(j)  (1280 + 64 * (j))
#define XB_XGEN(j)  (2304 + 64 * (j))
#define XB_TOP      3328
#define XB_TOPGEN   3392
#define XCD_BAR_WORDS 3456
#define XB_SPIN_CAP (1u << 18)
__device__ __forceinline__ unsigned xb_ld(unsigned* p)              { return __hip_atomic_load(p, __ATOMIC_RELAXED, __HIP_MEMORY_SCOPE_AGENT); }
__device__ __forceinline__ unsigned xb_add(unsigned* p, unsigned v) { return __hip_atomic_fetch_add(p, v, __ATOMIC_RELAXED, __HIP_MEMORY_SCOPE_AGENT); }
__device__ __forceinline__ unsigned xb_xcc_id() { return (unsigned)__builtin_amdgcn_s_getreg((3 << 11) | 20) & 0xFu; }
#define XB_SPIN(cond, bar) do { unsigned _sp = 0; while (cond) { __builtin_amdgcn_s_sleep(1); \
    if ((++_sp & 255u) == 0u) { if (xb_ld(&(bar)[XB_TMO])) break; if (_sp > XB_SPIN_CAP) { atomicAdd(&(bar)[XB_TMO], 1u); break; } } } } while (0)
struct XcdBarrier { unsigned* bar; unsigned x; volatile LAS unsigned* st; };
__device__ __forceinline__ XcdBarrier xcd_barrier_post(unsigned* bar, volatile LAS unsigned* st) {
    XcdBarrier b; b.bar = bar; b.x = xb_xcc_id(); b.st = st;
    if (threadIdx.x == 0) (void)xb_add(&bar[XB_XCNT(b.x)], 1u);
    return b;
}
__device__ __forceinline__ void xcd_barrier_complete(unsigned* bar, unsigned x, unsigned& nloc, unsigned& nx) {
    const unsigned G = gridDim.x * gridDim.y * gridDim.z;
    unsigned sum, cnt, mine, sp = 0u;
    for (;;) {
        sum = 0u; cnt = 0u; mine = 0u;
#pragma unroll
        for (unsigned j = 0; j < 16; ++j) { const unsigned c = xb_ld(&bar[XB_XCNT(j)]); sum += c; cnt += (c > 0u) ? 1u : 0u; mine = (j == x) ? c : mine; }
        if (sum == G) break;
        __builtin_amdgcn_s_sleep(1);
        if ((++sp & 255u) == 0u) { if (xb_ld(&bar[XB_TMO])) break; if (sp > XB_SPIN_CAP) { atomicAdd(&bar[XB_TMO], 1u); break; } }
    }
    nloc = mine > 0u ? mine : 1u; nx = cnt > 0u ? cnt : 1u;
}
__device__ __forceinline__ void xcd_barrier(const XcdBarrier& b) {
    asm volatile("s_waitcnt vmcnt(0)" ::: "memory");
    __syncthreads();
    if (threadIdx.x == 0) {
        unsigned* bar = b.bar;
        __builtin_amdgcn_s_waitcnt(0);
        unsigned nloc = b.st[0], nx = b.st[1];
        if (nloc == 0u) { xcd_barrier_complete(bar, b.x, nloc, nx); b.st[0] = nloc; b.st[1] = nx; }
        const unsigned old = xb_add(&bar[XB_XSUB(b.x)], 1u);
        const unsigned gen = old / nloc;
        if (old + 1u == (gen + 1u) * nloc) {
            __builtin_amdgcn_fence(__ATOMIC_RELEASE, "agent");
            asm volatile("s_waitcnt vmcnt(0)" ::: "memory");
            const unsigned og = xb_add(&bar[XB_TOP], 1u);
            const unsigned tg = og / nx;
            if (og + 1u == (tg + 1u) * nx) xb_add(&bar[XB_TOPGEN], 1u);
            else XB_SPIN(xb_ld(&bar[XB_TOPGEN]) == tg, bar);
            __builtin_amdgcn_fence(__ATOMIC_ACQUIRE, "agent");
            xb_add(&bar[XB_XGEN(b.x)], 1u);
            asm volatile("s_waitcnt vmcnt(0)" ::: "memory");
        } else {
            XB_SPIN(xb_ld(&bar[XB_XGEN(b.x)]) == gen, bar);
            __builtin_amdgcn_fence(__ATOMIC_ACQUIRE, "agent");
            asm volatile("s_waitcnt vmcnt(0)" ::: "memory");
        }
    }
    __syncthreads();
}

struct Args { const float* in[31]; float* out; unsigned char* ws; int ph_lo, ph_hi, bli, pad; };

#define LDS_WAIT() asm volatile("s_waitcnt lgkmcnt(0)" ::: "memory")
#define LDS_BARRIER() do { asm volatile("s_waitcnt lgkmcnt(0)" ::: "memory"); __builtin_amdgcn_s_barrier(); asm volatile("" ::: "memory"); } while (0)
__device__ __forceinline__ unsigned pk2(float lo, float hi) { return (unsigned)f2bf(lo) | ((unsigned)f2bf(hi) << 16); }
__device__ __forceinline__ void transpose_item(const float* W, int ldn, int col0, int k0, bf16* dst, int pitch, const float* gain, LAS float* scr, int lane) {
#pragma unroll 8
    for (int i = 0; i < 32; ++i) { const int kk = 2 * i + (lane >> 5); float v = W[(size_t)(k0 + kk) * ldn + col0 + (lane & 31)]; if (gain) v *= gain[k0 + kk]; scr[kk * 33 + (lane & 31)] = v; }
    LDS_WAIT(); asm volatile("" ::: "memory");
    const int c = lane & 7;
#pragma unroll
    for (int j = 0; j < 4; ++j) { const int n = (lane >> 3) + 8 * j; const LAS float* s = scr + (8 * c) * 33 + n;
        v4u o; o.x = pk2(s[0 * 33], s[1 * 33]); o.y = pk2(s[2 * 33], s[3 * 33]); o.z = pk2(s[4 * 33], s[5 * 33]); o.w = pk2(s[6 * 33], s[7 * 33]);
        *(GAS v4u*)(dst + (size_t)n * pitch + k0 + 8 * c) = o; }
    LDS_WAIT(); asm volatile("" ::: "memory");
}

__device__ __forceinline__ const float* arg_in(const Args& a, int k) { asm volatile("" : "+s"(k)); return a.in[k]; }
#define INP(k) arg_in(args, k)
#define PHASE_PTRS unsigned char* wsl = args.ws; asm volatile("" : "+s"(wsl)); float* out = args.out; asm volatile("" : "+s"(out)); unsigned* ctl = (unsigned*)(wsl + WS_CTL); const float *x = INP(0), *mem = INP(1), *norm_mix = INP(2), *w_in = INP(3), *w_out = INP(15), *norm_cross = INP(16), *norm_mem = INP(17), *w_cq = INP(18), *w_ckv = INP(19), *w_co = INP(20); const float *norm_moe = INP(21), *w_router = INP(22), *w_gate = INP(24), *b_gate = INP(25), *w_up = INP(26), *b_up = INP(27), *w_down = INP(28), *b_down = INP(29), *norm_final = INP(30); float* ss1 = (float*)(wsl + WS_SSP1); float* ss2 = (float*)(wsl + WS_SSP2); bf16 *Win_t = (bf16*)(wsl + WS_WIN), *Wout_t = (bf16*)(wsl + WS_WOUT), *Wcq_t = (bf16*)(wsl + WS_WCQ), *Wckv_t = (bf16*)(wsl + WS_WCKV), *Wco_t = (bf16*)(wsl + WS_WCO), *Wgu_t = (bf16*)(wsl + WS_WGU), *Wd_t = (bf16*)(wsl + WS_WD); bf16 *XN = (bf16*)(wsl + WS_XN), *MIX = XN, *HB2 = XN, *PROJ = (bf16*)(wsl + WS_PROJ), *HB = (bf16*)(wsl + WS_HB), *Qb = (bf16*)(wsl + WS_Q), *Pb = (bf16*)(wsl + WS_P), *HID = (bf16*)(wsl + WS_HID); bf16 *O2 = (bf16*)(wsl + WS_O2), *Y = (bf16*)(wsl + WS_Y), *MEMN = (bf16*)(wsl + WS_MEMN), *KM = (bf16*)(wsl + WS_KM), *VT = (bf16*)(wsl + WS_VT); const float *dn_conv = INP(4), *dn_a_log = INP(5), *dn_dt_bias = INP(6), *dn_norm = INP(7), *rg_conv = INP(8), *rg_conv_b = INP(9); const float *rg_w_a = INP(10), *rg_b_a = INP(11), *rg_w_x = INP(12), *rg_b_x = INP(13), *rg_lambda = INP(14), *b_router = INP(23); float* QKVN = (float*)(wsl + WS_QKVN); float* ODN = (float*)(wsl + WS_ODN); float* BAf = (float*)(wsl + WS_BA); float* AA = out; float* BX = out + (size_t)M * 512; const int* TOKL = (const int*)(wsl + WS_TOKL); const float* GATEL = (const float*)(wsl + WS_GATEL); const float* RSL = (const float*)(wsl + WS_RSL); (void)ctl;
template <bool NT = false> __device__ __forceinline__ void transpose_item64(const float* W, int ldn, int col0, int k0, bf16* dst, int pitch, const float* gain, LAS float* scr, int lane) {
    f32x4 v[16];
#pragma unroll
    for (int i = 0; i < 16; ++i) { const int kk = (lane >> 4) + 4 * i; const f32x4* p = (const f32x4*)(W + (size_t)(k0 + kk) * ldn + col0 + 4 * (lane & 15)); v[i] = NT ? __builtin_nontemporal_load(p) : *p; }
#pragma unroll
    for (int i = 0; i < 16; ++i) { const int kk = (lane >> 4) + 4 * i; f32x4 w = v[i]; if (gain) w = w * gain[k0 + kk]; LAS float* p = scr + kk * 65 + 4 * (lane & 15); p[0] = w[0]; p[1] = w[1]; p[2] = w[2]; p[3] = w[3]; }
    LDS_WAIT(); asm volatile("" ::: "memory");
    const int c = lane & 7;
#pragma unroll
    for (int j = 0; j < 8; ++j) { const int n = (lane >> 3) + 8 * j; const LAS float* sp = scr + (8 * c) * 65 + n;
        v4u o; o.x = pk2(sp[0 * 65], sp[1 * 65]); o.y = pk2(sp[2 * 65], sp[3 * 65]); o.z = pk2(sp[4 * 65], sp[5 * 65]); o.w = pk2(sp[6 * 65], sp[7 * 65]);
        GAS v4u* q = (GAS v4u*)(dst + (size_t)n * pitch + k0 + 8 * c); if (NT) __builtin_nontemporal_store(o, q); else *q = o; }
    LDS_WAIT(); asm volatile("" ::: "memory");
}
__global__ void __launch_bounds__(NTHR, 2) mk_fwd(Args args) {
    extern __shared__ __attribute__((aligned(16))) unsigned char lds_raw[];
    LAS unsigned char* lds = (LAS unsigned char*)lds_raw;
    volatile LAS unsigned* LW = (volatile LAS unsigned*)(lds + LDSCTL_OFF);
    const int tid = threadIdx.x, lane = tid & 63, wave = __builtin_amdgcn_readfirstlane(tid >> 6), G = gridDim.x, bx = blockIdx.x;
    for (int u = tid; u < LW_NWORDS; u += NTHR) LW[u] = 0u;
    __syncthreads();
    XcdBarrier bar = xcd_barrier_post((unsigned*)(args.ws + WS_CTL) + CW_BAR + args.bli * XCD_BAR_WORDS, LW + LW_BAR);
    const int lo = args.ph_lo, hi = args.ph_hi;
#define STAMP(k) do { if (TS_LO >= 0 && blockIdx.x == 0 && threadIdx.x == 0) { unsigned char* w_ = args.ws; asm volatile("" : "+s"(w_)); __hip_atomic_store((unsigned long long*)(w_ + WS_TS) + (k), __builtin_amdgcn_s_memrealtime(), __ATOMIC_RELAXED, __HIP_MEMORY_SCOPE_AGENT); } } while (0)
    STAMP(0);
#ifndef DOUBLE_PHASE
#define DOUBLE_PHASE -1
#endif
#define REPS(k) ((DOUBLE_PHASE == (k)) ? 2 : 1)
#ifndef SKIPMASK
#define SKIPMASK 0
#endif
#define IN(k) (!((SKIPMASK >> (k)) & 1) && lo <= (k) && (k) < hi)
#define SEAM(k) do { if (IN(k) && IN((k) + 1)) xcd_barrier(bar); } while (0)
    const int gw = bx * NWAVES + wave, NGW = G * NWAVES;

    if (IN(0)) {
        PHASE_PTRS
        LAS float* w8 = (LAS float*)lds;
        for (int i = tid; i < D * 8; i += NTHR) w8[(i & 7) * D + (i >> 3)] = w_in[(size_t)(i >> 3) * NIN + 2048 + (i & 7)];
        __syncthreads();
        float* BA = (float*)(wsl + WS_BA);
        for (int rp = gw; rp < M / 2; rp += NGW) {
            f32x4 v[2][4]; float ssq[2];
#pragma unroll
            for (int r2 = 0; r2 < 2; ++r2)
#pragma unroll
                for (int j = 0; j < 4; ++j) v[r2][j] = *(const f32x4*)(x + (size_t)(2 * rp + r2) * D + 4 * lane + 256 * j);
#pragma unroll
            for (int r2 = 0; r2 < 2; ++r2) { float sq = 0.f;
#pragma unroll
                for (int j = 0; j < 4; ++j) sq += (v[r2][j][0] * v[r2][j][0] + v[r2][j][1] * v[r2][j][1]) + (v[r2][j][2] * v[r2][j][2] + v[r2][j][3] * v[r2][j][3]);
                ssq[r2] = sq; }
#pragma unroll
            for (int r2 = 0; r2 < 2; ++r2) { const int row = 2 * rp + r2; const float rstd = rsqrtf(wave_sum(ssq[r2]) * (1.f / D) + EPS); bf16* orow = XN + (size_t)row * D; float acc[8];
#pragma unroll
                for (int q = 0; q < 8; ++q) acc[q] = 0.f;
#pragma unroll
                for (int j = 0; j < 4; ++j) { const f32x4 gg = *(const f32x4*)(norm_mix + 4 * lane + 256 * j); const f32x4 u = v[r2][j] * rstd * gg;
                    *(unsigned long long*)(orow + 4 * lane + 256 * j) = (unsigned long long)pk2(u[0], u[1]) | ((unsigned long long)pk2(u[2], u[3]) << 32);
#pragma unroll
                    for (int q = 0; q < 8; ++q) { const f32x4 wq = *(const LAS f32x4*)(w8 + q * D + 4 * lane + 256 * j); acc[q] += (u[0] * wq[0] + u[1] * wq[1]) + (u[2] * wq[2] + u[3] * wq[3]); } }
#pragma unroll
                for (int q = 0; q < 8; ++q) { const float t = wave_sum(acc[q]); if (lane == q) BA[(size_t)row * 8 + q] = t; } }
        }
        for (int row = gw; row < NB * MEML; row += NGW) { const float* xr = mem + (size_t)row * D; bf16* orow = MEMN + (size_t)row * D; f32x4 v[4]; float sq = 0.f;
#pragma unroll
            for (int j = 0; j < 4; ++j) { v[j] = *(const f32x4*)(xr + 4 * lane + 256 * j); sq += (v[j][0] * v[j][0] + v[j][1] * v[j][1]) + (v[j][2] * v[j][2] + v[j][3] * v[j][3]); }
            const float rstd = rsqrtf(wave_sum(sq) * (1.f / D) + EPS);
#pragma unroll
            for (int j = 0; j < 4; ++j) { const f32x4 gg = *(const f32x4*)(norm_mem + 4 * lane + 256 * j); const f32x4 u = v[j] * rstd * gg;
                *(unsigned long long*)(orow + 4 * lane + 256 * j) = (unsigned long long)pk2(u[0], u[1]) | ((unsigned long long)pk2(u[2], u[3]) << 32); } }
        __syncthreads();
        { LAS float* scr = (LAS float*)(lds + wave * 16640);
          constexpr int I_IN = 16 * 48, I_SQ = 16 * 16, I_KV = 16 * 32;
          constexpr int NIT = I_IN + 3 * I_SQ + I_KV + 16;
          for (int it = NGW - 1 - gw; it < NIT; it += NGW) {
            int r = it;
            if (r < I_IN) { const int kb = r / 48, nb = r % 48, n0 = nb * 64; transpose_item64(w_in, NIN, n0 < 2048 ? n0 : n0 + 8, kb * 64, Win_t + (size_t)n0 * D, D, nullptr, scr, lane); continue; } r -= I_IN;
            if (r < I_SQ) { const int kb = r / 16, nb = r % 16; transpose_item64(w_out, D, nb * 64, kb * 64, Wout_t + (size_t)nb * 64 * D, D, nullptr, scr, lane); continue; } r -= I_SQ;
            if (r < I_SQ) { const int kb = r / 16, nb = r % 16; transpose_item64(w_cq, D, nb * 64, kb * 64, Wcq_t + (size_t)nb * 64 * D, D, norm_cross, scr, lane); continue; } r -= I_SQ;
            if (r < I_SQ) { const int kb = r / 16, nb = r % 16; transpose_item64(w_co, D, nb * 64, kb * 64, Wco_t + (size_t)nb * 64 * D, D, nullptr, scr, lane); continue; } r -= I_SQ;
            if (r < I_KV) { const int kb = r / 32, nb = r % 32; transpose_item64(w_ckv, 2048, nb * 64, kb * 64, Wckv_t + (size_t)nb * 64 * D, D, nullptr, scr, lane); continue; } r -= I_KV;
            { const int mat = r >> 1, kb = r & 1, gate = mat >> 2, nbk = mat & 3;
              transpose_item64((gate ? rg_w_x : rg_w_a) + (size_t)nbk * 128 * 128, 128, 0, kb * 64, (bf16*)(wsl + WS_RGW) + (size_t)mat * 128 * 128, 128, nullptr, scr, lane);
              transpose_item64((gate ? rg_w_x : rg_w_a) + (size_t)nbk * 128 * 128, 128, 64, kb * 64, (bf16*)(wsl + WS_RGW) + ((size_t)mat * 128 + 64) * 128, 128, nullptr, scr, lane); }
          }
          bf16* WRh = (bf16*)(wsl + WS_WR); bf16* WRl = WRh + NE * D;
          for (int i = bx * NTHR + tid; i < NE * D; i += G * NTHR) { const int e = i >> 10, k = i & 1023; const float v = w_router[k * NE + e] * norm_moe[k]; const bf16 hv = f2bf(v); WRh[i] = hv; WRl[i] = f2bf(v - bf2f(hv)); } }
    }
    SEAM(0);
    STAMP(1);
    if (IN(1)) {
        PHASE_PTRS
        { pg8::Gemm g{D, D, D}; pg8::StaticOrder S; S.init(XN, Win_t, M, NP, D, D, G, bx); S.rep = REPS(1); pg8::EpiStore E{PROJ, NP};
          pg8::gemm_phase<pg8::EpiStore, pg8::StaticOrder, true, false>(lds, g, S, E); }
    }
    SEAM(1);
    STAMP(2);
    if (IN(2)) {
        PHASE_PTRS
        for (int unit_ = bx; unit_ < NB * 64 * REPS(2); unit_ += G) { const int unit = unit_ & 255;
            const int b = unit >> 6, n = unit & 63; const size_t row0 = (size_t)b * T + n * 64;
            for (int itp = 0; itp < 2; ++itp) {
                const int half = __builtin_amdgcn_readfirstlane(tid >> 8), ht = tid & 255, hw = wave & 3, h = itp * 2 + half;
                LAS unsigned char* HL = lds + half * 53248;
                LAS bf16* QN = (LAS bf16*)HL; LAS bf16* KN = (LAS bf16*)(HL + 17408); LAS float* AL = (LAS float*)(HL + 34816); LAS float* GC = (LAS float*)(HL + 52224); LAS float* BT = GC + 64;
                unsigned char* ub = wsl + WS_DN + (size_t)((b * 4 + h) * 64 + n) * DNU_BYTES;
                if (hw == 0) { int lanev = lane; asm volatile("" : "+v"(lanev)); const size_t row = row0 + lanev; const float beta = sigmoidf_(BAf[row * 8 + h]); float gv = -__expf(dn_a_log[h]) * softplusf_(BAf[row * 8 + 4 + h] + dn_dt_bias[h]);
#pragma unroll
                    for (int o = 1; o < 64; o <<= 1) { const float tv = __shfl_up(gv, o); if (lanev >= o) gv += tv; }
                    GC[lanev] = gv; BT[lanev] = beta; }
                { const int gch = ht & 15;
#pragma unroll
                  for (int tensor = 0; tensor < 2; ++tensor) { const int cb = tensor * 512 + h * 128 + gch * 8; float wv[4][8];
#pragma unroll
                    for (int j = 0; j < 4; ++j) { const f32x4 w0 = *(const f32x4*)(dn_conv + j * 1536 + cb), w1 = *(const f32x4*)(dn_conv + j * 1536 + cb + 4);
                        wv[j][0] = w0[0]; wv[j][1] = w0[1]; wv[j][2] = w0[2]; wv[j][3] = w0[3]; wv[j][4] = w1[0]; wv[j][5] = w1[1]; wv[j][6] = w1[2]; wv[j][7] = w1[3]; }
#pragma unroll
                    for (int ii = 0; ii < 4; ++ii) { const int c = (ht >> 4) + 16 * ii, t = n * 64 + c; float a8[8];
#pragma unroll
                        for (int e = 0; e < 8; ++e) a8[e] = 0.f;
                        v4u prv[4];
#pragma unroll
                        for (int j = 0; j < 4; ++j) { const int tt = t + j - 3; prv[j] = *(const v4u*)(PROJ + ((size_t)b * T + (tt < 0 ? 0 : tt)) * NP + cb); }
#pragma unroll
                        for (int j = 0; j < 4; ++j) { const float m = (t + j - 3 >= 0) ? 1.f : 0.f;
#pragma unroll
                                for (int e = 0; e < 4; ++e) { a8[2 * e] += wv[j][2 * e] * m * bf2f((bf16)(prv[j][e] & 0xffff)); a8[2 * e + 1] += wv[j][2 * e + 1] * m * bf2f((bf16)(prv[j][e] >> 16)); } }
                        float ssq = 0.f;
#pragma unroll
                        for (int e = 0; e < 8; ++e) { a8[e] = siluf_(a8[e]); ssq += a8[e] * a8[e]; }
                        ssq += __shfl_xor(ssq, 1); ssq += __shfl_xor(ssq, 2); ssq += __shfl_xor(ssq, 4); ssq += __shfl_xor(ssq, 8);
                        const float rn = rsqrtf(ssq + EPS); v4u o; o.x = pk2(a8[0] * rn, a8[1] * rn); o.y = pk2(a8[2] * rn, a8[3] * rn); o.z = pk2(a8[4] * rn, a8[5] * rn); o.w = pk2(a8[6] * rn, a8[7] * rn);
                        *(LAS v4u*)((tensor ? KN : QN) + c * 136 + gch * 8) = o; } } }
                LDS_BARRIER();
                if (hw < 3) { const int ci = hw == 0 ? 0 : 1, si = hw == 2 ? 1 : 0; int l31 = lane & 31, hh = lane >> 5; asm volatile("" : "+v"(l31), "+v"(hh)); f32x16 kk, qk;
#pragma unroll
                    for (int r = 0; r < 16; ++r) { kk[r] = 0.f; qk[r] = 0.f; }
#pragma unroll
                    for (int ks = 0; ks < 8; ++ks) { const bf16x8 ak = *(const LAS bf16x8*)(KN + (32 * ci + l31) * 136 + 16 * ks + 8 * hh), aq = *(const LAS bf16x8*)(QN + (32 * ci + l31) * 136 + 16 * ks + 8 * hh);
                        const bf16x8 bk = *(const LAS bf16x8*)(KN + (32 * si + l31) * 136 + 16 * ks + 8 * hh);
                        kk = __builtin_amdgcn_mfma_f32_32x32x16_bf16(ak, bk, kk, 0, 0, 0); qk = __builtin_amdgcn_mfma_f32_32x32x16_bf16(aq, bk, qk, 0, 0, 0); }
                    const int sc = 32 * si + l31; const float gs = GC[sc]; bf16* QKg = (bf16*)(ub + DNU_QK);
#pragma unroll
                    for (int r = 0; r < 16; ++r) { const int c = 32 * ci + (r & 3) + 8 * (r >> 2) + 4 * hh; const float dec = c >= sc ? __expf(GC[c] - gs) : 0.f;
                        AL[c * 68 + sc] = c > sc ? BT[c] * kk[r] * dec : 0.f; QKg[c * 64 + kperm(sc)] = f2bf(qk[r] * 0.08838834764831845f * dec); } }
                LDS_BARRIER();
                { float xs[64];
                  if (ht < 128) { const int cv = PC_V + h * 128 + ht; const float w0 = dn_conv[cv], w1 = dn_conv[1536 + cv], w2 = dn_conv[2 * 1536 + cv], w3 = dn_conv[3 * 1536 + cv];
                      float p3 = 0.f, p2 = 0.f, p1 = 0.f; if (n > 0) { p3 = bf2f(PROJ[(row0 - 3) * NP + cv]); p2 = bf2f(PROJ[(row0 - 2) * NP + cv]); p1 = bf2f(PROJ[(row0 - 1) * NP + cv]); }
                      const bf16* pp = PROJ + row0 * NP + cv;
#pragma unroll
                      for (int c = 0; c < 64; ++c) { xs[c] = bf2f(*pp); pp += NP; asm volatile("" : "+v"(pp)); }
#pragma unroll
                      for (int c = 0; c < 64; ++c) { const float cu = xs[c]; xs[c] = siluf_(w0 * p3 + w1 * p2 + w2 * p1 + w3 * cu) * BT[c]; p3 = p2; p2 = p1; p1 = cu; } }
                  else { const int dk = ht - 128;
#pragma unroll
                      for (int c = 0; c < 64; ++c) xs[c] = bf2f(KN[c * 136 + dk]) * BT[c] * __expf(GC[c]); }
#pragma unroll
                  for (int i = 1; i < 64; ++i) { float pa[4] = {0.f, 0.f, 0.f, 0.f};
#pragma unroll
                      for (int j = 0; j < i; ++j) pa[j & 3] += AL[i * 68 + j] * xs[j];
                      xs[i] -= (pa[0] + pa[1]) + (pa[2] + pa[3]); }
                  if (ht < 128) { bf16* UT = (bf16*)(ub + DNU_UT) + ht * 64;
#pragma unroll
                      for (int c8 = 0; c8 < 8; ++c8) { v4u o; o.x = pk2(xs[8 * c8], xs[8 * c8 + 1]); o.y = pk2(xs[8 * c8 + 2], xs[8 * c8 + 3]); o.z = pk2(xs[8 * c8 + 4], xs[8 * c8 + 5]); o.w = pk2(xs[8 * c8 + 6], xs[8 * c8 + 7]); *(v4u*)(UT + 8 * c8) = o; } }
                  else { bf16* Wn = (bf16*)(ub + DNU_WN) + kperm(ht - 128);
#pragma unroll
                      for (int c = 0; c < 64; ++c) { *Wn = f2bf(-xs[c]); Wn += 128; asm volatile("" : "+v"(Wn)); } } }
                { const int c = ht >> 2, d0 = (ht & 3) * 32; const float sc = 0.08838834764831845f * __expf(GC[c]); bf16* Qg = (bf16*)(ub + DNU_QG);
#pragma unroll
                  for (int q = 0; q < 4; ++q) { v4u o;
#pragma unroll
                      for (int e = 0; e < 4; ++e) { const int p0 = d0 + 8 * q + 2 * e; o[e] = pk2(bf2f(QN[c * 136 + kperm(p0)]) * sc, bf2f(QN[c * 136 + kperm(p0 + 1)]) * sc); }
                      *(v4u*)(Qg + c * 128 + d0 + 8 * q) = o; }
                  const int dk = ht >> 1, c0 = (ht & 1) * 32; const float gl = GC[63]; bf16* KdT = (bf16*)(ub + DNU_KDT);
#pragma unroll
                  for (int q = 0; q < 4; ++q) { v4u o;
#pragma unroll
                      for (int e = 0; e < 4; ++e) { const int ca = kperm(c0 + 8 * q + 2 * e), cb2 = kperm(c0 + 8 * q + 2 * e + 1); o[e] = pk2(bf2f(KN[ca * 136 + dk]) * __expf(gl - GC[ca]), bf2f(KN[cb2 * 136 + dk]) * __expf(gl - GC[cb2])); }
                      *(v4u*)(KdT + dk * 64 + c0 + 8 * q) = o; }
                  if (ht == 0) ((float*)(wsl + WS_DEC))[(b * 4 + h) * 64 + n] = __expf(gl); }
                LDS_BARRIER();
            }
            { LAS bf16* XRb = (LAS bf16*)lds; LAS unsigned* RI = (LAS unsigned*)(lds + 17408); const bf16* RGW = (const bf16*)(wsl + WS_RGW);
              for (int nbk = 0; nbk < 4; ++nbk) {
#pragma unroll
                for (int ii = 0; ii < 2; ++ii) { const int gch = tid & 15, c = (tid >> 4) + 32 * ii, t = n * 64 + c, cb = nbk * 128 + gch * 8; float a8[8];
                    { const f32x4 b0 = *(const f32x4*)(rg_conv_b + cb), b1 = *(const f32x4*)(rg_conv_b + cb + 4); a8[0] = b0[0]; a8[1] = b0[1]; a8[2] = b0[2]; a8[3] = b0[3]; a8[4] = b1[0]; a8[5] = b1[1]; a8[6] = b1[2]; a8[7] = b1[3]; }
#pragma unroll
                    for (int j = 0; j < 4; ++j) { const int tt = t + j - 3; const float m = tt >= 0 ? 1.f : 0.f; { const v4u pr = *(const v4u*)(PROJ + ((size_t)b * T + (tt < 0 ? 0 : tt)) * NP + PC_RX + cb); const f32x4 w0 = *(const f32x4*)(rg_conv + j * 512 + cb) * m, w1 = *(const f32x4*)(rg_conv + j * 512 + cb + 4) * m;
                            a8[0] += w0[0] * bf2f((bf16)(pr[0] & 0xffff)); a8[1] += w0[1] * bf2f((bf16)(pr[0] >> 16)); a8[2] += w0[2] * bf2f((bf16)(pr[1] & 0xffff)); a8[3] += w0[3] * bf2f((bf16)(pr[1] >> 16));
                            a8[4] += w1[0] * bf2f((bf16)(pr[2] & 0xffff)); a8[5] += w1[1] * bf2f((bf16)(pr[2] >> 16)); a8[6] += w1[2] * bf2f((bf16)(pr[3] & 0xffff)); a8[7] += w1[3] * bf2f((bf16)(pr[3] >> 16)); } }
                    v4u o; o.x = pk2(a8[0], a8[1]); o.y = pk2(a8[2], a8[3]); o.z = pk2(a8[4], a8[5]); o.w = pk2(a8[6], a8[7]); *(LAS v4u*)(XRb + c * 136 + gch * 8) = o; }
                LDS_BARRIER();
                { const int gate = wave >> 2, ot = wave & 3, l31 = lane & 31, hh = lane >> 5, outc = 32 * ot + l31, ch = nbk * 128 + outc; f32x16 ac[2];
#pragma unroll
                  for (int r = 0; r < 16; ++r) { ac[0][r] = 0.f; ac[1][r] = 0.f; }
                  const bf16* wrow = RGW + ((size_t)(gate * 4 + nbk) * 128 + outc) * 128 + 8 * hh;
#pragma unroll
                  for (int ks = 0; ks < 8; ++ks) { const bf16x8 bw = *(const bf16x8*)(wrow + 16 * ks);
#pragma unroll
                      for (int mt = 0; mt < 2; ++mt) ac[mt] = __builtin_amdgcn_mfma_f32_32x32x16_bf16(*(const LAS bf16x8*)(XRb + (32 * mt + l31) * 136 + 16 * ks + 8 * hh), bw, ac[mt], 0, 0, 0); }
                  const float bias = gate ? rg_b_x[ch] : rg_b_a[ch]; LAS bf16* RIh = (LAS bf16*)RI;
#pragma unroll
                  for (int mt = 0; mt < 2; ++mt)
#pragma unroll
                      for (int r = 0; r < 16; ++r) { const int c = 32 * mt + (r & 3) + 8 * (r >> 2) + 4 * hh; float v = sigmoidf_(ac[mt][r] + bias); if (gate) v *= bf2f(XRb[c * 136 + outc]);
                          RIh[(c * 516 + ch) * 2 + gate] = f2bf(v); } }
                LDS_BARRIER();
              }
              { const int ch = tid; const float lsl = -softplusf_(-rg_lambda[ch]); float hs = 0.f, cp = 1.f; bf16* HL = (bf16*)(wsl + WS_HLOC) + row0 * 512 + ch; bf16* CPg = (bf16*)(wsl + WS_CP) + row0 * 512 + ch;
#pragma unroll 4
                for (int c = 0; c < 64; ++c) { const unsigned w = RI[c * 516 + ch]; const float r = bf2f((bf16)(w & 0xffff)), ix = bf2f((bf16)(w >> 16)), a = __expf(8.f * r * lsl);
                    const float mult = (n == 0 && c == 0) ? 1.f : sqrtf(fmaxf(1.f - a * a, 0.f)); hs = a * hs + mult * ix; cp *= a; *HL = f2bf(hs); *CPg = f2bf(cp); HL += 512; CPg += 512; asm volatile("" : "+v"(HL), "+v"(CPg)); }
                float* SUM = (float*)(wsl + WS_RGSUM); SUM[(size_t)(b * 64 + n) * 512 + ch] = cp; SUM[(size_t)(256 + b * 64 + n) * 512 + ch] = hs; }
              LDS_BARRIER();
            }
        }
    }
    SEAM(2);
    STAMP(3);
    if (IN(3)) {
        PHASE_PTRS
        if (bx < 16) {
            const int b = bx >> 2, h = bx & 3, l31 = lane & 31, hh = lane >> 5, sl = wave;
            const unsigned char* ubase = wsl + WS_DN + (size_t)((b * 4 + h) * 64) * DNU_BYTES; const float* DECp = (const float*)(wsl + WS_DEC) + (b * 4 + h) * 64;
            unsigned a256[8], a128[4];
#pragma unroll
            for (int ks = 0; ks < 8; ++ks) a256[ks] = (unsigned)(l31 * 256 + 16 * ((2 * ks + hh) ^ (l31 & 15)));
#pragma unroll
            for (int ks = 0; ks < 4; ++ks) a128[ks] = (unsigned)(l31 * 128 + 16 * ((2 * ks + hh) ^ ((l31 >> 1) & 7)));
            const unsigned t7 = (unsigned)((l31 >> 1) & 7), utrow = (unsigned)((32 * (sl & 3) + l31) * 128 + 8 * hh);
            const int lw = wave & 3;
            v4u R0[18], R1[18];
#define DN_LD(R, nn) do { const unsigned char* _g = ubase + (size_t)(nn) * DNU_BYTES + lw * 1024 + lane * 16; _Pragma("unroll") for (int _i = 0; _i < 18; ++_i) { \
                asm volatile("global_load_dwordx4 %0, %1, off" : "=v"(R[_i]) : "v"(_g) : "memory"); _g += 4096; asm volatile("" : "+v"(_g)); } } while (0)
#define DN_LWAIT(R, cnt) asm volatile("s_waitcnt vmcnt(" #cnt ")" : "+v"(R[0]), "+v"(R[1]), "+v"(R[2]), "+v"(R[3]), "+v"(R[4]), "+v"(R[5]), "+v"(R[6]), "+v"(R[7]), "+v"(R[8]), "+v"(R[9]), \
                "+v"(R[10]), "+v"(R[11]), "+v"(R[12]), "+v"(R[13]), "+v"(R[14]), "+v"(R[15]), "+v"(R[16]), "+v"(R[17]) :: "memory")
#define DN_WR(R, buf) do { int _lv = lane; asm volatile("" : "+v"(_lv)); _Pragma("unroll") for (int _i = 0; _i < 18; ++_i) { const int _p = lw + 4 * _i, _q = _p * 64 + _lv; int _slot; \
                if (_i < 8) { const int _r = _q >> 4; _slot = _r * 16 + ((_q & 15) ^ (_r & 15)); } else { const int _r = _q >> 3; _slot = _r * 8 + ((_q & 7) ^ ((_r >> 1) & 7)); } \
                *(LAS v4u*)(lds + (buf) * DNU_BYTES + _slot * 16) = R[_i]; } } while (0)
            f32x16 S[4];
#pragma unroll
            for (int t = 0; t < 4; ++t)
#pragma unroll
                for (int r = 0; r < 16; ++r) S[t][r] = 0.f;
            const float decv = DECp[lane];
#define DN_FADDR(i) ((i) < 16 ? (L + DNU_WN + ((i) & 1) * 8192 + a256[(i) >> 1]) : (i) < 32 ? (L + DNU_QG + (((i) - 16) & 1) * 8192 + a256[((i) - 16) >> 1]) : \
                     (i) < 48 ? (L + DNU_KDT + (((i) - 32) >> 2) * 4096 + a128[((i) - 32) & 3]) : ((i) < 50 ? (L + DNU_QK + a128[(i) - 48]) : (L + DNU_QK + 4096 + a128[(i) - 50])))
#define DN_COMPUTE(n) do { constexpr int FD = 6; \
                    const LAS unsigned char* L = lds + ((n) & 1) * DNU_BYTES; const float dcy = __builtin_bit_cast(float, __builtin_amdgcn_readlane(__builtin_bit_cast(int, decv), (n))); const size_t row0 = (size_t)b * T + (n) * 64; \
                    bf16x8 fr[8]; \
                    _Pragma("unroll") for (int i = 0; i < FD; ++i) fr[i] = *(const LAS bf16x8*)DN_FADDR(i); \
                    bf16x8 Sb[8]; \
                    _Pragma("unroll") for (int t = 0; t < 4; ++t) _Pragma("unroll") for (int s2 = 0; s2 < 2; ++s2) { v4u w; w.x = cvtpk_s(S[t][8 * s2], S[t][8 * s2 + 1]); w.y = cvtpk_s(S[t][8 * s2 + 2], S[t][8 * s2 + 3]); \
                            w.z = cvtpk_s(S[t][8 * s2 + 4], S[t][8 * s2 + 5]); w.w = cvtpk_s(S[t][8 * s2 + 6], S[t][8 * s2 + 7]); Sb[2 * t + s2] = __builtin_bit_cast(bf16x8, w); } \
                    f32x16 VN[2], O[2]; \
                    _Pragma("unroll") for (int mt = 0; mt < 2; ++mt) _Pragma("unroll") for (int g4 = 0; g4 < 4; ++g4) { const unsigned long long uu = *(const LAS unsigned long long*)(L + DNU_UT + utrow + 16 * ((unsigned)(4 * mt + g4) ^ t7)); \
                            VN[mt][4 * g4] = bf2f((bf16)(uu & 0xffff)); VN[mt][4 * g4 + 1] = bf2f((bf16)((uu >> 16) & 0xffff)); VN[mt][4 * g4 + 2] = bf2f((bf16)((uu >> 32) & 0xffff)); VN[mt][4 * g4 + 3] = bf2f((bf16)(uu >> 48)); } \
                    _Pragma("unroll") for (int r = 0; r < 16; ++r) { O[0][r] = 0.f; O[1][r] = 0.f; } \
                    bf16x8 vb[4]; \
                    __builtin_amdgcn_sched_group_barrier(0x100, FD, 0); \
                    _Pragma("clang loop unroll(full)") for (int i = 0; i < 54; ++i) { \
                        const bf16x8 fa = fr[i & 7]; \
                        if (i + FD < 54) fr[(i + FD) & 7] = *(const LAS bf16x8*)DN_FADDR(i + FD); \
                        if (i < 16) VN[i & 1] = __builtin_amdgcn_mfma_f32_32x32x16_bf16(fa, Sb[i >> 1], VN[i & 1], 0, 0, 0); \
                        else if (i < 32) O[(i - 16) & 1] = __builtin_amdgcn_mfma_f32_32x32x16_bf16(fa, Sb[(i - 16) >> 1], O[(i - 16) & 1], 0, 0, 0); \
                        else if (i < 48) S[(i - 32) >> 2] = __builtin_amdgcn_mfma_f32_32x32x16_bf16(fa, vb[(i - 32) & 3], S[(i - 32) >> 2], 0, 0, 0); \
                        else if (i < 50) O[0] = __builtin_amdgcn_mfma_f32_32x32x16_bf16(fa, vb[i - 48], O[0], 0, 0, 0); \
                        else O[1] = __builtin_amdgcn_mfma_f32_32x32x16_bf16(fa, vb[i - 50], O[1], 0, 0, 0); \
                        __builtin_amdgcn_sched_group_barrier(0x008, 1, 0); if (i + FD < 54) __builtin_amdgcn_sched_group_barrier(0x100, 1, 0); \
                        if (i == 23) { \
                            _Pragma("unroll") for (int mt = 0; mt < 2; ++mt) _Pragma("unroll") for (int s2 = 0; s2 < 2; ++s2) { v4u w; w.x = cvtpk_s(VN[mt][8 * s2], VN[mt][8 * s2 + 1]); w.y = cvtpk_s(VN[mt][8 * s2 + 2], VN[mt][8 * s2 + 3]); \
                                    w.z = cvtpk_s(VN[mt][8 * s2 + 4], VN[mt][8 * s2 + 5]); w.w = cvtpk_s(VN[mt][8 * s2 + 6], VN[mt][8 * s2 + 7]); vb[2 * mt + s2] = __builtin_bit_cast(bf16x8, w); } \
                            _Pragma("unroll") for (int t = 0; t < 4; ++t) S[t] = S[t] * dcy; } } \
                    _Pragma("unroll") for (int mt = 0; mt < 2; ++mt) { GAS float* op = (GAS float*)ODN + (row0 + 32 * mt + 4 * hh) * 512 + h * 128 + 32 * sl + l31; \
                        _Pragma("unroll") for (int r = 0; r < 16; ++r) op[(size_t)((r & 3) + 8 * (r >> 2)) * 512] = O[mt][r]; } \
                } while (0)
#define DN_BAR() do { asm volatile("s_waitcnt lgkmcnt(0)" ::: "memory"); __builtin_amdgcn_s_barrier(); asm volatile("" ::: "memory"); } while (0)
            if (wave >= 4) {
#define DN_LSTEP(n, RL, RW) do { if ((n) + 2 < 64) DN_LD(RL, (n) + 2); \
                    if ((n) + 1 < 64) { if ((n) + 2 < 64) DN_LWAIT(RW, 18); else DN_LWAIT(RW, 0); DN_WR(RW, ((n) + 1) & 1); } \
                    DN_BAR(); } while (0)
                DN_LD(R0, 0); DN_LD(R1, 1); DN_LWAIT(R0, 18); DN_WR(R0, 0);
                DN_BAR();
#pragma clang loop unroll(full)
                for (int n2 = 0; n2 < 64; n2 += 2) { DN_LSTEP(n2, R0, R1); DN_LSTEP(n2 + 1, R1, R0); }
#undef DN_LSTEP
            } else {
                DN_BAR();
                for (int n = 0; n < 64; ++n) { DN_COMPUTE(n); DN_BAR(); }
            }
            asm volatile("s_waitcnt vmcnt(0)" ::: "memory");
#undef DN_BAR
#undef DN_LD
#undef DN_LWAIT
#undef DN_WR
#undef DN_FADDR
#undef DN_COMPUTE
        } else if (bx < 20) {
            const int b = bx - 16, ch = tid; const float* SUM = (const float*)(wsl + WS_RGSUM); float* CARRY = (float*)(wsl + WS_CARRY); float carry = 0.f;
            for (int n0 = 0; n0 < 64; n0 += 8) { float ap[8], he[8];
#pragma unroll
                for (int j = 0; j < 8; ++j) { ap[j] = SUM[(size_t)(b * 64 + n0 + j) * 512 + ch]; he[j] = SUM[(size_t)(256 + b * 64 + n0 + j) * 512 + ch]; }
#pragma unroll
                for (int j = 0; j < 8; ++j) { CARRY[(size_t)(b * 64 + n0 + j) * 512 + ch] = carry; carry = ap[j] * carry + he[j]; } }
        } else if (bx < 52) {
            if (bx < 36) { pg8::Gemm g{D, D, D}; pg8::StaticOrder S; S.init(MEMN, Wckv_t, NB * MEML, D, D, D, 16, bx - 20); pg8::EpiStore E{KM, D};
                pg8::gemm_phase<pg8::EpiStore, pg8::StaticOrder, true, false>(lds, g, S, E); }
            else { pg8::Gemm g{D, D, D}; pg8::StaticOrder S; S.init(Wckv_t + (size_t)D * D, MEMN, D, NB * MEML, D, D, 16, bx - 36); pg8::EpiStore E{VT, D};
                pg8::gemm_phase<pg8::EpiStore, pg8::StaticOrder, true, false>(lds, g, S, E); }
        } else if (wave < 4) {
            LAS float* scr = (LAS float*)(lds + wave * 16640); const int cw = (bx - 52) * 4 + wave, NCW = (G - 52) * 4;
            constexpr int I_GU = 32 * 2 * 16 * 16, I_D = 32 * 16 * 16;
            for (int it_ = cw; it_ < (I_GU + I_D) * REPS(3); it_ += NCW) { const int it = it_ % (I_GU + I_D);
                if (it < I_GU) { const int nb = it & 15, kb = (it >> 4) & 15, which = (it >> 8) & 1, e = it >> 9, n0 = nb * 64;
                    transpose_item64<true>((which ? w_up : w_gate) + (size_t)e * D * D, D, n0, kb * 64, Wgu_t + ((size_t)e * 2048 + (n0 >> 7) * 256 + (n0 & 127) + which * 128) * D, D, norm_moe, scr, lane); }
                else { const int r = it - I_GU, nb = r & 15, kb = (r >> 4) & 15, e = r >> 8;
                    transpose_item64<true>(w_down + (size_t)e * D * D, D, nb * 64, kb * 64, Wd_t + ((size_t)e * 1024 + nb * 64) * D, D, nullptr, scr, lane); }
            }
        }
    }
    SEAM(3);
    STAMP(4);
    if (IN(4)) {
        PHASE_PTRS
#pragma unroll 4
        for (int row_ = gw; row_ < M * REPS(4); row_ += NGW) { const int row = row_ % M, c0 = 8 * lane;
            const f32x4 o0 = *(const f32x4*)(ODN + (size_t)row * 512 + c0), o1 = *(const f32x4*)(ODN + (size_t)row * 512 + c0 + 4); const v4u zz = *(const v4u*)(PROJ + (size_t)row * NP + PC_Z + c0);
            float q = (o0[0] * o0[0] + o0[1] * o0[1]) + (o0[2] * o0[2] + o0[3] * o0[3]) + (o1[0] * o1[0] + o1[1] * o1[1]) + (o1[2] * o1[2] + o1[3] * o1[3]);
            q += __shfl_xor(q, 1); q += __shfl_xor(q, 2); q += __shfl_xor(q, 4); q += __shfl_xor(q, 8);
            const float rs = rsqrtf(q * (1.f / 128) + EPS); const f32x4 g0 = *(const f32x4*)(dn_norm + (c0 & 127)), g1 = *(const f32x4*)(dn_norm + (c0 & 127) + 4); v4u ov;
#pragma unroll
            for (int e = 0; e < 4; ++e) { const float a = (e < 2 ? o0[2 * e] : o1[2 * e - 4]) * rs * (e < 2 ? g0[2 * e] : g1[2 * e - 4]) * siluf_(bf2f((bf16)(zz[e] & 0xffff)));
                const float bq = (e < 2 ? o0[2 * e + 1] : o1[2 * e - 3]) * rs * (e < 2 ? g0[2 * e + 1] : g1[2 * e - 3]) * siluf_(bf2f((bf16)(zz[e] >> 16))); ov[e] = pk2(a, bq); }
            *(v4u*)(MIX + (size_t)row * D + c0) = ov; }
        for (int unit_ = bx; unit_ < NB * 64 * REPS(4); unit_ += G) { const int unit = unit_ & 255, c0 = 8 * lane; const size_t row0 = (size_t)unit * 64;
            const f32x4 ca = *(const f32x4*)((const float*)(wsl + WS_CARRY) + (size_t)unit * 512 + c0), cb = *(const f32x4*)((const float*)(wsl + WS_CARRY) + (size_t)unit * 512 + c0 + 4);
#pragma unroll 4
            for (int c = wave; c < 64; c += NWAVES) { const size_t row = row0 + c; const v4u hl = *(const v4u*)((const bf16*)(wsl + WS_HLOC) + row * 512 + c0), cpv = *(const v4u*)((const bf16*)(wsl + WS_CP) + row * 512 + c0), yy = *(const v4u*)(PROJ + row * NP + PC_RY + c0); v4u ov;
#pragma unroll
                for (int e = 0; e < 4; ++e) { const float c_lo = e < 2 ? ca[2 * e] : cb[2 * e - 4], c_hi = e < 2 ? ca[2 * e + 1] : cb[2 * e - 3];
                    const float h0 = bf2f((bf16)(hl[e] & 0xffff)) + bf2f((bf16)(cpv[e] & 0xffff)) * c_lo, h1 = bf2f((bf16)(hl[e] >> 16)) + bf2f((bf16)(cpv[e] >> 16)) * c_hi;
                    ov[e] = pk2(h0 * gelu_tanh(bf2f((bf16)(yy[e] & 0xffff))), h1 * gelu_tanh(bf2f((bf16)(yy[e] >> 16)))); }
                *(v4u*)(MIX + row * D + 512 + c0) = ov; } }
    }
    SEAM(4);
    STAMP(5);
    if (IN(5)) {
        PHASE_PTRS
        pg8::Gemm g{D, D, D}; pg8::StaticOrder S; S.init(MIX, Wout_t, M, D, D, D, G, bx); S.rep = REPS(5); pg8::EpiResid<false, false> E{x, nullptr, HB, ss1};
        pg8::gemm_phase<pg8::EpiResid<false, false>, pg8::StaticOrder, true, false>(lds, g, S, E);
    }
    SEAM(5);
    STAMP(6);
    if (IN(6)) {
        PHASE_PTRS
        for (int rp6 = 0; rp6 < REPS(6); ++rp6) { const int ut = bx; if (ut < (M / 256) * 4) {
            const int pm = ut >> 2, h = ut & 3, b = pm / (T / 256);
            { pg8::Gemm g{D, D, D}; pg8::OneUnit S; S.u0 = pg8::Unit{pm, h, (const char*)(HB + (size_t)pm * 256 * D), (const char*)(Wcq_t + (size_t)h * 256 * D), 0, 0};
              pg8::EpiRowScale E{Qb, ss1, 0.0625f}; pg8::gemm_phase<pg8::EpiRowScale, pg8::OneUnit, false, false>(lds, g, S, E); }
            asm volatile("s_waitcnt vmcnt(0)" ::: "memory"); __syncthreads();
            { pg8::Gemm g{D, D, 256}; pg8::OneUnit S; S.u0 = pg8::Unit{pm, h, (const char*)(Qb + (size_t)pm * 256 * D + h * 256), (const char*)(KM + (size_t)b * 256 * D + h * 256), 0, 0};
              pg8::EpiSoftmax E{Pb}; pg8::gemm_phase<pg8::EpiSoftmax, pg8::OneUnit, false, false>(lds, g, S, E); }
            asm volatile("s_waitcnt vmcnt(0)" ::: "memory"); __syncthreads();
            { pg8::Gemm g{D, D, 256}; pg8::OneUnit S; S.u0 = pg8::Unit{pm, h, (const char*)(Pb + (size_t)pm * 256 * D + h * 256), (const char*)(VT + (size_t)h * 256 * D + b * 256), 0, 0};
              pg8::EpiStore E{O2, D}; pg8::gemm_phase<pg8::EpiStore, pg8::OneUnit, false, false>(lds, g, S, E); }
            asm volatile("s_waitcnt vmcnt(0)" ::: "memory"); __syncthreads();
        } }
    }
    SEAM(6);
    STAMP(7);
    if (IN(7)) {
        PHASE_PTRS
        pg8::Gemm g{D, D, D}; pg8::StaticOrder S; S.init(O2, Wco_t, M, D, D, D, G, bx); pg8::EpiResid<true, true> E{HB, out, HB2, ss2};
        pg8::gemm_phase<pg8::EpiResid<true, true>, pg8::StaticOrder, true, false>(lds, g, S, E);
    }
    SEAM(7);
    STAMP(8);
    if (IN(8)) {
        PHASE_PTRS
        unsigned* cntg = ctl + CW_CNT; int* TOKLw = (int*)(wsl + WS_TOKL); float* GATELw = (float*)(wsl + WS_GATEL); float* RSLw = (float*)(wsl + WS_RSL);
        const bf16* WRh = (const bf16*)(wsl + WS_WR); const bf16* WRl = WRh + NE * D; LAS float* part = (LAS float*)lds;
        for (int rb = bx; rb < M / 64; rb += G) {
            const int rgp = wave & 1, kq = wave >> 1, l31 = lane & 31, hh = lane >> 5; f32x16 acc;
#pragma unroll
            for (int r = 0; r < 16; ++r) acc[r] = 0.f;
            const float* arow = out + (size_t)(rb * 64 + rgp * 32 + l31) * D + kq * 256 + 8 * hh; const bf16* bh = WRh + (size_t)l31 * D + kq * 256 + 8 * hh; const bf16* bl = WRl + (size_t)l31 * D + kq * 256 + 8 * hh;
#pragma unroll 4
            for (int ks = 0; ks < 16; ++ks) { const f32x4 a0 = *(const f32x4*)(arow + 16 * ks), a1 = *(const f32x4*)(arow + 16 * ks + 4); const bf16x8 bhv = *(const bf16x8*)(bh + 16 * ks), blv = *(const bf16x8*)(bl + 16 * ks);
                v4u ah, al;
#pragma unroll
                for (int e = 0; e < 4; ++e) { const float x0 = e < 2 ? a0[2 * e] : a1[2 * e - 4], x1 = e < 2 ? a0[2 * e + 1] : a1[2 * e - 3]; const bf16 h0 = f2bf(x0), h1 = f2bf(x1);
                    ah[e] = (unsigned)h0 | ((unsigned)h1 << 16); al[e] = pk2(x0 - bf2f(h0), x1 - bf2f(h1)); }
                const bf16x8 ahv = __builtin_bit_cast(bf16x8, ah), alv = __builtin_bit_cast(bf16x8, al);
                acc = __builtin_amdgcn_mfma_f32_32x32x16_bf16(ahv, bhv, acc, 0, 0, 0); acc = __builtin_amdgcn_mfma_f32_32x32x16_bf16(alv, bhv, acc, 0, 0, 0); acc = __builtin_amdgcn_mfma_f32_32x32x16_bf16(ahv, blv, acc, 0, 0, 0); }
#pragma unroll
            for (int r = 0; r < 16; ++r) part[(kq * 64 + rgp * 32 + (r & 3) + 8 * (r >> 2) + 4 * hh) * 33 + l31] = acc[r];
            __syncthreads();
            if (tid < 64) { const int row = rb * 64 + tid; const float rs = rsqrtf(pg8::row_ss(ss2, row) * (1.f / D) + EPS); float lg[32];
#pragma unroll
                for (int e = 0; e < 32; ++e) lg[e] = ((part[tid * 33 + e] + part[(64 + tid) * 33 + e]) + (part[(128 + tid) * 33 + e] + part[(192 + tid) * 33 + e])) * rs + b_router[e];
                float tl[4]; int te[4];
#pragma unroll
                for (int q = 0; q < 4; ++q) { float m = lg[0]; int mi = 0;
#pragma unroll
                    for (int e = 1; e < 32; ++e) if (lg[e] > m) { m = lg[e]; mi = e; }
                    tl[q] = m; te[q] = mi;
#pragma unroll
                    for (int e = 0; e < 32; ++e) if (e == mi) lg[e] = -3.0e38f; }
                const float e1 = __expf(tl[1] - tl[0]), e2 = __expf(tl[2] - tl[0]), e3 = __expf(tl[3] - tl[0]), inv = 1.f / (1.f + e1 + e2 + e3);
                LAS unsigned* lcnt = (LAS unsigned*)(lds + 40960); LAS unsigned* lbase = lcnt + 32;
                if (tid < 32) lcnt[tid] = 0u;
                LDS_WAIT(); __builtin_amdgcn_wave_barrier();
                unsigned lp[4];
#pragma unroll
                for (int q = 0; q < 4; ++q) lp[q] = __hip_atomic_fetch_add(&lcnt[te[q]], 1u, __ATOMIC_RELAXED, __HIP_MEMORY_SCOPE_WORKGROUP);
                LDS_WAIT(); __builtin_amdgcn_wave_barrier();
                if (tid < 32) lbase[tid] = atomicAdd(&cntg[tid * CNT_STRIDE], lcnt[tid]);
                LDS_WAIT(); __builtin_amdgcn_wave_barrier();
#pragma unroll
                for (int q = 0; q < 4; ++q) { const float gv = (q == 0 ? 1.f : q == 1 ? e1 : q == 2 ? e2 : e3) * inv; const unsigned pos = lbase[te[q]] + lp[q];
                    TOKLw[te[q] * M + pos] = row * 4 + q; GATELw[te[q] * M + pos] = gv; RSLw[te[q] * M + pos] = rs; } }
            __syncthreads();
        }
    }
    SEAM(8);
    STAMP(9);
    if (IN(9) || IN(10)) {
        PHASE_PTRS
        const unsigned* cntg = ctl + CW_CNT;
        if (tid < 32) LW[LW_CNT + tid] = cntg[tid * CNT_STRIDE];
        __syncthreads();
        if (tid == 0) { int s = 0; for (int e = 0; e < 32; ++e) { LW[LW_TSTART + e] = (unsigned)s; s += ((int)LW[LW_CNT + e] + 255) >> 8; } LW[LW_TSTART + 32] = (unsigned)s; }
        __syncthreads();
    }
    const LAS int* tstart = (const LAS int*)(lds + LDSCTL_OFF) + LW_TSTART; const LAS int* cntl = (const LAS int*)(lds + LDSCTL_OFF) + LW_CNT;
    if (IN(9)) {
        PHASE_PTRS
        pg8::Gemm g{D, D, D}; pg8::MoeOrder<8, true> S{G, bx, tstart, cntl, (const char*)HB2, (const char*)Wgu_t, TOKL, REPS(9)};
        pg8::EpiFFN1 E{HID, RSL, b_gate, b_up, cntl};
        pg8::gemm_phase<pg8::EpiFFN1, pg8::MoeOrder<8, true>, true, true>(lds, g, S, E);
    }
    SEAM(9);
    STAMP(10);
    if (IN(10)) {
        PHASE_PTRS
        pg8::Gemm g{D, D, D}; pg8::MoeOrder<4, false> S{G, bx, tstart, cntl, (const char*)HID, (const char*)Wd_t, TOKL, REPS(10)};
        pg8::EpiFFN2 E{Y, TOKL, GATEL, b_down, cntl};
        pg8::gemm_phase<pg8::EpiFFN2, pg8::MoeOrder<4, false>, true, false>(lds, g, S, E);
    }
    SEAM(10);
    STAMP(11);
    if (IN(11)) {
        PHASE_PTRS
#pragma unroll 2
        for (int row = gw; row < M; row += NGW) {
            f32x4 v[4]; float s = 0.f;
#pragma unroll
            for (int j = 0; j < 4; ++j) { const int c = 4 * lane + 256 * j; f32x4 h = *(const f32x4*)(out + (size_t)row * D + c);
#pragma unroll
                for (int k = 0; k < 4; ++k) { const unsigned long long yy = *(const unsigned long long*)(Y + ((size_t)row * 4 + k) * D + c);
                    h[0] += bf2f((bf16)(yy & 0xffff)); h[1] += bf2f((bf16)((yy >> 16) & 0xffff)); h[2] += bf2f((bf16)((yy >> 32) & 0xffff)); h[3] += bf2f((bf16)(yy >> 48)); }
                v[j] = h; s += (h[0] * h[0] + h[1] * h[1]) + (h[2] * h[2] + h[3] * h[3]); }
            const float rs = rsqrtf(wave_sum(s) * (1.f / D) + EPS);
#pragma unroll
            for (int j = 0; j < 4; ++j) { const int c = 4 * lane + 256 * j; const f32x4 gg = *(const f32x4*)(norm_final + c); *(f32x4*)(out + (size_t)row * D + c) = v[j] * rs * gg; }
        }
    }
    STAMP(12);
    if (TS_LO >= 0 && blockIdx.x == 0 && threadIdx.x == 0) {
        unsigned long long* tsp = (unsigned long long*)(args.ws + WS_TS);
        const unsigned long long t0 = __hip_atomic_load(tsp + TS_LO, __ATOMIC_RELAXED, __HIP_MEMORY_SCOPE_AGENT), t1 = __hip_atomic_load(tsp + TS_HI, __ATOMIC_RELAXED, __HIP_MEMORY_SCOPE_AGENT);
        const unsigned long long until = __builtin_amdgcn_s_memrealtime() + TS_MULT * (t1 - t0);
        while (__builtin_amdgcn_s_memrealtime() < until) __builtin_amdgcn_s_sleep(8);
    }
#undef IN
#undef SEAM
}

static void launch_mk(Args a, int lo, int hi, int bli, int grid, hipStream_t stream) {
    a.ph_lo = lo; a.ph_hi = hi; a.bli = bli; a.pad = 0;
    hipLaunchKernelGGL(mk_fwd, dim3(grid), dim3(NTHR), LDS_BYTES, stream, a);
}
extern "C" void kernel_launch(void* const* d_in, const int* in_sizes, int n_in, void* d_out, int out_size, void* d_ws, size_t ws_size, hipStream_t stream) {
    if (n_in != 31 || out_size != M * D || ws_size < WS_END) { fprintf(stderr, "kernel_launch: unexpected shapes n_in %d out %d ws %zu\n", n_in, out_size, ws_size); return; }
    static int grid = 0;
    if (grid == 0) {
        int dev = 0, cus = 0;
        if (hipGetDevice(&dev) != hipSuccess || hipDeviceGetAttribute(&cus, hipDeviceAttributeMultiprocessorCount, dev) != hipSuccess) { grid = -1; return; }
        if (hipFuncSetAttribute((const void*)mk_fwd, hipFuncAttributeMaxDynamicSharedMemorySize, LDS_BYTES) != hipSuccess) { fprintf(stderr, "kernel_launch: hipFuncSetAttribute failed\n"); grid = -1; return; }
        int per_cu = 0; (void)hipOccupancyMaxActiveBlocksPerMultiprocessor(&per_cu, (const void*)mk_fwd, NTHR, LDS_BYTES); (void)hipGetLastError();
        if (per_cu < 1) fprintf(stderr, "kernel_launch: occupancy query reports %d blocks per CU\n", per_cu);
        if (cus < 256) { fprintf(stderr, "kernel_launch: needs 256 CUs, device has %d\n", cus); grid = -1; return; }
        grid = 256;
    }
    if (grid < 0) return;
    const float* const* in = (const float* const*)d_in;
    const float *dn_conv = in[4], *dn_a_log = in[5], *dn_dt_bias = in[6], *dn_norm = in[7];
    const float *rg_conv = in[8], *rg_conv_b = in[9], *rg_w_a = in[10], *rg_b_a = in[11], *rg_w_x = in[12], *rg_b_x = in[13], *rg_lambda = in[14];
    const float *norm_moe = in[21], *w_router = in[22], *b_router = in[23];
    char* ws = (char*)d_ws; float* out = (float*)d_out;
    unsigned* ctl = (unsigned*)(ws + WS_CTL); unsigned* cnt = ctl + CW_CNT; float* ss2 = (float*)(ws + CTL_SS2);
    float* BA = (float*)(ws + WS_BA); float* RSTD2 = (float*)(ws + WS_RSTD2);
    int* TOKL = (int*)(ws + WS_TOKL); float* GATEL = (float*)(ws + WS_GATEL); float* RSL = (float*)(ws + WS_RSL);
    bf16 *MIX = (bf16*)(ws + WS_XN), *PROJ = (bf16*)(ws + WS_PROJ);
    float* ODN = (float*)(ws + WS_ODN); float* QKVN = (float*)(ws + WS_QKVN);
    Args a{};
    for (int i = 0; i < 31; ++i) a.in[i] = (const float*)d_in[i];
    a.out = out; a.ws = (unsigned char*)d_ws;

    (void)hipMemsetAsync(ws + WS_CTL, 0, CTL_BYTES, stream);
    launch_mk(a, 0, 12, 0, grid, stream);
}
```

```cpp
#include <hip/hip_runtime.h>
#include <cstdio>
#include <cstdint>

typedef unsigned short bf16;
#ifndef TS_LO
#define TS_LO -1
#define TS_HI -1
#endif
#define TS_MULT 4
__device__ __forceinline__ float bf2f(bf16 v) { return __builtin_bit_cast(float, (unsigned)v << 16); }
typedef __bf16 bf16x2_t __attribute__((ext_vector_type(2)));
typedef float f32x2_t __attribute__((ext_vector_type(2)));
__device__ __forceinline__ unsigned cvtpk_s(float lo, float hi) { f32x2_t v = {lo, hi}; bf16x2_t b = __builtin_convertvector(v, bf16x2_t); return __builtin_bit_cast(unsigned, b); }
__device__ __forceinline__ bf16 f2bf(float f) { return (bf16)(cvtpk_s(f, 0.f) & 0xffffu); }

constexpr int NB = 4, T = 4096, D = 1024, M = NB * T, NIN = 3080, NP = 3072, MEML = 256;
constexpr int NE = 32, TOPK = 4;
constexpr float EPS = 1e-6f;
constexpr int PC_Q = 0, PC_K = 512, PC_V = 1024, PC_Z = 1536, PC_RX = 2048, PC_RY = 2560;

constexpr size_t MiB = 1u << 20;
constexpr size_t WS_CTL = 0, CTL_BYTES = 1 * MiB;
constexpr int CW_CNT = 16384, CNT_STRIDE = 64;
constexpr size_t CTL_SS1 = 128 * 1024, CTL_SS2 = 192 * 1024;
constexpr size_t WS_BA = 1 * MiB, WS_RSTD2 = 1 * MiB + 512 * 1024, WS_DEC = 1 * MiB + 768 * 1024;
constexpr size_t WS_RGW = 2 * MiB, WS_WR = 2 * MiB + 512 * 1024, WS_MEMN = 3 * MiB, WS_KM = 5 * MiB, WS_VT = 7 * MiB;
constexpr size_t WS_RGSUM = 9 * MiB, WS_TOKL = 10 * MiB, WS_GATEL = 12 * MiB, WS_RSL = 14 * MiB;
constexpr size_t WS_WIN = 16 * MiB, WS_WOUT = 22 * MiB, WS_WCQ = 24 * MiB, WS_WCKV = 26 * MiB, WS_WCO = 30 * MiB;
constexpr size_t WS_WGU = 32 * MiB, WS_WD = 160 * MiB;
constexpr size_t WS_XN = 224 * MiB;
constexpr size_t WS_PROJ = 256 * MiB;
constexpr size_t WS_HB = 256 * MiB, WS_Q = 288 * MiB, WS_P = 320 * MiB, WS_HID = 256 * MiB;
constexpr size_t WS_DN = 352 * MiB;
constexpr size_t WS_O2 = 352 * MiB, WS_SC = 384 * MiB  ;
constexpr size_t WS_ODN = 442 * MiB, WS_HLOC = 474 * MiB, WS_CP = 490 * MiB, WS_SSP1 = 506 * MiB, WS_SSP2 = 507 * MiB, WS_CARRY = 508 * MiB, WS_TS = 508 * MiB + 768 * 1024, WS_END = 509 * MiB;
constexpr size_t WS_Y = 24 * MiB;
constexpr int DNU_BYTES = 73728, DNU_WN = 0, DNU_QG = 16384, DNU_KDT = 32768, DNU_QK = 49152, DNU_UT = 57344;
constexpr size_t WS_QKVN = 32 * MiB;

__host__ __device__ __forceinline__ int kperm(int k) { const int g = (k >> 2) & 3; return (g == 1 || g == 2) ? (k ^ 12) : k; }
#define DPP_ADD(v, ctrl) ((v) + __builtin_bit_cast(float, __builtin_amdgcn_update_dpp(0, __builtin_bit_cast(int, (v)), (ctrl), 0xF, 0xF, true)))
__device__ __forceinline__ float wave_sum(float v) {
    v = DPP_ADD(v, 0xB1); v = DPP_ADD(v, 0x4E); v = DPP_ADD(v, 0x141); v = DPP_ADD(v, 0x140);
    const float r0 = __builtin_bit_cast(float, __builtin_amdgcn_readlane(__builtin_bit_cast(int, v), 0)), r1 = __builtin_bit_cast(float, __builtin_amdgcn_readlane(__builtin_bit_cast(int, v), 16));
    const float r2 = __builtin_bit_cast(float, __builtin_amdgcn_readlane(__builtin_bit_cast(int, v), 32)), r3 = __builtin_bit_cast(float, __builtin_amdgcn_readlane(__builtin_bit_cast(int, v), 48));
    return (r0 + r1) + (r2 + r3);
}
__device__ __forceinline__ float sigmoidf_(float x) { return __builtin_amdgcn_rcpf(1.f + __builtin_amdgcn_exp2f(x * -1.4426950408889634f)); }
__device__ __forceinline__ float siluf_(float x) { return x * sigmoidf_(x); }
__device__ __forceinline__ float softplusf_(float x) { return fmaxf(x, 0.f) + log1pf(__expf(-fabsf(x))); }
__device__ __forceinline__ float gelu_tanh(float x) { const float u = 0.7978845608028654f * (x + 0.044715f * x * x * x); return x * sigmoidf_(2.f * u); }
__device__ __forceinline__ float ffn_act(float gt, float up) { gt = fminf(gt, 7.f); up = fminf(fmaxf(up, -7.f), 7.f); return (up + 1.f) * (gt * sigmoidf_(1.702f * gt)); }

namespace pg8 {
#define PG8_LAS __attribute__((address_space(3)))
typedef unsigned short bf16_t;
typedef short bf16x8 __attribute__((ext_vector_type(8)));
typedef float f32x4 __attribute__((ext_vector_type(4)));
typedef unsigned u32x4 __attribute__((ext_vector_type(4)));
constexpr int BM = 256, BK = 64, HALF = 128, HTB = HALF * BK * 2, STAGE_BYTES = 8 * HTB, NXCD = 8, WGM = 8;

__host__ __device__ __forceinline__ int lds_byte(int r, int c) { const int st = (r >> 4) * 2 + (c >> 5), rr = r & 15, cc = c & 31, ob = rr * 64 + cc * 2; return st * 1024 + (ob ^ (((ob >> 9) & 1) << 5)); }
__host__ __device__ __forceinline__ void stage_rc(int b, int& R, int& C) { const int st = b / 1024, sb = b % 1024, swz = sb ^ (((sb >> 9) & 1) << 5); R = (st >> 1) * 16 + swz / 64; C = (st & 1) * 32 + (swz % 64) / 2; }
__host__ __device__ __forceinline__ int perm32(int rho) { const int n = rho >> 4, i = rho & 15; return 8 * (i >> 2) + 4 * n + (i & 3); }

struct Unit { int pm, pn; const char* a; const char* b; int e, j, kind; };
struct Gemm { int lda, ldb, K; };

struct StaticOrder {
    static constexpr bool HOOK = false; int nM, nN, nwg, G, c, rep = 1; const char* A; const char* Bt; size_t astep, bstep;
    __device__ void init(const void* A_, const void* Bt_, int M, int N, int lda, int ldb, int G_, int c_) { nM = M / BM; nN = N / BM; nwg = nM * nN; G = G_; c = c_; A = (const char*)A_; Bt = (const char*)Bt_; astep = (size_t)BM * lda * 2; bstep = (size_t)BM * ldb * 2; }
    __device__ bool next(int i, Unit& u) const {
        long L = (long)i * G + c; if (L >= (long)nwg * rep) return false; L %= nwg;
        int wgid = (int)L; { const int q = nwg / NXCD, r = nwg % NXCD, xcd = wgid % NXCD, off = wgid / NXCD; wgid = (xcd < r ? xcd * (q + 1) : r * (q + 1) + (xcd - r) * q) + off; }
        const int nig = WGM * nN, gid = wgid / nig, fm = gid * WGM, gsz = (nM - fm) < WGM ? (nM - fm) : WGM;
        u.pm = fm + ((wgid % nig) % gsz); u.pn = (wgid % nig) / gsz; u.a = A + (size_t)u.pm * astep; u.b = Bt + (size_t)u.pn * bstep; u.e = 0; u.j = 0; u.kind = 0; return true;
    }
    __device__ __forceinline__ int arow(const Unit&, int) const { return 0; }
};
struct OneUnit {
    Unit u0;
    __device__ bool next(int i, Unit& u) const { if (i != 0) return false; u = u0; return true; }
    __device__ __forceinline__ int arow(const Unit&, int) const { return 0; }
};

__device__ __forceinline__ unsigned cvt_pk_bf16(float lo, float hi) { unsigned r; asm volatile("v_cvt_pk_bf16_f32 %0, %1, %2" : "=v"(r) : "v"(lo), "v"(hi)); return r; }

typedef f32x4 Acc[2][2][4][2];

template <class Epi, class Sched, bool ALIGN_EPI, bool GATHER>
__device__ __forceinline__ void gemm_phase(PG8_LAS unsigned char* lds, const Gemm g, const Sched& S, const Epi& E) {
    const int tid = threadIdx.x, wid = __builtin_amdgcn_readfirstlane(tid >> 6), lane = tid & 63, wr = wid >> 2, wc = wid & 3, fr = lane & 15, fq = lane >> 4;
    const int nt = g.K / BK;
    unsigned voffA[2], voffB[2]; int RA[2], CA[2];
#pragma unroll
    for (int i = 0; i < 2; ++i) { int R, C; stage_rc(tid * 16 + i * 8192, R, C); const int Rb = (R & ~31) + perm32(R & 31);
        voffA[i] = (unsigned)(R * g.lda + C) * 2u; voffB[i] = (unsigned)(Rb * g.ldb + C) * 2u; RA[i] = R; CA[i] = C; }
    const size_t kstep = (size_t)(BK * 2);
    const size_t hstepA = (size_t)HALF * g.lda * 2, hstepB = (size_t)HALF * g.ldb * 2;
    const unsigned ldsw = (unsigned)wid * 1024u;
    const int aoff = lds_byte(wr * 64 + fr, fq * 8), boff = lds_byte(wc * 32 + fr, fq * 8);
    unsigned aoC[2][2], aoN[2][2];
#define PG8_SA(b, h) (((b) * 2 + (h)) * HTB)
#define PG8_SB(b, h) ((4 + (b) * 2 + (h)) * HTB)
#define PG8_STAGE(bufoff, gbase, voff) do { _Pragma("unroll") for (int _i = 0; _i < 2; ++_i) \
        __builtin_amdgcn_global_load_lds((const unsigned*)((const char*)(gbase) + (voff)[_i]), (PG8_LAS unsigned*)(lds + (bufoff) + ldsw + _i * 8192), 16, 0, 0); } while (0)
#define PG8_STAGE_A(bufoff, gbase, h, nx) do { if constexpr (GATHER) { unsigned _v[2]; _v[0] = (nx) ? aoN[h][0] : aoC[h][0]; _v[1] = (nx) ? aoN[h][1] : aoC[h][1]; PG8_STAGE(bufoff, gbase, _v); } \
        else { PG8_STAGE(bufoff, (gbase) + (h) * hstepA, voffA); } } while (0)
#define PG8_GOFF(dst, un) do { _Pragma("unroll") for (int _h = 0; _h < 2; ++_h) _Pragma("unroll") for (int _i = 0; _i < 2; ++_i) \
        dst[_h][_i] = (unsigned)(S.arow(un, _h * HALF + RA[_i]) * g.lda + CA[_i]) * 2u; } while (0)
#define PG8_LDA(dst, b, h) do { _Pragma("unroll") for (int m = 0; m < 4; ++m) _Pragma("unroll") for (int k = 0; k < 2; ++k) dst[m][k] = *(const PG8_LAS bf16x8*)(lds + PG8_SA(b, h) + aoff + m * 2048 + k * 1024); } while (0)
#define PG8_LDB(dst, b, h) do { _Pragma("unroll") for (int n = 0; n < 2; ++n) _Pragma("unroll") for (int k = 0; k < 2; ++k) dst[n][k] = *(const PG8_LAS bf16x8*)(lds + PG8_SB(b, h) + boff + n * 2048 + k * 1024); } while (0)
#define PG8_MMA(ai, bj, At, Bt) do { __builtin_amdgcn_s_setprio(1); _Pragma("unroll") for (int m = 0; m < 4; ++m) _Pragma("unroll") for (int n = 0; n < 2; ++n) _Pragma("unroll") for (int k = 0; k < 2; ++k) \
        acc[ai][bj][m][n] = __builtin_amdgcn_mfma_f32_16x16x32_bf16(Bt[n][k], At[m][k], acc[ai][bj][m][n], 0, 0, 0); __builtin_amdgcn_s_setprio(0); } while (0)
#define PG8_WAIT_V(n) asm volatile("s_waitcnt vmcnt(" #n ")" ::: "memory")
#define PG8_WAIT_L(n) asm volatile("s_waitcnt lgkmcnt(" #n ")" ::: "memory")
#define PG8_BAR __builtin_amdgcn_s_barrier()
#define PG8_SCHED __builtin_amdgcn_sched_barrier(0)
    Unit cur, nxt; int ui = 0;
    if (!S.next(0, cur)) return;
    if constexpr (GATHER) { PG8_GOFF(aoC, cur); }
    Acc acc;
#pragma unroll
    for (int a = 0; a < 2; ++a)
#pragma unroll
        for (int b = 0; b < 2; ++b)
#pragma unroll
            for (int m = 0; m < 4; ++m)
#pragma unroll
                for (int n = 0; n < 2; ++n) acc[a][b][m][n] = (f32x4){0.f, 0.f, 0.f, 0.f};
    bf16x8 At[4][2], B0[2][2], B1[2][2];
    const char* cA = cur.a; const char* cB = cur.b;
    PG8_STAGE(PG8_SB(0, 0), cB, voffB); PG8_STAGE(PG8_SB(0, 1), cB + hstepB, voffB); PG8_STAGE_A(PG8_SA(0, 0), cA, 0, false); PG8_STAGE_A(PG8_SA(0, 1), cA, 1, false);
    if (wr == 1) PG8_BAR;
    PG8_WAIT_V(2); PG8_BAR;
    PG8_STAGE(PG8_SB(1, 0), cB + kstep, voffB); PG8_STAGE_A(PG8_SA(1, 0), cA + kstep, 0, false); PG8_STAGE(PG8_SB(1, 1), cB + hstepB + kstep, voffB);
    PG8_WAIT_V(6); PG8_BAR;
    for (;;) {
        const bool has_next = S.next(ui + 1, nxt);
        if constexpr (GATHER) { if (has_next) { PG8_GOFF(aoN, nxt); } else {
#pragma unroll
            for (int _h = 0; _h < 2; ++_h) { aoN[_h][0] = aoC[_h][0]; aoN[_h][1] = aoC[_h][1]; } } }
        const char* nA = has_next ? nxt.a : cA; const char* nB = has_next ? nxt.b : cB;
#pragma nounroll
        for (int t = 0; t < nt; t += 2) {
            const bool last = (t == nt - 2);
            const char* a1 = cA + (size_t)(t + 1) * kstep;
            const char* a2 = last ? nA : cA + (size_t)(t + 2) * kstep; const char* b2 = last ? nB : cB + (size_t)(t + 2) * kstep;
            const char* a3 = a2 + kstep; const char* b3 = b2 + kstep;
            PG8_LDB(B0, 0, 0); PG8_LDB(B1, 0, 1); PG8_SCHED; PG8_LDA(At, 0, 0); PG8_STAGE_A(PG8_SA(1, 1), a1, 1, false);
            PG8_WAIT_V(8); PG8_WAIT_L(0); PG8_BAR; PG8_MMA(0, 0, At, B0); PG8_MMA(0, 1, At, B1); PG8_BAR; PG8_SCHED;
            PG8_LDA(At, 0, 1); PG8_STAGE(PG8_SB(0, 0), b2, voffB); PG8_STAGE(PG8_SB(0, 1), b2 + hstepB, voffB); PG8_STAGE_A(PG8_SA(0, 0), a2, 0, last);
            PG8_WAIT_V(8); PG8_WAIT_L(0); PG8_BAR; PG8_MMA(1, 0, At, B0); PG8_MMA(1, 1, At, B1); PG8_BAR; PG8_SCHED;
            PG8_LDB(B0, 1, 0); PG8_LDB(B1, 1, 1); PG8_SCHED; PG8_LDA(At, 1, 0); PG8_STAGE_A(PG8_SA(0, 1), a2, 1, last);
            PG8_WAIT_V(8); PG8_WAIT_L(0); PG8_BAR; PG8_MMA(0, 0, At, B0); PG8_MMA(0, 1, At, B1); PG8_BAR; PG8_SCHED;
            PG8_LDA(At, 1, 1); PG8_STAGE(PG8_SB(1, 0), b3, voffB); PG8_STAGE(PG8_SB(1, 1), b3 + hstepB, voffB); PG8_STAGE_A(PG8_SA(1, 0), a3, 0, last);
            PG8_WAIT_V(8); PG8_WAIT_L(0); PG8_BAR; PG8_MMA(1, 0, At, B0); PG8_MMA(1, 1, At, B1); PG8_BAR; PG8_SCHED;
        }
        if constexpr (ALIGN_EPI) { if (wr == 0) PG8_BAR; }
        if constexpr (!Epi::AFTER_DRAIN) { E(acc, cur, wr, wc, fr, fq); }
        if (!has_next) break;
#pragma unroll
        for (int a = 0; a < 2; ++a)
#pragma unroll
            for (int b = 0; b < 2; ++b)
#pragma unroll
                for (int m = 0; m < 4; ++m)
#pragma unroll
                    for (int n = 0; n < 2; ++n) acc[a][b][m][n] = (f32x4){0.f, 0.f, 0.f, 0.f};
        cur = nxt; cA = nA; cB = nB; ++ui;
        if constexpr (GATHER) {
#pragma unroll
            for (int _h = 0; _h < 2; ++_h) { aoC[_h][0] = aoN[_h][0]; aoC[_h][1] = aoN[_h][1]; } }
        if constexpr (ALIGN_EPI) { if (wr == 1) PG8_BAR; }
    }
    PG8_WAIT_V(0);
    if constexpr (!ALIGN_EPI) { if (wr == 0) PG8_BAR; }
    PG8_BAR;
    if constexpr (Epi::AFTER_DRAIN) { E.fused(acc, cur, wr, wc, fr, fq, lds); }
#undef PG8_SA
#undef PG8_SB
#undef PG8_STAGE
#undef PG8_STAGE_A
#undef PG8_GOFF
#undef PG8_LDA
#undef PG8_LDB
#undef PG8_MMA
#undef PG8_WAIT_V
#undef PG8_WAIT_L
#undef PG8_BAR
#undef PG8_SCHED
}

struct EpiStore {
    static constexpr bool AFTER_DRAIN = false; bf16_t* O; int ldc;
    __device__ __forceinline__ void operator()(const Acc& acc, const Unit& u, int wr, int wc, int fr, int fq) const {
        const int row0 = u.pm * BM + wr * 64 + fr, col0 = u.pn * BM + wc * 32 + 8 * fq;
#pragma unroll
        for (int ai = 0; ai < 2; ++ai)
#pragma unroll
            for (int m = 0; m < 4; ++m) { bf16_t* rowp = O + (size_t)(row0 + ai * HALF + m * 16) * ldc + col0;
#pragma unroll
                for (int bj = 0; bj < 2; ++bj) { const f32x4 v0 = acc[ai][bj][m][0], v1 = acc[ai][bj][m][1];
                    u32x4 w; w.x = cvt_pk_bf16(v0[0], v0[1]); w.y = cvt_pk_bf16(v0[2], v0[3]); w.z = cvt_pk_bf16(v1[0], v1[1]); w.w = cvt_pk_bf16(v1[2], v1[3]);
                    *(u32x4*)(rowp + bj * HALF) = w; } }
    }
};
__device__ __forceinline__ float row_ss(const float* SS, int row) { const f32x4 a = *(const f32x4*)(SS + row * 16), b = *(const f32x4*)(SS + row * 16 + 4), c = *(const f32x4*)(SS + row * 16 + 8), d = *(const f32x4*)(SS + row * 16 + 12);
    return (((a[0] + a[1]) + (a[2] + a[3])) + ((b[0] + b[1]) + (b[2] + b[3]))) + (((c[0] + c[1]) + (c[2] + c[3])) + ((d[0] + d[1]) + (d[2] + d[3]))); }
template <bool RBF16, bool WF32> struct EpiResid {
    static constexpr bool AFTER_DRAIN = false; const void* R; float* H; bf16_t* HB; float* SS;
    __device__ __forceinline__ void operator()(const Acc& acc, const Unit& u, int wr, int wc, int fr, int fq) const {
        const int row0 = u.pm * BM + wr * 64 + fr, col0 = u.pn * BM + wc * 32 + 8 * fq;
#pragma unroll
        for (int ai = 0; ai < 2; ++ai)
#pragma unroll
            for (int m = 0; m < 4; ++m) { const int row = row0 + ai * HALF + m * 16; const size_t off = (size_t)row * D + col0; float sq = 0.f;
#pragma unroll
                for (int bj = 0; bj < 2; ++bj) { f32x4 r0, r1;
                    if (RBF16) { const u32x4 rb = *(const u32x4*)((const bf16_t*)R + off + bj * HALF);
                        r0 = (f32x4){__builtin_bit_cast(float, rb.x << 16), __builtin_bit_cast(float, rb.x & 0xffff0000u), __builtin_bit_cast(float, rb.y << 16), __builtin_bit_cast(float, rb.y & 0xffff0000u)};
                        r1 = (f32x4){__builtin_bit_cast(float, rb.z << 16), __builtin_bit_cast(float, rb.z & 0xffff0000u), __builtin_bit_cast(float, rb.w << 16), __builtin_bit_cast(float, rb.w & 0xffff0000u)}; }
                    else { r0 = *(const f32x4*)((const float*)R + off + bj * HALF); r1 = *(const f32x4*)((const float*)R + off + bj * HALF + 4); }
                    const f32x4 v0 = acc[ai][bj][m][0] + r0, v1 = acc[ai][bj][m][1] + r1;
                    if (WF32) { *(f32x4*)(H + off + bj * HALF) = v0; *(f32x4*)(H + off + bj * HALF + 4) = v1; }
                    u32x4 w; w.x = cvt_pk_bf16(v0[0], v0[1]); w.y = cvt_pk_bf16(v0[2], v0[3]); w.z = cvt_pk_bf16(v1[0], v1[1]); w.w = cvt_pk_bf16(v1[2], v1[3]);
                    *(u32x4*)(HB + off + bj * HALF) = w;
                    sq += (v0[0] * v0[0] + v0[1] * v0[1]) + (v0[2] * v0[2] + v0[3] * v0[3]) + (v1[0] * v1[0] + v1[1] * v1[1]) + (v1[2] * v1[2] + v1[3] * v1[3]); }
                sq += __shfl_xor(sq, 16); sq += __shfl_xor(sq, 32);
                if (fq == 0) SS[row * 16 + u.pn * 4 + wc] = sq; }
    }
};
struct EpiRowScale {
    static constexpr bool AFTER_DRAIN = false; bf16_t* O; const float* SS; float s;
    __device__ __forceinline__ void operator()(const Acc& acc, const Unit& u, int wr, int wc, int fr, int fq) const {
        const int row0 = u.pm * BM + wr * 64 + fr, col0 = u.pn * BM + wc * 32 + 8 * fq;
#pragma unroll
        for (int ai = 0; ai < 2; ++ai)
#pragma unroll
            for (int m = 0; m < 4; ++m) { const int row = row0 + ai * HALF + m * 16; const float rs = rsqrtf(row_ss(SS, row) * (1.f / D) + EPS) * s; bf16_t* rowp = O + (size_t)row * D + col0;
#pragma unroll
                for (int bj = 0; bj < 2; ++bj) { const f32x4 v0 = acc[ai][bj][m][0] * rs, v1 = acc[ai][bj][m][1] * rs;
                    u32x4 w; w.x = cvt_pk_bf16(v0[0], v0[1]); w.y = cvt_pk_bf16(v0[2], v0[3]); w.z = cvt_pk_bf16(v1[0], v1[1]); w.w = cvt_pk_bf16(v1[2], v1[3]);
                    *(u32x4*)(rowp + bj * HALF) = w; } }
    }
};
struct EpiSoftmax {
    static constexpr bool AFTER_DRAIN = true; bf16_t* P;
    __device__ __forceinline__ void operator()(const Acc&, const Unit&, int, int, int, int) const {}
    __device__ __forceinline__ void fused(Acc& acc, const Unit& u, int wr, int wc, int fr, int fq, PG8_LAS unsigned char* lds) const {
        PG8_LAS float* xm = (PG8_LAS float*)lds; PG8_LAS float* xs = xm + 1024;
#pragma unroll
        for (int ai = 0; ai < 2; ++ai)
#pragma unroll
            for (int m = 0; m < 4; ++m) { float mx = -3.0e38f;
#pragma unroll
                for (int bj = 0; bj < 2; ++bj)
#pragma unroll
                    for (int n = 0; n < 2; ++n) { const f32x4 v = acc[ai][bj][m][n]; mx = fmaxf(mx, fmaxf(fmaxf(v[0], v[1]), fmaxf(v[2], v[3]))); }
                mx = fmaxf(mx, __shfl_xor(mx, 16)); mx = fmaxf(mx, __shfl_xor(mx, 32));
                if (fq == 0) xm[(ai * HALF + wr * 64 + m * 16 + fr) * 4 + wc] = mx; }
        __syncthreads();
#pragma unroll
        for (int ai = 0; ai < 2; ++ai)
#pragma unroll
            for (int m = 0; m < 4; ++m) { const int r = ai * HALF + wr * 64 + m * 16 + fr; const f32x4 q = *(const PG8_LAS f32x4*)(xm + r * 4);
                const float mx = fmaxf(fmaxf(q[0], q[1]), fmaxf(q[2], q[3])); float sm = 0.f;
#pragma unroll
                for (int bj = 0; bj < 2; ++bj)
#pragma unroll
                    for (int n = 0; n < 2; ++n) { f32x4 v = acc[ai][bj][m][n]; v[0] = __expf(v[0] - mx); v[1] = __expf(v[1] - mx); v[2] = __expf(v[2] - mx); v[3] = __expf(v[3] - mx);
                        acc[ai][bj][m][n] = v; sm += (v[0] + v[1]) + (v[2] + v[3]); }
                sm += __shfl_xor(sm, 16); sm += __shfl_xor(sm, 32);
                if (fq == 0) xs[r * 4 + wc] = sm; }
        __syncthreads();
        const int row0 = u.pm * BM, col0 = u.pn * BM + wc * 32 + 8 * fq;
#pragma unroll
        for (int ai = 0; ai < 2; ++ai)
#pragma unroll
            for (int m = 0; m < 4; ++m) { const int r = ai * HALF + wr * 64 + m * 16 + fr; const f32x4 q = *(const PG8_LAS f32x4*)(xs + r * 4);
                const float inv = 1.f / ((q[0] + q[1]) + (q[2] + q[3])); bf16_t* rowp = P + (size_t)(row0 + r) * D + col0;
#pragma unroll
                for (int bj = 0; bj < 2; ++bj) { const f32x4 v0 = acc[ai][bj][m][0] * inv, v1 = acc[ai][bj][m][1] * inv;
                    u32x4 w; w.x = cvt_pk_bf16(v0[0], v0[1]); w.y = cvt_pk_bf16(v0[2], v0[3]); w.z = cvt_pk_bf16(v1[0], v1[1]); w.w = cvt_pk_bf16(v1[2], v1[3]);
                    *(u32x4*)(rowp + bj * HALF) = w; } }
        __syncthreads();
    }
};
struct EpiFFN1 {
    static constexpr bool AFTER_DRAIN = false; bf16_t* HID; const float* RSL; const float* bg; const float* bu; const PG8_LAS int* cntl;
    __device__ __forceinline__ void operator()(const Acc& acc, const Unit& u, int wr, int wc, int fr, int fq) const {
        const int cnt = cntl[u.e], c0 = u.pn * HALF + wc * 32 + 8 * fq;
        const f32x4 g0 = *(const f32x4*)(bg + u.e * 1024 + c0), g1 = *(const f32x4*)(bg + u.e * 1024 + c0 + 4), u0 = *(const f32x4*)(bu + u.e * 1024 + c0), u1 = *(const f32x4*)(bu + u.e * 1024 + c0 + 4);
#pragma unroll
        for (int ai = 0; ai < 2; ++ai)
#pragma unroll
            for (int m = 0; m < 4; ++m) { const int r = ai * HALF + wr * 64 + m * 16 + fr, pos = u.j * BM + r; const float rs = pos < cnt ? RSL[u.e * M + pos] : 0.f;
                const f32x4 a0 = acc[ai][0][m][0] * rs + g0, a1 = acc[ai][0][m][1] * rs + g1, b0 = acc[ai][1][m][0] * rs + u0, b1 = acc[ai][1][m][1] * rs + u1;
                u32x4 w; w.x = cvt_pk_bf16(ffn_act(a0[0], b0[0]), ffn_act(a0[1], b0[1])); w.y = cvt_pk_bf16(ffn_act(a0[2], b0[2]), ffn_act(a0[3], b0[3]));
                w.z = cvt_pk_bf16(ffn_act(a1[0], b1[0]), ffn_act(a1[1], b1[1])); w.w = cvt_pk_bf16(ffn_act(a1[2], b1[2]), ffn_act(a1[3], b1[3]));
                *(u32x4*)(HID + (size_t)(u.pm * BM + r) * 1024 + c0) = w; }
    }
};
struct EpiFFN2 {
    static constexpr bool AFTER_DRAIN = false; bf16_t* Y; const int* TOKL; const float* GATEL; const float* bd; const PG8_LAS int* cntl;
    __device__ __forceinline__ void operator()(const Acc& acc, const Unit& u, int wr, int wc, int fr, int fq) const {
        const int cnt = cntl[u.e], c0 = u.pn * BM + wc * 32 + 8 * fq;
        f32x4 bv[2][2];
#pragma unroll
        for (int bj = 0; bj < 2; ++bj) { bv[bj][0] = *(const f32x4*)(bd + u.e * 1024 + c0 + bj * HALF); bv[bj][1] = *(const f32x4*)(bd + u.e * 1024 + c0 + bj * HALF + 4); }
#pragma unroll
        for (int ai = 0; ai < 2; ++ai)
#pragma unroll
            for (int m = 0; m < 4; ++m) { const int r = ai * HALF + wr * 64 + m * 16 + fr, pos = u.j * BM + r;
                if (pos < cnt) { const int dst = TOKL[u.e * M + pos]; const float gt = GATEL[u.e * M + pos]; bf16_t* rowp = Y + (size_t)dst * 1024 + c0;
#pragma unroll
                    for (int bj = 0; bj < 2; ++bj) { const f32x4 v0 = (acc[ai][bj][m][0] + bv[bj][0]) * gt, v1 = (acc[ai][bj][m][1] + bv[bj][1]) * gt;
                        u32x4 w; w.x = cvt_pk_bf16(v0[0], v0[1]); w.y = cvt_pk_bf16(v0[2], v0[3]); w.z = cvt_pk_bf16(v1[0], v1[1]); w.w = cvt_pk_bf16(v1[2], v1[3]);
                        *(u32x4*)(rowp + bj * HALF) = w; } } }
    }
};
template <int NPN, bool IS_FFN1> struct MoeOrder {
    static constexpr bool HOOK = false; int G, c; const PG8_LAS int* tstart; const PG8_LAS int* cntl; const char* A; const char* W; const int* TOKL; int rt0, rt1;
    __device__ bool next(int i, Unit& u) const {
        const int L = i * G + c; if (L >= (rt1 - rt0) * NPN) return false;
        const int rt = rt0 + L / NPN, pn = L % NPN; int e = 0;
        for (int q = 1; q < 32; ++q) e += (tstart[q] <= rt) ? 1 : 0;
        u.pm = rt; u.pn = pn; u.e = e; u.j = rt - tstart[e]; u.kind = IS_FFN1 ? 0 : 1;
        if (IS_FFN1) { u.a = A; u.b = W + ((size_t)e * 2048 + (size_t)pn * 256) * 2048; }
        else { u.a = A + (size_t)rt * 256 * 2048; u.b = W + ((size_t)e * 1024 + (size_t)pn * 256) * 2048; }
        return true;
    }
    __device__ __forceinline__ int arow(const Unit& u, int r) const { const int pos = u.j * BM + r; return pos < cntl[u.e] ? (TOKL[u.e * M + pos] >> 2) : 0; }
};
struct MoeMixed {
    static constexpr bool HOOK = false; int G, c; const PG8_LAS int* tstart; const PG8_LAS int* cntl; const char* HB2p; const char* HIDp; const char* Wgu; const char* Wd; const int* TOKL; int rtA, nrt, rtB;
    __device__ bool next(int i, Unit& u) const {
        int L = i * G + c; const int n1 = (nrt - rtA) * 8; if (L >= n1 + rtB * 4) return false;
        int rt, pn, kind; if (L < n1) { rt = rtA + (L >> 3); pn = L & 7; kind = 0; } else { L -= n1; rt = L >> 2; pn = L & 3; kind = 1; }
        int e = 0;
        for (int q = 1; q < 32; ++q) e += (tstart[q] <= rt) ? 1 : 0;
        e = __builtin_amdgcn_readfirstlane(e);
        u.pm = rt; u.pn = pn; u.e = e; u.j = rt - tstart[e]; u.kind = kind;
        if (kind == 0) { u.a = HB2p; u.b = Wgu + ((size_t)e * 2048 + (size_t)pn * 256) * 2048; }
        else { u.a = HIDp; u.b = Wd + ((size_t)e * 1024 + (size_t)pn * 256) * 2048; }
        return true;
    }
    __device__ __forceinline__ int arow(const Unit& u, int r) const {
        if (u.kind) return u.pm * BM + r;
        const int pos = u.j * BM + r; return pos < cntl[u.e] ? (TOKL[u.e * M + pos] >> 2) : 0; }
};
struct EpiMixed {
    static constexpr bool AFTER_DRAIN = false; EpiFFN1 e1; EpiFFN2 e2;
    __device__ __forceinline__ void operator()(const Acc& acc, const Unit& u, int wr, int wc, int fr, int fq) const { if (u.kind == 0) e1(acc, u, wr, wc, fr, fq); else e2(acc, u, wr, wc, fr, fq); }
};
}

#define GAS __attribute__((address_space(1)))
#define LAS __attribute__((address_space(3)))
typedef unsigned v4u __attribute__((ext_vector_type(4)));
typedef float f32x4 __attribute__((ext_vector_type(4)));
typedef GAS unsigned gu32;
typedef short bf16x8 __attribute__((ext_vector_type(8)));
typedef float f32x16 __attribute__((ext_vector_type(16)));
#ifndef NVGPR_CAP
#define NVGPR_CAP 256
#endif
constexpr int NWAVES = 8, NTHR = 512;
constexpr int RING_BYTES = 131072, LDS_BYTES = 163840, LDSCTL_OFF = LDS_BYTES - 512;
constexpr int LW_BAR = 0, LW_TSTART = 16, LW_CNT = 64, LW_NWORDS = 128;
constexpr int CW_BAR = 1024;

#define XB_TMO      128
#define XB_XCNT(j)  (256  + 64 * (j))
#define XB_XSUB(j)  (1280 + 64 * (j))
#define XB_XGEN(j)  (2304 + 64 * (j))
#define XB_TOP      3328
#define XB_TOPGEN   3392
#define XCD_BAR_WORDS 3456
#define XB_SPIN_CAP (1u << 18)
__device__ __forceinline__ unsigned xb_ld(unsigned* p)              { return __hip_atomic_load(p, __ATOMIC_RELAXED, __HIP_MEMORY_SCOPE_AGENT); }
__device__ __forceinline__ unsigned xb_add(unsigned* p, unsigned v) { return __hip_atomic_fetch_add(p, v, __ATOMIC_RELAXED, __HIP_MEMORY_SCOPE_AGENT); }
__device__ __forceinline__ unsigned xb_xcc_id() { return (unsigned)__builtin_amdgcn_s_getreg((3 << 11) | 20) & 0xFu; }
#define XB_SPIN(cond, bar) do { unsigned _sp = 0; while (cond) { __builtin_amdgcn_s_sleep(1); \
    if ((++_sp & 255u) == 0u) { if (xb_ld(&(bar)[XB_TMO])) break; if (_sp > XB_SPIN_CAP) { atomicAdd(&(bar)[XB_TMO], 1u); break; } } } } while (0)
struct XcdBarrier { unsigned* bar; unsigned x; volatile LAS unsigned* st; };
__device__ __forceinline__ XcdBarrier xcd_barrier_post(unsigned* bar, volatile LAS unsigned* st) {
    XcdBarrier b; b.bar = bar; b.x = xb_xcc_id(); b.st = st;
    if (threadIdx.x == 0) (void)xb_add(&bar[XB_XCNT(b.x)], 1u);
    return b;
}
__device__ __forceinline__ void xcd_barrier_complete(unsigned* bar, unsigned x, unsigned& nloc, unsigned& nx) {
    const unsigned G = gridDim.x * gridDim.y * gridDim.z;
    unsigned sum, cnt, mine, sp = 0u;
    for (;;) {
        sum = 0u; cnt = 0u; mine = 0u;
#pragma unroll
        for (unsigned j = 0; j < 16; ++j) { const unsigned c = xb_ld(&bar[XB_XCNT(j)]); sum += c; cnt += (c > 0u) ? 1u : 0u; mine = (j == x) ? c : mine; }
        if (sum == G) break;
        __builtin_amdgcn_s_sleep(1);
        if ((++sp & 255u) == 0u) { if (xb_ld(&bar[XB_TMO])) break; if (sp > XB_SPIN_CAP) { atomicAdd(&bar[XB_TMO], 1u); break; } }
    }
    nloc = mine > 0u ? mine : 1u; nx = cnt > 0u ? cnt : 1u;
}
__device__ __forceinline__ void xcd_barrier(const XcdBarrier& b) {
    asm volatile("s_waitcnt vmcnt(0)" ::: "memory");
    __syncthreads();
    if (threadIdx.x == 0) {
        unsigned* bar = b.bar;
        __builtin_amdgcn_s_waitcnt(0);
        unsigned nloc = b.st[0], nx = b.st[1];
        if (nloc == 0u) { xcd_barrier_complete(bar, b.x, nloc, nx); b.st[0] = nloc; b.st[1] = nx; }
        const unsigned old = xb_add(&bar[XB_XSUB(b.x)], 1u);
        const unsigned gen = old / nloc;
        if (old + 1u == (gen + 1u) * nloc) {
            __builtin_amdgcn_fence(__ATOMIC_RELEASE, "agent");
            asm volatile("s_waitcnt vmcnt(0)" ::: "memory");
            const unsigned og = xb_add(&bar[XB_TOP], 1u);
            const unsigned tg = og / nx;
            if (og + 1u == (tg + 1u) * nx) xb_add(&bar[XB_TOPGEN], 1u);
            else XB_SPIN(xb_ld(&bar[XB_TOPGEN]) == tg, bar);
            __builtin_amdgcn_fence(__ATOMIC_ACQUIRE, "agent");
            xb_add(&bar[XB_XGEN(b.x)], 1u);
            asm volatile("s_waitcnt vmcnt(0)" ::: "memory");
        } else {
            XB_SPIN(xb_ld(&bar[XB_XGEN(b.x)]) == gen, bar);
            __builtin_amdgcn_fence(__ATOMIC_ACQUIRE, "agent");
            asm volatile("s_waitcnt vmcnt(0)" ::: "memory");
        }
    }
    __syncthreads();
}

struct Args { const float* in[31]; float* out; unsigned char* ws; int ph_lo, ph_hi, bli, pad; };

#define LDS_WAIT() asm volatile("s_waitcnt lgkmcnt(0)" ::: "memory")
#define LDS_BARRIER() do { asm volatile("s_waitcnt lgkmcnt(0)" ::: "memory"); __builtin_amdgcn_s_barrier(); asm volatile("" ::: "memory"); } while (0)
__device__ __forceinline__ unsigned pk2(float lo, float hi) { return cvtpk_s(lo, hi); }
__device__ __forceinline__ void transpose_item(const float* W, int ldn, int col0, int k0, bf16* dst, int pitch, const float* gain, LAS float* scr, int lane) {
#pragma unroll 8
    for (int i = 0; i < 32; ++i) { const int kk = 2 * i + (lane >> 5); float v = W[(size_t)(k0 + kk) * ldn + col0 + (lane & 31)]; if (gain) v *= gain[k0 + kk]; scr[kk * 33 + (lane & 31)] = v; }
    LDS_WAIT(); asm volatile("" ::: "memory");
    const int c = lane & 7;
#pragma unroll
    for (int j = 0; j < 4; ++j) { const int n = (lane >> 3) + 8 * j; const LAS float* s = scr + (8 * c) * 33 + n;
        v4u o; o.x = pk2(s[0 * 33], s[1 * 33]); o.y = pk2(s[2 * 33], s[3 * 33]); o.z = pk2(s[4 * 33], s[5 * 33]); o.w = pk2(s[6 * 33], s[7 * 33]);
        *(GAS v4u*)(dst + (size_t)n * pitch + k0 + 8 * c) = o; }
    LDS_WAIT(); asm volatile("" ::: "memory");
}

__device__ __forceinline__ const float* arg_in(const Args& a, int k) { asm volatile("" : "+s"(k)); return a.in[k]; }
#define INP(k) arg_in(args, k)
#define PHASE_PTRS unsigned char* wsl = args.ws; asm volatile("" : "+s"(wsl)); float* out = args.out; asm volatile("" : "+s"(out)); unsigned* ctl = (unsigned*)(wsl + WS_CTL); const float *x = INP(0), *mem = INP(1), *norm_mix = INP(2), *w_in = INP(3), *w_out = INP(15), *norm_cross = INP(16), *norm_mem = INP(17), *w_cq = INP(18), *w_ckv = INP(19), *w_co = INP(20); const float *norm_moe = INP(21), *w_router = INP(22), *w_gate = INP(24), *b_gate = INP(25), *w_up = INP(26), *b_up = INP(27), *w_down = INP(28), *b_down = INP(29), *norm_final = INP(30); float* ss1 = (float*)(wsl + WS_SSP1); float* ss2 = (float*)(wsl + WS_SSP2); bf16 *Win_t = (bf16*)(wsl + WS_WIN), *Wout_t = (bf16*)(wsl + WS_WOUT), *Wcq_t = (bf16*)(wsl + WS_WCQ), *Wckv_t = (bf16*)(wsl + WS_WCKV), *Wco_t = (bf16*)(wsl + WS_WCO), *Wgu_t = (bf16*)(wsl + WS_WGU), *Wd_t = (bf16*)(wsl + WS_WD); bf16 *XN = (bf16*)(wsl + WS_XN), *MIX = XN, *HB2 = XN, *PROJ = (bf16*)(wsl + WS_PROJ), *HB = (bf16*)(wsl + WS_HB), *Qb = (bf16*)(wsl + WS_Q), *Pb = (bf16*)(wsl + WS_P), *HID = (bf16*)(wsl + WS_HID); bf16 *O2 = (bf16*)(wsl + WS_O2), *Y = (bf16*)(wsl + WS_Y), *MEMN = (bf16*)(wsl + WS_MEMN), *KM = (bf16*)(wsl + WS_KM), *VT = (bf16*)(wsl + WS_VT); const float *dn_conv = INP(4), *dn_a_log = INP(5), *dn_dt_bias = INP(6), *dn_norm = INP(7), *rg_conv = INP(8), *rg_conv_b = INP(9); const float *rg_w_a = INP(10), *rg_b_a = INP(11), *rg_w_x = INP(12), *rg_b_x = INP(13), *rg_lambda = INP(14), *b_router = INP(23); float* QKVN = (float*)(wsl + WS_QKVN); float* ODN = (float*)(wsl + WS_ODN); float* BAf = (float*)(wsl + WS_BA); float* AA = out; float* BX = out + (size_t)M * 512; const int* TOKL = (const int*)(wsl + WS_TOKL); const float* GATEL = (const float*)(wsl + WS_GATEL); const float* RSL = (const float*)(wsl + WS_RSL); (void)ctl;
template <bool NT = false> __device__ __forceinline__ void transpose_item64(const float* W, int ldn, int col0, int k0, bf16* dst, int pitch, const float* gain, LAS float* scr, int lane) {
    f32x4 v[16];
#pragma unroll
    for (int i = 0; i < 16; ++i) { const int kk = (lane >> 4) + 4 * i; const f32x4* p = (const f32x4*)(W + (size_t)(k0 + kk) * ldn + col0 + 4 * (lane & 15)); v[i] = NT ? __builtin_nontemporal_load(p) : *p; }
#pragma unroll
    for (int i = 0; i < 16; ++i) { const int kk = (lane >> 4) + 4 * i; f32x4 w = v[i]; if (gain) w = w * gain[k0 + kk]; LAS float* p = scr + kk * 65 + 4 * (lane & 15); p[0] = w[0]; p[1] = w[1]; p[2] = w[2]; p[3] = w[3]; }
    LDS_WAIT(); asm volatile("" ::: "memory");
    const int c = lane & 7;
#pragma unroll
    for (int j = 0; j < 8; ++j) { const int n = (lane >> 3) + 8 * j; const LAS float* sp = scr + (8 * c) * 65 + n;
        v4u o; o.x = pk2(sp[0 * 65], sp[1 * 65]); o.y = pk2(sp[2 * 65], sp[3 * 65]); o.z = pk2(sp[4 * 65], sp[5 * 65]); o.w = pk2(sp[6 * 65], sp[7 * 65]);
        GAS v4u* q = (GAS v4u*)(dst + (size_t)n * pitch + k0 + 8 * c); if (NT) __builtin_nontemporal_store(o, q); else *q = o; }
    LDS_WAIT(); asm volatile("" ::: "memory");
}
__global__ void __launch_bounds__(NTHR, 2) mk_fwd(Args args) {
    extern __shared__ __attribute__((aligned(16))) unsigned char lds_raw[];
    LAS unsigned char* lds = (LAS unsigned char*)lds_raw;
    volatile LAS unsigned* LW = (volatile LAS unsigned*)(lds + LDSCTL_OFF);
    const int tid = threadIdx.x, lane = tid & 63, wave = __builtin_amdgcn_readfirstlane(tid >> 6), G = gridDim.x, bx = blockIdx.x;
    for (int u = tid; u < LW_NWORDS; u += NTHR) LW[u] = 0u;
    __syncthreads();
    XcdBarrier bar = xcd_barrier_post((unsigned*)(args.ws + WS_CTL) + CW_BAR + args.bli * XCD_BAR_WORDS, LW + LW_BAR);
    const int lo = args.ph_lo, hi = args.ph_hi;
#define STAMP(k) do { if (TS_LO >= 0 && blockIdx.x == 0 && threadIdx.x == 0) { unsigned char* w_ = args.ws; asm volatile("" : "+s"(w_)); __hip_atomic_store((unsigned long long*)(w_ + WS_TS) + (k), __builtin_amdgcn_s_memrealtime(), __ATOMIC_RELAXED, __HIP_MEMORY_SCOPE_AGENT); } } while (0)
    STAMP(0);
#ifndef DOUBLE_PHASE
#define DOUBLE_PHASE -1
#endif
#define REPS(k) ((DOUBLE_PHASE == (k)) ? 2 : 1)
#ifndef SKIPMASK
#define SKIPMASK 0
#endif
#define IN(k) (!((SKIPMASK >> (k)) & 1) && lo <= (k) && (k) < hi)
#define SEAM(k) do { if (IN(k) && IN((k) + 1)) xcd_barrier(bar); } while (0)
    const int gw = bx * NWAVES + wave, NGW = G * NWAVES;

    if (IN(0)) {
        PHASE_PTRS
        LAS float* w8 = (LAS float*)lds;
        for (int i = tid; i < D * 8; i += NTHR) w8[(i & 7) * D + (i >> 3)] = w_in[(size_t)(i >> 3) * NIN + 2048 + (i & 7)];
        __syncthreads();
        float* BA = (float*)(wsl + WS_BA);
        for (int rp = gw; rp < M / 2; rp += NGW) {
            f32x4 v[2][4]; float ssq[2];
#pragma unroll
            for (int r2 = 0; r2 < 2; ++r2)
#pragma unroll
                for (int j = 0; j < 4; ++j) v[r2][j] = *(const f32x4*)(x + (size_t)(2 * rp + r2) * D + 4 * lane + 256 * j);
#pragma unroll
            for (int r2 = 0; r2 < 2; ++r2) { float sq = 0.f;
#pragma unroll
                for (int j = 0; j < 4; ++j) sq += (v[r2][j][0] * v[r2][j][0] + v[r2][j][1] * v[r2][j][1]) + (v[r2][j][2] * v[r2][j][2] + v[r2][j][3] * v[r2][j][3]);
                ssq[r2] = sq; }
#pragma unroll
            for (int r2 = 0; r2 < 2; ++r2) { const int row = 2 * rp + r2; const float rstd = rsqrtf(wave_sum(ssq[r2]) * (1.f / D) + EPS); bf16* orow = XN + (size_t)row * D; float acc[8];
#pragma unroll
                for (int q = 0; q < 8; ++q) acc[q] = 0.f;
#pragma unroll
                for (int j = 0; j < 4; ++j) { const f32x4 gg = *(const f32x4*)(norm_mix + 4 * lane + 256 * j); const f32x4 u = v[r2][j] * rstd * gg;
                    *(unsigned long long*)(orow + 4 * lane + 256 * j) = (unsigned long long)pk2(u[0], u[1]) | ((unsigned long long)pk2(u[2], u[3]) << 32);
#pragma unroll
                    for (int q = 0; q < 8; ++q) { const f32x4 wq = *(const LAS f32x4*)(w8 + q * D + 4 * lane + 256 * j); acc[q] += (u[0] * wq[0] + u[1] * wq[1]) + (u[2] * wq[2] + u[3] * wq[3]); } }
#pragma unroll
                for (int q = 0; q < 8; ++q) { const float t = wave_sum(acc[q]); if (lane == q) BA[(size_t)row * 8 + q] = t; } }
        }
        for (int row = gw; row < NB * MEML; row += NGW) { const float* xr = mem + (size_t)row * D; bf16* orow = MEMN + (size_t)row * D; f32x4 v[4]; float sq = 0.f;
#pragma unroll
            for (int j = 0; j < 4; ++j) { v[j] = *(const f32x4*)(xr + 4 * lane + 256 * j); sq += (v[j][0] * v[j][0] + v[j][1] * v[j][1]) + (v[j][2] * v[j][2] + v[j][3] * v[j][3]); }
            const float rstd = rsqrtf(wave_sum(sq) * (1.f / D) + EPS);
#pragma unroll
            for (int j = 0; j < 4; ++j) { const f32x4 gg = *(const f32x4*)(norm_mem + 4 * lane + 256 * j); const f32x4 u = v[j] * rstd * gg;
                *(unsigned long long*)(orow + 4 * lane + 256 * j) = (unsigned long long)pk2(u[0], u[1]) | ((unsigned long long)pk2(u[2], u[3]) << 32); } }
        __syncthreads();
        { LAS float* scr = (LAS float*)(lds + wave * 16640);
          constexpr int I_IN = 16 * 48, I_SQ = 16 * 16, I_KV = 16 * 32;
          constexpr int NIT = I_IN + 3 * I_SQ + I_KV + 16;
          for (int it = NGW - 1 - gw; it < NIT; it += NGW) {
            int r = it;
            if (r < I_IN) { const int kb = r / 48, nb = r % 48, n0 = nb * 64; transpose_item64(w_in, NIN, n0 < 2048 ? n0 : n0 + 8, kb * 64, Win_t + (size_t)n0 * D, D, nullptr, scr, lane); continue; } r -= I_IN;
            if (r < I_SQ) { const int kb = r / 16, nb = r % 16; transpose_item64(w_out, D, nb * 64, kb * 64, Wout_t + (size_t)nb * 64 * D, D, nullptr, scr, lane); continue; } r -= I_SQ;
            if (r < I_SQ) { const int kb = r / 16, nb = r % 16; transpose_item64(w_cq, D, nb * 64, kb * 64, Wcq_t + (size_t)nb * 64 * D, D, norm_cross, scr, lane); continue; } r -= I_SQ;
            if (r < I_SQ) { const int kb = r / 16, nb = r % 16; transpose_item64(w_co, D, nb * 64, kb * 64, Wco_t + (size_t)nb * 64 * D, D, nullptr, scr, lane); continue; } r -= I_SQ;
            if (r < I_KV) { const int kb = r / 32, nb = r % 32; transpose_item64(w_ckv, 2048, nb * 64, kb * 64, Wckv_t + (size_t)nb * 64 * D, D, nullptr, scr, lane); continue; } r -= I_KV;
            { const int mat = r >> 1, kb = r & 1, gate = mat >> 2, nbk = mat & 3;
              transpose_item64((gate ? rg_w_x : rg_w_a) + (size_t)nbk * 128 * 128, 128, 0, kb * 64, (bf16*)(wsl + WS_RGW) + (size_t)mat * 128 * 128, 128, nullptr, scr, lane);
              transpose_item64((gate ? rg_w_x : rg_w_a) + (size_t)nbk * 128 * 128, 128, 64, kb * 64, (bf16*)(wsl + WS_RGW) + ((size_t)mat * 128 + 64) * 128, 128, nullptr, scr, lane); }
          }
          bf16* WRh = (bf16*)(wsl + WS_WR); bf16* WRl = WRh + NE * D;
          for (int i = bx * NTHR + tid; i < NE * D; i += G * NTHR) { const int e = i >> 10, k = i & 1023; const float v = w_router[k * NE + e] * norm_moe[k]; const bf16 hv = f2bf(v); WRh[i] = hv; WRl[i] = f2bf(v - bf2f(hv)); } }
    }
    SEAM(0);
    STAMP(1);
    if (IN(1)) {
        PHASE_PTRS
        { pg8::Gemm g{D, D, D}; pg8::StaticOrder S; S.init(XN, Win_t, M, NP, D, D, G, bx); S.rep = REPS(1); pg8::EpiStore E{PROJ, NP};
          pg8::gemm_phase<pg8::EpiStore, pg8::StaticOrder, true, false>(lds, g, S, E); }
    }
    SEAM(1);
    STAMP(2);
    if (IN(2)) {
        PHASE_PTRS
        for (int unit_ = bx; unit_ < NB * 64 * REPS(2); unit_ += G) { const int unit = unit_ & 255;
            const int b = unit >> 6, n = unit & 63; const size_t row0 = (size_t)b * T + n * 64;
            for (int itp = 0; itp < 2; ++itp) {
                const int half = __builtin_amdgcn_readfirstlane(tid >> 8), ht = tid & 255, hw = wave & 3, h = itp * 2 + half;
                LAS unsigned char* HL = lds + half * 53248;
                LAS bf16* QN = (LAS bf16*)HL; LAS bf16* KN = (LAS bf16*)(HL + 17408); LAS float* AL = (LAS float*)(HL + 34816); LAS float* GC = (LAS float*)(HL + 52224); LAS float* BT = GC + 64;
                unsigned char* ub = wsl + WS_DN + (size_t)((b * 4 + h) * 64 + n) * DNU_BYTES;
                if (hw == 0) { int lanev = lane; asm volatile("" : "+v"(lanev)); const size_t row = row0 + lanev; const float beta = sigmoidf_(BAf[row * 8 + h]); float gv = -__expf(dn_a_log[h]) * softplusf_(BAf[row * 8 + 4 + h] + dn_dt_bias[h]);
#pragma unroll
                    for (int o = 1; o < 64; o <<= 1) { const float tv = __shfl_up(gv, o); if (lanev >= o) gv += tv; }
                    GC[lanev] = gv; BT[lanev] = beta; }
                { const int gch = ht & 15;
#pragma unroll
                  for (int tensor = 0; tensor < 2; ++tensor) { const int cb = tensor * 512 + h * 128 + gch * 8; float wv[4][8];
#pragma unroll
                    for (int j = 0; j < 4; ++j) { const f32x4 w0 = *(const f32x4*)(dn_conv + j * 1536 + cb), w1 = *(const f32x4*)(dn_conv + j * 1536 + cb + 4);
                        wv[j][0] = w0[0]; wv[j][1] = w0[1]; wv[j][2] = w0[2]; wv[j][3] = w0[3]; wv[j][4] = w1[0]; wv[j][5] = w1[1]; wv[j][6] = w1[2]; wv[j][7] = w1[3]; }
#pragma unroll
                    for (int ii = 0; ii < 4; ++ii) { const int c = (ht >> 4) + 16 * ii, t = n * 64 + c; float a8[8];
#pragma unroll
                        for (int e = 0; e < 8; ++e) a8[e] = 0.f;
                        v4u prv[4];
#pragma unroll
                        for (int j = 0; j < 4; ++j) { const int tt = t + j - 3; prv[j] = *(const v4u*)(PROJ + ((size_t)b * T + (tt < 0 ? 0 : tt)) * NP + cb); }
#pragma unroll
                        for (int j = 0; j < 4; ++j) { const float m = (t + j - 3 >= 0) ? 1.f : 0.f;
#pragma unroll
                                for (int e = 0; e < 4; ++e) { a8[2 * e] += wv[j][2 * e] * m * bf2f((bf16)(prv[j][e] & 0xffff)); a8[2 * e + 1] += wv[j][2 * e + 1] * m * bf2f((bf16)(prv[j][e] >> 16)); } }
                        float ssq = 0.f;
#pragma unroll
                        for (int e = 0; e < 8; ++e) { a8[e] = siluf_(a8[e]); ssq += a8[e] * a8[e]; }
                        ssq += __shfl_xor(ssq, 1); ssq += __shfl_xor(ssq, 2); ssq += __shfl_xor(ssq, 4); ssq += __shfl_xor(ssq, 8);
                        const float rn = rsqrtf(ssq + EPS); v4u o; o.x = pk2(a8[0] * rn, a8[1] * rn); o.y = pk2(a8[2] * rn, a8[3] * rn); o.z = pk2(a8[4] * rn, a8[5] * rn); o.w = pk2(a8[6] * rn, a8[7] * rn);
                        *(LAS v4u*)((tensor ? KN : QN) + c * 136 + gch * 8) = o; } } }
                LDS_BARRIER();
                if (hw < 3) { const int ci = hw == 0 ? 0 : 1, si = hw == 2 ? 1 : 0; int l31 = lane & 31, hh = lane >> 5; asm volatile("" : "+v"(l31), "+v"(hh)); f32x16 kk, qk;
#pragma unroll
                    for (int r = 0; r < 16; ++r) { kk[r] = 0.f; qk[r] = 0.f; }
#pragma unroll
                    for (int ks = 0; ks < 8; ++ks) { const bf16x8 ak = *(const LAS bf16x8*)(KN + (32 * ci + l31) * 136 + 16 * ks + 8 * hh), aq = *(const LAS bf16x8*)(QN + (32 * ci + l31) * 136 + 16 * ks + 8 * hh);
                        const bf16x8 bk = *(const LAS bf16x8*)(KN + (32 * si + l31) * 136 + 16 * ks + 8 * hh);
                        kk = __builtin_amdgcn_mfma_f32_32x32x16_bf16(ak, bk, kk, 0, 0, 0); qk = __builtin_amdgcn_mfma_f32_32x32x16_bf16(aq, bk, qk, 0, 0, 0); }
                    const int sc = 32 * si + l31; const float gs = GC[sc]; bf16* QKg = (bf16*)(ub + DNU_QK);
#pragma unroll
                    for (int r = 0; r < 16; ++r) { const int c = 32 * ci + (r & 3) + 8 * (r >> 2) + 4 * hh; const float dec = c >= sc ? __expf(GC[c] - gs) : 0.f;
                        AL[c * 68 + sc] = c > sc ? BT[c] * kk[r] * dec : 0.f; QKg[c * 64 + kperm(sc)] = f2bf(qk[r] * 0.08838834764831845f * dec); } }
                LDS_BARRIER();
                { float xs[64];
                  if (ht < 128) { const int cv = PC_V + h * 128 + ht; const float w0 = dn_conv[cv], w1 = dn_conv[1536 + cv], w2 = dn_conv[2 * 1536 + cv], w3 = dn_conv[3 * 1536 + cv];
                      float p3 = 0.f, p2 = 0.f, p1 = 0.f; if (n > 0) { p3 = bf2f(PROJ[(row0 - 3) * NP + cv]); p2 = bf2f(PROJ[(row0 - 2) * NP + cv]); p1 = bf2f(PROJ[(row0 - 1) * NP + cv]); }
                      const bf16* pp = PROJ + row0 * NP + cv;
#pragma unroll
                      for (int c = 0; c < 64; ++c) { xs[c] = bf2f(*pp); pp += NP; asm volatile("" : "+v"(pp)); }
#pragma unroll
                      for (int c = 0; c < 64; ++c) { const float cu = xs[c]; xs[c] = siluf_(w0 * p3 + w1 * p2 + w2 * p1 + w3 * cu) * BT[c]; p3 = p2; p2 = p1; p1 = cu; } }
                  else { const int dk = ht - 128;
#pragma unroll
                      for (int c = 0; c < 64; ++c) xs[c] = bf2f(KN[c * 136 + dk]) * BT[c] * __expf(GC[c]); }
#pragma unroll
                  for (int i = 1; i < 64; ++i) { float pa[4] = {0.f, 0.f, 0.f, 0.f};
#pragma unroll
                      for (int j = 0; j < i; ++j) pa[j & 3] += AL[i * 68 + j] * xs[j];
                      xs[i] -= (pa[0] + pa[1]) + (pa[2] + pa[3]); }
                  if (ht < 128) { bf16* UT = (bf16*)(ub + DNU_UT) + ht * 64;
#pragma unroll
                      for (int c8 = 0; c8 < 8; ++c8) { v4u o; o.x = pk2(xs[8 * c8], xs[8 * c8 + 1]); o.y = pk2(xs[8 * c8 + 2], xs[8 * c8 + 3]); o.z = pk2(xs[8 * c8 + 4], xs[8 * c8 + 5]); o.w = pk2(xs[8 * c8 + 6], xs[8 * c8 + 7]); *(v4u*)(UT + 8 * c8) = o; } }
                  else { bf16* Wn = (bf16*)(ub + DNU_WN) + kperm(ht - 128);
#pragma unroll
                      for (int c = 0; c < 64; ++c) { *Wn = f2bf(-xs[c]); Wn += 128; asm volatile("" : "+v"(Wn)); } } }
                { const int c = ht >> 2, d0 = (ht & 3) * 32; const float sc = 0.08838834764831845f * __expf(GC[c]); bf16* Qg = (bf16*)(ub + DNU_QG);
#pragma unroll
                  for (int q = 0; q < 4; ++q) { v4u o;
#pragma unroll
                      for (int e = 0; e < 4; ++e) { const int p0 = d0 + 8 * q + 2 * e; o[e] = pk2(bf2f(QN[c * 136 + kperm(p0)]) * sc, bf2f(QN[c * 136 + kperm(p0 + 1)]) * sc); }
                      *(v4u*)(Qg + c * 128 + d0 + 8 * q) = o; }
                  const int dk = ht >> 1, c0 = (ht & 1) * 32; const float gl = GC[63]; bf16* KdT = (bf16*)(ub + DNU_KDT);
#pragma unroll
                  for (int q = 0; q < 4; ++q) { v4u o;
#pragma unroll
                      for (int e = 0; e < 4; ++e) { const int ca = kperm(c0 + 8 * q + 2 * e), cb2 = kperm(c0 + 8 * q + 2 * e + 1); o[e] = pk2(bf2f(KN[ca * 136 + dk]) * __expf(gl - GC[ca]), bf2f(KN[cb2 * 136 + dk]) * __expf(gl - GC[cb2])); }
                      *(v4u*)(KdT + dk * 64 + c0 + 8 * q) = o; }
                  if (ht == 0) ((float*)(wsl + WS_DEC))[(b * 4 + h) * 64 + n] = __expf(gl); }
                LDS_BARRIER();
            }
            { LAS bf16* XRb = (LAS bf16*)lds; LAS unsigned* RI = (LAS unsigned*)(lds + 17408); const bf16* RGW = (const bf16*)(wsl + WS_RGW);
              for (int nbk = 0; nbk < 4; ++nbk) {
#pragma unroll
                for (int ii = 0; ii < 2; ++ii) { const int gch = tid & 15, c = (tid >> 4) + 32 * ii, t = n * 64 + c, cb = nbk * 128 + gch * 8; float a8[8];
                    { const f32x4 b0 = *(const f32x4*)(rg_conv_b + cb), b1 = *(const f32x4*)(rg_conv_b + cb + 4); a8[0] = b0[0]; a8[1] = b0[1]; a8[2] = b0[2]; a8[3] = b0[3]; a8[4] = b1[0]; a8[5] = b1[1]; a8[6] = b1[2]; a8[7] = b1[3]; }
#pragma unroll
                    for (int j = 0; j < 4; ++j) { const int tt = t + j - 3; const float m = tt >= 0 ? 1.f : 0.f; { const v4u pr = *(const v4u*)(PROJ + ((size_t)b * T + (tt < 0 ? 0 : tt)) * NP + PC_RX + cb); const f32x4 w0 = *(const f32x4*)(rg_conv + j * 512 + cb) * m, w1 = *(const f32x4*)(rg_conv + j * 512 + cb + 4) * m;
                            a8[0] += w0[0] * bf2f((bf16)(pr[0] & 0xffff)); a8[1] += w0[1] * bf2f((bf16)(pr[0] >> 16)); a8[2] += w0[2] * bf2f((bf16)(pr[1] & 0xffff)); a8[3] += w0[3] * bf2f((bf16)(pr[1] >> 16));
                            a8[4] += w1[0] * bf2f((bf16)(pr[2] & 0xffff)); a8[5] += w1[1] * bf2f((bf16)(pr[2] >> 16)); a8[6] += w1[2] * bf2f((bf16)(pr[3] & 0xffff)); a8[7] += w1[3] * bf2f((bf16)(pr[3] >> 16)); } }
                    v4u o; o.x = pk2(a8[0], a8[1]); o.y = pk2(a8[2], a8[3]); o.z = pk2(a8[4], a8[5]); o.w = pk2(a8[6], a8[7]); *(LAS v4u*)(XRb + c * 136 + gch * 8) = o; }
                LDS_BARRIER();
                { const int gate = wave >> 2, ot = wave & 3, l31 = lane & 31, hh = lane >> 5, outc = 32 * ot + l31, ch = nbk * 128 + outc; f32x16 ac[2];
#pragma unroll
                  for (int r = 0; r < 16; ++r) { ac[0][r] = 0.f; ac[1][r] = 0.f; }
                  const bf16* wrow = RGW + ((size_t)(gate * 4 + nbk) * 128 + outc) * 128 + 8 * hh;
#pragma unroll
                  for (int ks = 0; ks < 8; ++ks) { const bf16x8 bw = *(const bf16x8*)(wrow + 16 * ks);
#pragma unroll
                      for (int mt = 0; mt < 2; ++mt) ac[mt] = __builtin_amdgcn_mfma_f32_32x32x16_bf16(*(const LAS bf16x8*)(XRb + (32 * mt + l31) * 136 + 16 * ks + 8 * hh), bw, ac[mt], 0, 0, 0); }
                  const float bias = gate ? rg_b_x[ch] : rg_b_a[ch]; LAS bf16* RIh = (LAS bf16*)RI;
#pragma unroll
                  for (int mt = 0; mt < 2; ++mt)
#pragma unroll
                      for (int r = 0; r < 16; ++r) { const int c = 32 * mt + (r & 3) + 8 * (r >> 2) + 4 * hh; float v = sigmoidf_(ac[mt][r] + bias); if (gate) v *= bf2f(XRb[c * 136 + outc]);
                          RIh[(c * 516 + ch) * 2 + gate] = f2bf(v); } }
                LDS_BARRIER();
              }
              { const int ch = tid; const float lsl = -softplusf_(-rg_lambda[ch]); float hs = 0.f, cp = 1.f; bf16* HL = (bf16*)(wsl + WS_HLOC) + row0 * 512 + ch; bf16* CPg = (bf16*)(wsl + WS_CP) + row0 * 512 + ch;
#pragma unroll 4
                for (int c = 0; c < 64; ++c) { const unsigned w = RI[c * 516 + ch]; const float r = bf2f((bf16)(w & 0xffff)), ix = bf2f((bf16)(w >> 16)), a = __expf(8.f * r * lsl);
                    const float mult = (n == 0 && c == 0) ? 1.f : __builtin_amdgcn_sqrtf(fmaxf(1.f - a * a, 0.f)); hs = a * hs + mult * ix; cp *= a; *HL = f2bf(hs); *CPg = f2bf(cp); HL += 512; CPg += 512; asm volatile("" : "+v"(HL), "+v"(CPg)); }
                float* SUM = (float*)(wsl + WS_RGSUM); SUM[(size_t)(b * 64 + n) * 512 + ch] = cp; SUM[(size_t)(256 + b * 64 + n) * 512 + ch] = hs; }
              LDS_BARRIER();
            }
        }
    }
    SEAM(2);
    STAMP(3);
    if (IN(3)) {
        PHASE_PTRS
        if (bx < 16) {
            const int b = bx >> 2, h = bx & 3, l31 = lane & 31, hh = lane >> 5, sl = wave;
            const unsigned char* ubase = wsl + WS_DN + (size_t)((b * 4 + h) * 64) * DNU_BYTES; const float* DECp = (const float*)(wsl + WS_DEC) + (b * 4 + h) * 64;
            unsigned a256[8], a128[4];
#pragma unroll
            for (int ks = 0; ks < 8; ++ks) a256[ks] = (unsigned)(l31 * 256 + 16 * ((2 * ks + hh) ^ (l31 & 15)));
#pragma unroll
            for (int ks = 0; ks < 4; ++ks) a128[ks] = (unsigned)(l31 * 128 + 16 * ((2 * ks + hh) ^ ((l31 >> 1) & 7)));
            const unsigned t7 = (unsigned)((l31 >> 1) & 7), utrow = (unsigned)((32 * (sl & 3) + l31) * 128 + 8 * hh);
            const int lw = wave & 3;
            v4u R0[18], R1[18];
#define DN_LD(R, nn) do { const unsigned char* _g = ubase + (size_t)(nn) * DNU_BYTES + lw * 1024 + lane * 16; _Pragma("unroll") for (int _i = 0; _i < 18; ++_i) { \
                asm volatile("global_load_dwordx4 %0, %1, off" : "=v"(R[_i]) : "v"(_g) : "memory"); _g += 4096; asm volatile("" : "+v"(_g)); } } while (0)
#define DN_LWAIT(R, cnt) asm volatile("s_waitcnt vmcnt(" #cnt ")" : "+v"(R[0]), "+v"(R[1]), "+v"(R[2]), "+v"(R[3]), "+v"(R[4]), "+v"(R[5]), "+v"(R[6]), "+v"(R[7]), "+v"(R[8]), "+v"(R[9]), \
                "+v"(R[10]), "+v"(R[11]), "+v"(R[12]), "+v"(R[13]), "+v"(R[14]), "+v"(R[15]), "+v"(R[16]), "+v"(R[17]) :: "memory")
#define DN_WR(R, buf) do { int _lv = lane; asm volatile("" : "+v"(_lv)); _Pragma("unroll") for (int _i = 0; _i < 18; ++_i) { const int _p = lw + 4 * _i, _q = _p * 64 + _lv; int _slot; \
                if (_i < 8) { const int _r = _q >> 4; _slot = _r * 16 + ((_q & 15) ^ (_r & 15)); } else { const int _r = _q >> 3; _slot = _r * 8 + ((_q & 7) ^ ((_r >> 1) & 7)); } \
                *(LAS v4u*)(lds + (buf) * DNU_BYTES + _slot * 16) = R[_i]; } } while (0)
            f32x16 S[4];
#pragma unroll
            for (int t = 0; t < 4; ++t)
#pragma unroll
                for (int r = 0; r < 16; ++r) S[t][r] = 0.f;
            const float decv = DECp[lane];
#define DN_FADDR(i) ((i) < 16 ? (L + DNU_WN + ((i) & 1) * 8192 + a256[(i) >> 1]) : (i) < 32 ? (L + DNU_QG + (((i) - 16) & 1) * 8192 + a256[((i) - 16) >> 1]) : \
                     (i) < 48 ? (L + DNU_KDT + (((i) - 32) >> 2) * 4096 + a128[((i) - 32) & 3]) : ((i) < 50 ? (L + DNU_QK + a128[(i) - 48]) : (L + DNU_QK + 4096 + a128[(i) - 50])))
#define DN_COMPUTE(n) do { constexpr int FD = 6; \
                    const LAS unsigned char* L = lds + ((n) & 1) * DNU_BYTES; const float dcy = __builtin_bit_cast(float, __builtin_amdgcn_readlane(__builtin_bit_cast(int, decv), (n))); const size_t row0 = (size_t)b * T + (n) * 64; \
                    bf16x8 fr[8]; \
                    _Pragma("unroll") for (int i = 0; i < FD; ++i) fr[i] = *(const LAS bf16x8*)DN_FADDR(i); \
                    bf16x8 Sb[8]; \
                    _Pragma("unroll") for (int t = 0; t < 4; ++t) _Pragma("unroll") for (int s2 = 0; s2 < 2; ++s2) { v4u w; w.x = cvtpk_s(S[t][8 * s2], S[t][8 * s2 + 1]); w.y = cvtpk_s(S[t][8 * s2 + 2], S[t][8 * s2 + 3]); \
                            w.z = cvtpk_s(S[t][8 * s2 + 4], S[t][8 * s2 + 5]); w.w = cvtpk_s(S[t][8 * s2 + 6], S[t][8 * s2 + 7]); Sb[2 * t + s2] = __builtin_bit_cast(bf16x8, w); } \
                    f32x16 VN[2], O[2]; \
                    _Pragma("unroll") for (int mt = 0; mt < 2; ++mt) _Pragma("unroll") for (int g4 = 0; g4 < 4; ++g4) { const unsigned long long uu = *(const LAS unsigned long long*)(L + DNU_UT + utrow + 16 * ((unsigned)(4 * mt + g4) ^ t7)); \
                            VN[mt][4 * g4] = bf2f((bf16)(uu & 0xffff)); VN[mt][4 * g4 + 1] = bf2f((bf16)((uu >> 16) & 0xffff)); VN[mt][4 * g4 + 2] = bf2f((bf16)((uu >> 32) & 0xffff)); VN[mt][4 * g4 + 3] = bf2f((bf16)(uu >> 48)); } \
                    _Pragma("unroll") for (int r = 0; r < 16; ++r) { O[0][r] = 0.f; O[1][r] = 0.f; } \
                    bf16x8 vb[4]; \
                    __builtin_amdgcn_sched_group_barrier(0x100, FD, 0); \
                    _Pragma("clang loop unroll(full)") for (int i = 0; i < 54; ++i) { \
                        const bf16x8 fa = fr[i & 7]; \
                        if (i + FD < 54) fr[(i + FD) & 7] = *(const LAS bf16x8*)DN_FADDR(i + FD); \
                        if (i < 16) VN[i & 1] = __builtin_amdgcn_mfma_f32_32x32x16_bf16(fa, Sb[i >> 1], VN[i & 1], 0, 0, 0); \
                        else if (i < 32) O[(i - 16) & 1] = __builtin_amdgcn_mfma_f32_32x32x16_bf16(fa, Sb[(i - 16) >> 1], O[(i - 16) & 1], 0, 0, 0); \
                        else if (i < 48) S[(i - 32) >> 2] = __builtin_amdgcn_mfma_f32_32x32x16_bf16(fa, vb[(i - 32) & 3], S[(i - 32) >> 2], 0, 0, 0); \
                        else if (i < 50) O[0] = __builtin_amdgcn_mfma_f32_32x32x16_bf16(fa, vb[i - 48], O[0], 0, 0, 0); \
                        else O[1] = __builtin_amdgcn_mfma_f32_32x32x16_bf16(fa, vb[i - 50], O[1], 0, 0, 0); \
                        __builtin_amdgcn_sched_group_barrier(0x008, 1, 0); if (i + FD < 54) __builtin_amdgcn_sched_group_barrier(0x100, 1, 0); \
                        if (i == 23) { \
                            _Pragma("unroll") for (int mt = 0; mt < 2; ++mt) _Pragma("unroll") for (int s2 = 0; s2 < 2; ++s2) { v4u w; w.x = cvtpk_s(VN[mt][8 * s2], VN[mt][8 * s2 + 1]); w.y = cvtpk_s(VN[mt][8 * s2 + 2], VN[mt][8 * s2 + 3]); \
                                    w.z = cvtpk_s(VN[mt][8 * s2 + 4], VN[mt][8 * s2 + 5]); w.w = cvtpk_s(VN[mt][8 * s2 + 6], VN[mt][8 * s2 + 7]); vb[2 * mt + s2] = __builtin_bit_cast(bf16x8, w); } \
                            _Pragma("unroll") for (int t = 0; t < 4; ++t) S[t] = S[t] * dcy; } } \
                    _Pragma("unroll") for (int mt = 0; mt < 2; ++mt) { GAS float* op = (GAS float*)ODN + (row0 + 32 * mt + 4 * hh) * 512 + h * 128 + 32 * sl + l31; \
                        _Pragma("unroll") for (int r = 0; r < 16; ++r) op[(size_t)((r & 3) + 8 * (r >> 2)) * 512] = O[mt][r]; } \
                } while (0)
#define DN_BAR() do { asm volatile("s_waitcnt lgkmcnt(0)" ::: "memory"); __builtin_amdgcn_s_barrier(); asm volatile("" ::: "memory"); } while (0)
            if (wave >= 4) {
#define DN_LSTEP(n, RL, RW) do { if ((n) + 2 < 64) DN_LD(RL, (n) + 2); \
                    if ((n) + 1 < 64) { if ((n) + 2 < 64) DN_LWAIT(RW, 18); else DN_LWAIT(RW, 0); DN_WR(RW, ((n) + 1) & 1); } \
                    DN_BAR(); } while (0)
                DN_LD(R0, 0); DN_LD(R1, 1); DN_LWAIT(R0, 18); DN_WR(R0, 0);
                DN_BAR();
#pragma clang loop unroll(full)
                for (int n2 = 0; n2 < 64; n2 += 2) { DN_LSTEP(n2, R0, R1); DN_LSTEP(n2 + 1, R1, R0); }
#undef DN_LSTEP
            } else {
                DN_BAR();
                for (int n = 0; n < 64; ++n) { DN_COMPUTE(n); DN_BAR(); }
            }
            asm volatile("s_waitcnt vmcnt(0)" ::: "memory");
#undef DN_BAR
#undef DN_LD
#undef DN_LWAIT
#undef DN_WR
#undef DN_FADDR
#undef DN_COMPUTE
        } else if (bx < 20) {
            const int b = bx - 16, ch = tid; const float* SUM = (const float*)(wsl + WS_RGSUM); float* CARRY = (float*)(wsl + WS_CARRY); float carry = 0.f;
            for (int n0 = 0; n0 < 64; n0 += 8) { float ap[8], he[8];
#pragma unroll
                for (int j = 0; j < 8; ++j) { ap[j] = SUM[(size_t)(b * 64 + n0 + j) * 512 + ch]; he[j] = SUM[(size_t)(256 + b * 64 + n0 + j) * 512 + ch]; }
#pragma unroll
                for (int j = 0; j < 8; ++j) { CARRY[(size_t)(b * 64 + n0 + j) * 512 + ch] = carry; carry = ap[j] * carry + he[j]; } }
        } else if (bx < 52) {
            if (bx < 36) { pg8::Gemm g{D, D, D}; pg8::StaticOrder S; S.init(MEMN, Wckv_t, NB * MEML, D, D, D, 16, bx - 20); pg8::EpiStore E{KM, D};
                pg8::gemm_phase<pg8::EpiStore, pg8::StaticOrder, true, false>(lds, g, S, E); }
            else { pg8::Gemm g{D, D, D}; pg8::StaticOrder S; S.init(Wckv_t + (size_t)D * D, MEMN, D, NB * MEML, D, D, 16, bx - 36); pg8::EpiStore E{VT, D};
                pg8::gemm_phase<pg8::EpiStore, pg8::StaticOrder, true, false>(lds, g, S, E); }
        } else if (wave < 4) {
            LAS float* scr = (LAS float*)(lds + wave * 16640); const int cw = (bx - 52) * 4 + wave, NCW = (G - 52) * 4;
            constexpr int I_GU = 32 * 2 * 16 * 16, I_D = 32 * 16 * 16;
            for (int it_ = cw; it_ < (I_GU + I_D) * REPS(3); it_ += NCW) { const int it = it_ % (I_GU + I_D);
                if (it < I_GU) { const int nb = it & 15, kb = (it >> 4) & 15, which = (it >> 8) & 1, e = it >> 9, n0 = nb * 64;
                    transpose_item64<true>((which ? w_up : w_gate) + (size_t)e * D * D, D, n0, kb * 64, Wgu_t + ((size_t)e * 2048 + (n0 >> 7) * 256 + (n0 & 127) + which * 128) * D, D, norm_moe, scr, lane); }
                else { const int r = it - I_GU, nb = r & 15, kb = (r >> 4) & 15, e = r >> 8;
                    transpose_item64<true>(w_down + (size_t)e * D * D, D, nb * 64, kb * 64, Wd_t + ((size_t)e * 1024 + nb * 64) * D, D, nullptr, scr, lane); }
            }
        }
    }
    SEAM(3);
    STAMP(4);
    if (IN(4)) {
        PHASE_PTRS
#pragma unroll 4
        for (int row_ = gw; row_ < M * REPS(4); row_ += NGW) { const int row = row_ % M, c0 = 8 * lane;
            const f32x4 o0 = *(const f32x4*)(ODN + (size_t)row * 512 + c0), o1 = *(const f32x4*)(ODN + (size_t)row * 512 + c0 + 4); const v4u zz = *(const v4u*)(PROJ + (size_t)row * NP + PC_Z + c0);
            float q = (o0[0] * o0[0] + o0[1] * o0[1]) + (o0[2] * o0[2] + o0[3] * o0[3]) + (o1[0] * o1[0] + o1[1] * o1[1]) + (o1[2] * o1[2] + o1[3] * o1[3]);
            q += __shfl_xor(q, 1); q += __shfl_xor(q, 2); q += __shfl_xor(q, 4); q += __shfl_xor(q, 8);
            const float rs = rsqrtf(q * (1.f / 128) + EPS); const f32x4 g0 = *(const f32x4*)(dn_norm + (c0 & 127)), g1 = *(const f32x4*)(dn_norm + (c0 & 127) + 4); v4u ov;
#pragma unroll
            for (int e = 0; e < 4; ++e) { const float a = (e < 2 ? o0[2 * e] : o1[2 * e - 4]) * rs * (e < 2 ? g0[2 * e] : g1[2 * e - 4]) * siluf_(bf2f((bf16)(zz[e] & 0xffff)));
                const float bq = (e < 2 ? o0[2 * e + 1] : o1[2 * e - 3]) * rs * (e < 2 ? g0[2 * e + 1] : g1[2 * e - 3]) * siluf_(bf2f((bf16)(zz[e] >> 16))); ov[e] = pk2(a, bq); }
            *(v4u*)(MIX + (size_t)row * D + c0) = ov; }
        for (int unit_ = bx; unit_ < NB * 64 * REPS(4); unit_ += G) { const int unit = unit_ & 255, c0 = 8 * lane; const size_t row0 = (size_t)unit * 64;
            const f32x4 ca = *(const f32x4*)((const float*)(wsl + WS_CARRY) + (size_t)unit * 512 + c0), cb = *(const f32x4*)((const float*)(wsl + WS_CARRY) + (size_t)unit * 512 + c0 + 4);
#pragma unroll 4
            for (int c = wave; c < 64; c += NWAVES) { const size_t row = row0 + c; const v4u hl = *(const v4u*)((const bf16*)(wsl + WS_HLOC) + row * 512 + c0), cpv = *(const v4u*)((const bf16*)(wsl + WS_CP) + row * 512 + c0), yy = *(const v4u*)(PROJ + row * NP + PC_RY + c0); v4u ov;
#pragma unroll
                for (int e = 0; e < 4; ++e) { const float c_lo = e < 2 ? ca[2 * e] : cb[2 * e - 4], c_hi = e < 2 ? ca[2 * e + 1] : cb[2 * e - 3];
                    const float h0 = bf2f((bf16)(hl[e] & 0xffff)) + bf2f((bf16)(cpv[e] & 0xffff)) * c_lo, h1 = bf2f((bf16)(hl[e] >> 16)) + bf2f((bf16)(cpv[e] >> 16)) * c_hi;
                    ov[e] = pk2(h0 * gelu_tanh(bf2f((bf16)(yy[e] & 0xffff))), h1 * gelu_tanh(bf2f((bf16)(yy[e] >> 16)))); }
                *(v4u*)(MIX + row * D + 512 + c0) = ov; } }
    }
    SEAM(4);
    STAMP(5);
    if (IN(5)) {
        PHASE_PTRS
        pg8::Gemm g{D, D, D}; pg8::StaticOrder S; S.init(MIX, Wout_t, M, D, D, D, G, bx); S.rep = REPS(5); pg8::EpiResid<false, false> E{x, nullptr, HB, ss1};
        pg8::gemm_phase<pg8::EpiResid<false, false>, pg8::StaticOrder, true, false>(lds, g, S, E);
    }
    SEAM(5);
    STAMP(6);
    if (IN(6)) {
        PHASE_PTRS
        for (int rp6 = 0; rp6 < REPS(6); ++rp6) { const int ut = bx; if (ut < (M / 256) * 4) {
            const int pm = ut >> 2, h = ut & 3, b = pm / (T / 256);
            { pg8::Gemm g{D, D, D}; pg8::OneUnit S; S.u0 = pg8::Unit{pm, h, (const char*)(HB + (size_t)pm * 256 * D), (const char*)(Wcq_t + (size_t)h * 256 * D), 0, 0, 0};
              pg8::EpiRowScale E{Qb, ss1, 0.0625f}; pg8::gemm_phase<pg8::EpiRowScale, pg8::OneUnit, false, false>(lds, g, S, E); }
            asm volatile("s_waitcnt vmcnt(0)" ::: "memory"); __syncthreads();
            { pg8::Gemm g{D, D, 256}; pg8::OneUnit S; S.u0 = pg8::Unit{pm, h, (const char*)(Qb + (size_t)pm * 256 * D + h * 256), (const char*)(KM + (size_t)b * 256 * D + h * 256), 0, 0, 0};
              pg8::EpiSoftmax E{Pb}; pg8::gemm_phase<pg8::EpiSoftmax, pg8::OneUnit, false, false>(lds, g, S, E); }
            asm volatile("s_waitcnt vmcnt(0)" ::: "memory"); __syncthreads();
            { pg8::Gemm g{D, D, 256}; pg8::OneUnit S; S.u0 = pg8::Unit{pm, h, (const char*)(Pb + (size_t)pm * 256 * D + h * 256), (const char*)(VT + (size_t)h * 256 * D + b * 256), 0, 0, 0};
              pg8::EpiStore E{O2, D}; pg8::gemm_phase<pg8::EpiStore, pg8::OneUnit, false, false>(lds, g, S, E); }
            asm volatile("s_waitcnt vmcnt(0)" ::: "memory"); __syncthreads();
        } }
    }
    SEAM(6);
    STAMP(7);
    if (IN(7)) {
        PHASE_PTRS
        pg8::Gemm g{D, D, D}; pg8::StaticOrder S; S.init(O2, Wco_t, M, D, D, D, G, bx); pg8::EpiResid<true, true> E{HB, out, HB2, ss2};
        pg8::gemm_phase<pg8::EpiResid<true, true>, pg8::StaticOrder, true, false>(lds, g, S, E);
    }
    SEAM(7);
    STAMP(8);
    if (IN(8)) {
        PHASE_PTRS
        unsigned* cntg = ctl + CW_CNT; int* TOKLw = (int*)(wsl + WS_TOKL); float* GATELw = (float*)(wsl + WS_GATEL); float* RSLw = (float*)(wsl + WS_RSL);
        const bf16* WRh = (const bf16*)(wsl + WS_WR); const bf16* WRl = WRh + NE * D; LAS float* part = (LAS float*)lds;
        for (int rb = bx; rb < M / 64; rb += G) {
            const int rgp = wave & 1, kq = wave >> 1, l31 = lane & 31, hh = lane >> 5; f32x16 acc;
#pragma unroll
            for (int r = 0; r < 16; ++r) acc[r] = 0.f;
            const float* arow = out + (size_t)(rb * 64 + rgp * 32 + l31) * D + kq * 256 + 8 * hh; const bf16* bh = WRh + (size_t)l31 * D + kq * 256 + 8 * hh; const bf16* bl = WRl + (size_t)l31 * D + kq * 256 + 8 * hh;
#pragma unroll 4
            for (int ks = 0; ks < 16; ++ks) { const f32x4 a0 = *(const f32x4*)(arow + 16 * ks), a1 = *(const f32x4*)(arow + 16 * ks + 4); const bf16x8 bhv = *(const bf16x8*)(bh + 16 * ks), blv = *(const bf16x8*)(bl + 16 * ks);
                v4u ah, al;
#pragma unroll
                for (int e = 0; e < 4; ++e) { const float x0 = e < 2 ? a0[2 * e] : a1[2 * e - 4], x1 = e < 2 ? a0[2 * e + 1] : a1[2 * e - 3]; const bf16 h0 = f2bf(x0), h1 = f2bf(x1);
                    ah[e] = (unsigned)h0 | ((unsigned)h1 << 16); al[e] = pk2(x0 - bf2f(h0), x1 - bf2f(h1)); }
                const bf16x8 ahv = __builtin_bit_cast(bf16x8, ah), alv = __builtin_bit_cast(bf16x8, al);
                acc = __builtin_amdgcn_mfma_f32_32x32x16_bf16(ahv, bhv, acc, 0, 0, 0); acc = __builtin_amdgcn_mfma_f32_32x32x16_bf16(alv, bhv, acc, 0, 0, 0); acc = __builtin_amdgcn_mfma_f32_32x32x16_bf16(ahv, blv, acc, 0, 0, 0); }
#pragma unroll
            for (int r = 0; r < 16; ++r) part[(kq * 64 + rgp * 32 + (r & 3) + 8 * (r >> 2) + 4 * hh) * 33 + l31] = acc[r];
            __syncthreads();
            if (tid < 64) { const int row = rb * 64 + tid; const float rs = rsqrtf(pg8::row_ss(ss2, row) * (1.f / D) + EPS); float lg[32];
#pragma unroll
                for (int e = 0; e < 32; ++e) lg[e] = ((part[tid * 33 + e] + part[(64 + tid) * 33 + e]) + (part[(128 + tid) * 33 + e] + part[(192 + tid) * 33 + e])) * rs + b_router[e];
                float tl[4]; int te[4];
#pragma unroll
                for (int q = 0; q < 4; ++q) { float m = lg[0]; int mi = 0;
#pragma unroll
                    for (int e = 1; e < 32; ++e) if (lg[e] > m) { m = lg[e]; mi = e; }
                    tl[q] = m; te[q] = mi;
#pragma unroll
                    for (int e = 0; e < 32; ++e) if (e == mi) lg[e] = -3.0e38f; }
                const float e1 = __expf(tl[1] - tl[0]), e2 = __expf(tl[2] - tl[0]), e3 = __expf(tl[3] - tl[0]), inv = 1.f / (1.f + e1 + e2 + e3);
                LAS unsigned* lcnt = (LAS unsigned*)(lds + 40960); LAS unsigned* lbase = lcnt + 32;
                if (tid < 32) lcnt[tid] = 0u;
                LDS_WAIT(); __builtin_amdgcn_wave_barrier();
                unsigned lp[4];
#pragma unroll
                for (int q = 0; q < 4; ++q) lp[q] = __hip_atomic_fetch_add(&lcnt[te[q]], 1u, __ATOMIC_RELAXED, __HIP_MEMORY_SCOPE_WORKGROUP);
                LDS_WAIT(); __builtin_amdgcn_wave_barrier();
                if (tid < 32) lbase[tid] = atomicAdd(&cntg[tid * CNT_STRIDE], lcnt[tid]);
                LDS_WAIT(); __builtin_amdgcn_wave_barrier();
#pragma unroll
                for (int q = 0; q < 4; ++q) { const float gv = (q == 0 ? 1.f : q == 1 ? e1 : q == 2 ? e2 : e3) * inv; const unsigned pos = lbase[te[q]] + lp[q];
                    TOKLw[te[q] * M + pos] = row * 4 + q; GATELw[te[q] * M + pos] = gv; RSLw[te[q] * M + pos] = rs; } }
            __syncthreads();
        }
    }
    SEAM(8);
    STAMP(9);
    if (IN(9) || IN(10)) {
        PHASE_PTRS
        const unsigned* cntg = ctl + CW_CNT;
        if (tid < 32) LW[LW_CNT + tid] = cntg[tid * CNT_STRIDE];
        __syncthreads();
        if (tid == 0) { int s = 0; for (int e = 0; e < 32; ++e) { LW[LW_TSTART + e] = (unsigned)s; s += ((int)LW[LW_CNT + e] + 255) >> 8; } LW[LW_TSTART + 32] = (unsigned)s; }
        __syncthreads();
    }
    const LAS int* tstart = (const LAS int*)(lds + LDSCTL_OFF) + LW_TSTART; const LAS int* cntl = (const LAS int*)(lds + LDSCTL_OFF) + LW_CNT;
    const int nrt_ = __builtin_amdgcn_readfirstlane(tstart[32]), rtA_ = __builtin_amdgcn_readfirstlane(tstart[30]);
    const int n1_ = (nrt_ - rtA_) * 8; int rtB_ = (((n1_ + G - 1) / G) * G - n1_) / 4; if (n1_ == 0) rtB_ = 0; if (rtB_ > rtA_) rtB_ = rtA_;
    if (IN(9)) {
        PHASE_PTRS
        { pg8::Gemm g{D, D, D}; pg8::MoeOrder<8, true> S{G, bx, tstart, cntl, (const char*)HB2, (const char*)Wgu_t, TOKL, 0, rtA_};
          pg8::EpiFFN1 E{HID, RSL, b_gate, b_up, cntl};
          pg8::gemm_phase<pg8::EpiFFN1, pg8::MoeOrder<8, true>, true, true>(lds, g, S, E); }
        xcd_barrier(bar);
        { pg8::Gemm g{D, D, D}; pg8::MoeMixed S{G, bx, tstart, cntl, (const char*)HB2, (const char*)HID, (const char*)Wgu_t, (const char*)Wd_t, TOKL, rtA_, nrt_, rtB_};
          pg8::EpiMixed E{pg8::EpiFFN1{HID, RSL, b_gate, b_up, cntl}, pg8::EpiFFN2{Y, TOKL, GATEL, b_down, cntl}};
          pg8::gemm_phase<pg8::EpiMixed, pg8::MoeMixed, true, true>(lds, g, S, E); }
    }
    SEAM(9);
    STAMP(10);
    if (IN(10)) {
        PHASE_PTRS
        pg8::Gemm g{D, D, D}; pg8::MoeOrder<4, false> S{G, bx, tstart, cntl, (const char*)HID, (const char*)Wd_t, TOKL, rtB_, nrt_};
        pg8::EpiFFN2 E{Y, TOKL, GATEL, b_down, cntl};
        pg8::gemm_phase<pg8::EpiFFN2, pg8::MoeOrder<4, false>, true, false>(lds, g, S, E);
    }
    SEAM(10);
    STAMP(11);
    if (IN(11)) {
        PHASE_PTRS
#pragma unroll 2
        for (int row = gw; row < M; row += NGW) {
            f32x4 v[4]; float s = 0.f;
#pragma unroll
            for (int j = 0; j < 4; ++j) { const int c = 4 * lane + 256 * j; f32x4 h = *(const f32x4*)(out + (size_t)row * D + c);
#pragma unroll
                for (int k = 0; k < 4; ++k) { const unsigned long long yy = *(const unsigned long long*)(Y + ((size_t)row * 4 + k) * D + c);
                    h[0] += bf2f((bf16)(yy & 0xffff)); h[1] += bf2f((bf16)((yy >> 16) & 0xffff)); h[2] += bf2f((bf16)((yy >> 32) & 0xffff)); h[3] += bf2f((bf16)(yy >> 48)); }
                v[j] = h; s += (h[0] * h[0] + h[1] * h[1]) + (h[2] * h[2] + h[3] * h[3]); }
            const float rs = rsqrtf(wave_sum(s) * (1.f / D) + EPS);
#pragma unroll
            for (int j = 0; j < 4; ++j) { const int c = 4 * lane + 256 * j; const f32x4 gg = *(const f32x4*)(norm_final + c); *(f32x4*)(out + (size_t)row * D + c) = v[j] * rs * gg; }
        }
    }
    STAMP(12);
    if (TS_LO >= 0 && blockIdx.x == 0 && threadIdx.x == 0) {
        unsigned long long* tsp = (unsigned long long*)(args.ws + WS_TS);
        const unsigned long long t0 = __hip_atomic_load(tsp + TS_LO, __ATOMIC_RELAXED, __HIP_MEMORY_SCOPE_AGENT), t1 = __hip_atomic_load(tsp + TS_HI, __ATOMIC_RELAXED, __HIP_MEMORY_SCOPE_AGENT);
        const unsigned long long until = __builtin_amdgcn_s_memrealtime() + TS_MULT * (t1 - t0);
        while (__builtin_amdgcn_s_memrealtime() < until) __builtin_amdgcn_s_sleep(8);
    }
#undef IN
#undef SEAM
}

static void launch_mk(Args a, int lo, int hi, int bli, int grid, hipStream_t stream) {
    a.ph_lo = lo; a.ph_hi = hi; a.bli = bli; a.pad = 0;
    hipLaunchKernelGGL(mk_fwd, dim3(grid), dim3(NTHR), LDS_BYTES, stream, a);
}
extern "C" void kernel_launch(void* const* d_in, const int* in_sizes, int n_in, void* d_out, int out_size, void* d_ws, size_t ws_size, hipStream_t stream) {
    if (n_in != 31 || out_size != M * D || ws_size < WS_END) { fprintf(stderr, "kernel_launch: unexpected shapes n_in %d out %d ws %zu\n", n_in, out_size, ws_size); return; }
    static int grid = 0;
    if (grid == 0) {
        int dev = 0, cus = 0;
        if (hipGetDevice(&dev) != hipSuccess || hipDeviceGetAttribute(&cus, hipDeviceAttributeMultiprocessorCount, dev) != hipSuccess) { grid = -1; return; }
        if (hipFuncSetAttribute((const void*)mk_fwd, hipFuncAttributeMaxDynamicSharedMemorySize, LDS_BYTES) != hipSuccess) { fprintf(stderr, "kernel_launch: hipFuncSetAttribute failed\n"); grid = -1; return; }
        int per_cu = 0; (void)hipOccupancyMaxActiveBlocksPerMultiprocessor(&per_cu, (const void*)mk_fwd, NTHR, LDS_BYTES); (void)hipGetLastError();
        if (per_cu < 1) fprintf(stderr, "kernel_launch: occupancy query reports %d blocks per CU\n", per_cu);
        if (cus < 256) { fprintf(stderr, "kernel_launch: needs 256 CUs, device has %d\n", cus); grid = -1; return; }
        grid = 256;
    }
    if (grid < 0) return;
    const float* const* in = (const float* const*)d_in;
    const float *dn_conv = in[4], *dn_a_log = in[5], *dn_dt_bias = in[6], *dn_norm = in[7];
    const float *rg_conv = in[8], *rg_conv_b = in[9], *rg_w_a = in[10], *rg_b_a = in[11], *rg_w_x = in[12], *rg_b_x = in[13], *rg_lambda = in[14];
    const float *norm_moe = in[21], *w_router = in[22], *b_router = in[23];
    char* ws = (char*)d_ws; float* out = (float*)d_out;
    unsigned* ctl = (unsigned*)(ws + WS_CTL); unsigned* cnt = ctl + CW_CNT; float* ss2 = (float*)(ws + CTL_SS2);
    float* BA = (float*)(ws + WS_BA); float* RSTD2 = (float*)(ws + WS_RSTD2);
    int* TOKL = (int*)(ws + WS_TOKL); float* GATEL = (float*)(ws + WS_GATEL); float* RSL = (float*)(ws + WS_RSL);
    bf16 *MIX = (bf16*)(ws + WS_XN), *PROJ = (bf16*)(ws + WS_PROJ);
    float* ODN = (float*)(ws + WS_ODN); float* QKVN = (float*)(ws + WS_QKVN);
    Args a{};
    for (int i = 0; i < 31; ++i) a.in[i] = (const float*)d_in[i];
    a.out = out; a.ws = (unsigned char*)d_ws;

    (void)hipMemsetAsync(ws + WS_CTL, 0, CTL_BYTES, stream);
    launch_mk(a, 0, 12, 0, grid, stream);
}
```
